# Optimizing an MI355X kernel written in HIP

```python
import jax, jax.numpy as jnp
from jax import lax
import numpy as np

D_MODEL = 1024
BATCH = 1
SEQ = 16384
DEPTH = 2

N_EVEN = (DEPTH + 1) // 2
N_ODD = DEPTH // 2
EPS = 1e-6

CHUNK = 128
A_WIDTH = D_MODEL // 2
A_GROUPS = 4
A_HD = A_WIDTH // A_GROUPS
B_WIDTH = D_MODEL // 2
POOL_WINDOWS = (2, 4, 8, 16)
B_GROUPS = len(POOL_WINDOWS)
B_HD = B_WIDTH // B_GROUPS
E_IN = 2 * A_WIDTH + B_WIDTH
E_OUT = A_WIDTH + B_WIDTH
C_WIDTH = D_MODEL // 2
CONV_W = 3
MLA_HEADS = 4
Q_LORA = 256
KV_LORA = 256
QK_NOPE = 128
QK_ROPE = 64
QK_HD = QK_NOPE + QK_ROPE
V_HD = 128
ROPE_THETA = 10000.0
Q_BLOCK = 128
O_IN = 3 * C_WIDTH + Q_LORA + KV_LORA + QK_ROPE
O_OUT = C_WIDTH + MLA_HEADS * V_HD
D_FF = 2816
N_EXPERTS = 8
TOP_K = 2
D_FF_EXPERT = 3584

kernel_name = "hybrid_gmlp_pool_conv_mla_moe_adaln"


def rmsnorm(x, w):
    xf = x.astype(jnp.float32)
    y = xf * lax.rsqrt(jnp.mean(xf * xf, axis=-1, keepdims=True) + EPS)
    return (y * w.astype(jnp.float32)).astype(x.dtype)


def layernorm(x, w, b):
    xf = x.astype(jnp.float32)
    mu = jnp.mean(xf, axis=-1, keepdims=True)
    var = jnp.mean(jnp.square(xf - mu), axis=-1, keepdims=True)
    y = (xf - mu) * lax.rsqrt(var + EPS)
    return (y * w.astype(jnp.float32) + b.astype(jnp.float32)).astype(x.dtype)


def swiglu(h, w_gu, w_down):
    g, u = jnp.split(h @ w_gu, 2, axis=-1)
    return (jax.nn.silu(g) * u) @ w_down


def mixer_a(uv, ln_w, ln_b, w_s, b_s):
    bsz, s, _ = uv.shape
    u, v = jnp.split(jax.nn.gelu(uv), 2, axis=-1)
    v = layernorm(v, ln_w, ln_b)
    v = v.reshape(bsz, s // CHUNK, CHUNK, A_GROUPS, A_HD)
    w = w_s * jnp.tril(jnp.ones((CHUNK, CHUNK), dtype=w_s.dtype))[None]
    sv = jnp.einsum('gts,bnsgd->bntgd', w, v) + b_s.T[None, None, :, :, None]
    return u * sv.reshape(bsz, s, A_WIDTH)


def mixer_b(p, w_grp, scale):
    bsz, s, _ = p.shape
    cs = jnp.pad(jnp.cumsum(p.astype(jnp.float32), axis=1), ((0, 0), (1, 0), (0, 0)))
    t = jnp.arange(s)
    pooled = []
    for gi, win in enumerate(POOL_WINDOWS):
        csg = cs[..., gi * B_HD:(gi + 1) * B_HD]
        hi = csg[:, 1:]
        lo = jnp.pad(csg, ((0, 0), (win - 1, 0), (0, 0)))[:, :s]
        count = jnp.minimum(t + 1, win).astype(jnp.float32)[None, :, None]
        pooled.append((hi - lo) / count)
    pooled = jnp.concatenate(pooled, axis=-1).astype(p.dtype) - p
    y = jnp.einsum('bsgd,gde->bsge', pooled.reshape(bsz, s, B_GROUPS, B_HD), w_grp)
    return y.reshape(bsz, s, B_WIDTH) * scale


def mixer_c(bch, conv_w):
    s = bch.shape[1]
    bg, cg, h = jnp.split(bch, 3, axis=-1)
    z = jnp.pad(cg * h, ((0, 0), (CONV_W - 1, 0), (0, 0)))
    conv = sum(conv_w[k] * z[:, k:k + s] for k in range(CONV_W))
    return bg * conv


def rope(x, positions):
    inv_freq = ROPE_THETA ** (-jnp.arange(0, QK_ROPE, 2, dtype=jnp.float32) / QK_ROPE)
    ang = positions.astype(jnp.float32)[..., None] * inv_freq
    cos = jnp.cos(ang)[:, :, None, :].astype(x.dtype)
    sin = jnp.sin(ang)[:, :, None, :].astype(x.dtype)
    x1, x2 = jnp.split(x, 2, axis=-1)
    return jnp.concatenate([x1 * cos - x2 * sin, x2 * cos + x1 * sin], axis=-1)


def mixer_d(cq, ckv, kpe, positions, q_a_norm, w_uq, kv_norm, w_ukv, q_norm_w, k_norm_w):
    bsz, s, _ = cq.shape
    q = (rmsnorm(cq, q_a_norm) @ w_uq).reshape(bsz, s, MLA_HEADS, QK_HD)
    kv = (rmsnorm(ckv, kv_norm) @ w_ukv).reshape(bsz, s, MLA_HEADS, QK_NOPE + V_HD)
    k_nope, v = kv[..., :QK_NOPE], kv[..., QK_NOPE:]
    k_pe = jnp.broadcast_to(kpe[:, :, None, :], (bsz, s, MLA_HEADS, QK_ROPE))
    k = jnp.concatenate([k_nope, k_pe], axis=-1)
    q = rmsnorm(q, q_norm_w)
    k = rmsnorm(k, k_norm_w)
    q = jnp.concatenate([q[..., :QK_NOPE], rope(q[..., QK_NOPE:], positions)], axis=-1)
    k = jnp.concatenate([k[..., :QK_NOPE], rope(k[..., QK_NOPE:], positions)], axis=-1)
    nb = s // Q_BLOCK
    qb = q.reshape(bsz, nb, Q_BLOCK, MLA_HEADS, QK_HD).transpose(1, 0, 2, 3, 4)
    key_pos = jnp.arange(s)
    sm_scale = QK_HD ** -0.5

    def block(args):
        qi, bi = args
        sc = jnp.einsum('bqhd,bkhd->bhqk', qi, k, preferred_element_type=jnp.float32) * sm_scale
        qpos = bi * Q_BLOCK + jnp.arange(Q_BLOCK)
        sc = jnp.where(key_pos[None, :] <= qpos[:, None], sc, -1e30)
        pr = jax.nn.softmax(sc, axis=-1).astype(v.dtype)
        return jnp.einsum('bhqk,bkhd->bqhd', pr, v)

    o = lax.map(block, (qb, jnp.arange(nb)))
    return o.transpose(1, 0, 2, 3, 4).reshape(bsz, s, MLA_HEADS * V_HD)


def moe_swiglu(h, router_w, w_gu, w_down):
    logits = (h @ router_w).astype(jnp.float32)
    top_v, top_i = lax.top_k(logits, TOP_K)
    wts = jax.nn.softmax(top_v, axis=-1)
    gates = jnp.einsum('bsk,bske->bse', wts, jax.nn.one_hot(top_i, N_EXPERTS, dtype=jnp.float32)).astype(h.dtype)
    y = jnp.zeros_like(h)
    for e in range(N_EXPERTS):
        y = y + gates[..., e:e + 1] * swiglu(h, w_gu[e], w_down[e])
    return y


def setup_inputs(seed: int = 0) -> dict:
    key = jax.random.key(seed)
    keys = jax.random.split(key, 40)
    ctr = [0]

    def nrm(shape, scale):
        k = keys[ctr[0]]
        ctr[0] += 1
        return jax.random.normal(k, shape, jnp.float32) * scale

    def gain(shape):
        return 1.0 + nrm(shape, 0.1)

    D = D_MODEL
    return {
        "x": nrm((BATCH, SEQ, D), 1.0),
        "c": nrm((BATCH, D), 1.0),
        "positions": jnp.broadcast_to(jnp.arange(SEQ, dtype=jnp.int32), (BATCH, SEQ)),
        "norm_mix_w": gain((DEPTH, D)),
        "norm_ffn_w": gain((DEPTH, D)),
        "ada_w": nrm((DEPTH, D, 6 * D), D ** -0.5),
        "ada_b": nrm((DEPTH, 6 * D), 0.02),
        "e_w_in": nrm((N_EVEN, D, E_IN), D ** -0.5),
        "a_ln_w": gain((N_EVEN, A_WIDTH)),
        "a_ln_b": nrm((N_EVEN, A_WIDTH), 0.02),
        "a_w_s": nrm((N_EVEN, A_GROUPS, CHUNK, CHUNK), CHUNK ** -0.5),
        "a_b_s": gain((N_EVEN, A_GROUPS, CHUNK)),
        "b_w_grp": nrm((N_EVEN, B_GROUPS, B_HD, B_HD), B_HD ** -0.5),
        "b_scale": gain((N_EVEN, B_WIDTH)),
        "e_w_out": nrm((N_EVEN, E_OUT, D), E_OUT ** -0.5),
        "ffn_w_gu": nrm((N_EVEN, D, 2 * D_FF), D ** -0.5),
        "ffn_w_down": nrm((N_EVEN, D_FF, D), D_FF ** -0.5),
        "o_w_in": nrm((N_ODD, D, O_IN), D ** -0.5),
        "c_conv_w": nrm((N_ODD, CONV_W, C_WIDTH), CONV_W ** -0.5),
        "q_a_norm": gain((N_ODD, Q_LORA)),
        "w_uq": nrm((N_ODD, Q_LORA, MLA_HEADS * QK_HD), Q_LORA ** -0.5),
        "kv_norm": gain((N_ODD, KV_LORA)),
        "w_ukv": nrm((N_ODD, KV_LORA, MLA_HEADS * (QK_NOPE + V_HD)), KV_LORA ** -0.5),
        "q_norm_w": gain((N_ODD, QK_HD)),
        "k_norm_w": gain((N_ODD, QK_HD)),
        "o_w_out": nrm((N_ODD, O_OUT, D), O_OUT ** -0.5),
        "router_w": nrm((N_ODD, D, N_EXPERTS), D ** -0.5),
        "moe_w_gu": nrm((N_ODD, N_EXPERTS, D, 2 * D_FF_EXPERT), D ** -0.5),
        "moe_w_down": nrm((N_ODD, N_EXPERTS, D_FF_EXPERT, D), D_FF_EXPERT ** -0.5),
    }


def reference(x, c, positions, norm_mix_w, norm_ffn_w, ada_w, ada_b,
              e_w_in, a_ln_w, a_ln_b, a_w_s, a_b_s, b_w_grp, b_scale, e_w_out,
              ffn_w_gu, ffn_w_down,
              o_w_in, c_conv_w, q_a_norm, w_uq, kv_norm, w_ukv, q_norm_w, k_norm_w,
              o_w_out, router_w, moe_w_gu, moe_w_down):
    c_act = jax.nn.silu(c)
    for layer in range(DEPTH):
        mod = c_act @ ada_w[layer] + ada_b[layer]
        sh_m, sc_m, g_m, sh_f, sc_f, g_f = [m[:, None, :] for m in jnp.split(mod, 6, axis=-1)]
        h = rmsnorm(x, norm_mix_w[layer]) * (1 + sc_m) + sh_m
        if layer % 2 == 0:
            i = layer // 2
            p = h @ e_w_in[i]
            ya = mixer_a(p[..., :2 * A_WIDTH], a_ln_w[i], a_ln_b[i], a_w_s[i], a_b_s[i])
            yb = mixer_b(p[..., 2 * A_WIDTH:], b_w_grp[i], b_scale[i])
            mix = jnp.concatenate([ya, yb], axis=-1) @ e_w_out[i]
        else:
            i = layer // 2
            p = h @ o_w_in[i]
            o0 = 3 * C_WIDTH
            o1 = o0 + Q_LORA
            o2 = o1 + KV_LORA
            yc = mixer_c(p[..., :o0], c_conv_w[i])
            yd = mixer_d(p[..., o0:o1], p[..., o1:o2], p[..., o2:], positions,
                         q_a_norm[i], w_uq[i], kv_norm[i], w_ukv[i], q_norm_w[i], k_norm_w[i])
            mix = jnp.concatenate([yc, yd], axis=-1) @ o_w_out[i]
        x = x + g_m * mix
        h = rmsnorm(x, norm_ffn_w[layer]) * (1 + sc_f) + sh_f
        if layer % 2 == 0:
            ffn = swiglu(h, ffn_w_gu[layer // 2], ffn_w_down[layer // 2])
        else:
            i = layer // 2
            ffn = moe_swiglu(h, router_w[i], moe_w_gu[i], moe_w_down[i])
        x = x + g_f * ffn
    return x
```

```cpp
#include <hip/hip_runtime.h>
#include <cstdio>
#include <cstdint>

#ifndef MK_MULTI
#define MK_MULTI 0
#endif
#ifndef DBG_STOP
#define DBG_STOP -1
#endif

namespace pg8 {
#define PG8_LAS __attribute__((address_space(3)))
typedef unsigned short bf16_t;
typedef short bf16x8 __attribute__((ext_vector_type(8)));
typedef float f32x4 __attribute__((ext_vector_type(4)));
typedef float f32x2 __attribute__((ext_vector_type(2)));
typedef unsigned u32x4 __attribute__((ext_vector_type(4)));
constexpr int BM = 256, BK = 64, HALF = 128, HTB = HALF * BK * 2, STAGE_BYTES = 8 * HTB, NXCD = 8, WGM = 8;

__host__ __device__ __forceinline__ int lds_byte(int r, int c) { const int st = (r >> 4) * 2 + (c >> 5), rr = r & 15, cc = c & 31, ob = rr * 64 + cc * 2; return st * 1024 + (ob ^ (((ob >> 9) & 1) << 5)); }
__host__ __device__ __forceinline__ void stage_rc(int b, int& R, int& C) { const int st = b / 1024, sb = b % 1024, swz = sb ^ (((sb >> 9) & 1) << 5); R = (st >> 1) * 16 + swz / 64; C = (st & 1) * 32 + (swz % 64) / 2; }
__host__ __device__ __forceinline__ int perm32(int rho) { const int n = rho >> 4, i = rho & 15; return 8 * (i >> 2) + 4 * n + (i & 3); }

struct Unit { int pm, pn, po; };
struct Gemm { const bf16_t* A; const bf16_t* Bt; int lda, K; };

struct StaticOrder {
    int nM, nN, nwg, G, c;
    __device__ void init(int M, int N, int G_, int c_) { nM = M / BM; nN = N / BM; nwg = nM * nN; G = G_; c = c_; }
    __device__ bool next(int i, Unit& u) const {
        const long L = (long)i * G + c; if (L >= nwg) return false;
        int wgid = (int)L; { const int q = nwg / NXCD, r = nwg % NXCD, xcd = wgid % NXCD, off = wgid / NXCD; wgid = (xcd < r ? xcd * (q + 1) : r * (q + 1) + (xcd - r) * q) + off; }
        const int nig = WGM * nN, gid = wgid / nig, fm = gid * WGM, gsz = (nM - fm) < WGM ? (nM - fm) : WGM;
        u.pm = fm + ((wgid % nig) % gsz); u.pn = (wgid % nig) / gsz; u.po = u.pn; return true;
    }
};
struct MoeOrder {
    int rt0, rt1, rt2, rt3, rt4, rt5, rt6, rt7, nct, G, c;
    __device__ void init(const unsigned* cnt, int nct_, int G_, int c_) {
        rt0 = (int)((cnt[0] + 255u) >> 8); rt1 = (int)((cnt[64] + 255u) >> 8); rt2 = (int)((cnt[128] + 255u) >> 8); rt3 = (int)((cnt[192] + 255u) >> 8);
        rt4 = (int)((cnt[256] + 255u) >> 8); rt5 = (int)((cnt[320] + 255u) >> 8); rt6 = (int)((cnt[384] + 255u) >> 8); rt7 = (int)((cnt[448] + 255u) >> 8);
        nct = nct_; G = G_; c = c_;
    }
    __device__ bool next(int i, Unit& u) const {
        const int L = i * G + c; int cum = 0, tb = 0; bool found = false;
#define MO_STEP(e, rte) { const int n_ = (rte) * nct; if (!found && L < cum + n_) { const int r_ = L - cum; u.pm = tb + r_ % (rte); u.po = r_ / (rte); u.pn = (e) * nct + u.po; found = true; } cum += n_; tb += (rte); }
        MO_STEP(0, rt0) MO_STEP(1, rt1) MO_STEP(2, rt2) MO_STEP(3, rt3) MO_STEP(4, rt4) MO_STEP(5, rt5) MO_STEP(6, rt6) MO_STEP(7, rt7)
#undef MO_STEP
        return found;
    }
};

__device__ __forceinline__ unsigned cvt_pk_bf16(float lo, float hi) { unsigned r; asm volatile("v_cvt_pk_bf16_f32 %0, %1, %2" : "=v"(r) : "v"(lo), "v"(hi)); return r; }
__device__ __forceinline__ float gelu_tanh(float x) {
    const float u2 = x * (1.5957691216057308f + 0.07135481282599649f * x * x);
    return x * __builtin_amdgcn_rcpf(1.0f + __builtin_amdgcn_exp2f(-1.4426950408889634f * u2));
}
__device__ __forceinline__ float silu_f(float x) { return x * __builtin_amdgcn_rcpf(1.0f + __builtin_amdgcn_exp2f(-1.4426950408889634f * x)); }

struct EpiBf16G {
    static constexpr bool PERM = true;
    bf16_t* O; int ldc; int gelu_tiles;
    __device__ __forceinline__ void operator()(const f32x4 (&acc)[2][2][4][2], const Unit& u, int wr, int wc, int fr, int fq) const {
        const int row0 = u.pm * BM + wr * 64 + fr, col0 = u.po * BM + wc * 32 + 8 * fq; const bool g = u.po < gelu_tiles;
#pragma unroll
        for (int ai = 0; ai < 2; ++ai)
#pragma unroll
            for (int m = 0; m < 4; ++m) { bf16_t* rowp = O + (size_t)(row0 + ai * HALF + m * 16) * ldc + col0;
#pragma unroll
                for (int bj = 0; bj < 2; ++bj) { f32x4 v0 = acc[ai][bj][m][0], v1 = acc[ai][bj][m][1];
                    if (g) { v0 = (f32x4){gelu_tanh(v0[0]), gelu_tanh(v0[1]), gelu_tanh(v0[2]), gelu_tanh(v0[3])}; v1 = (f32x4){gelu_tanh(v1[0]), gelu_tanh(v1[1]), gelu_tanh(v1[2]), gelu_tanh(v1[3])}; }
                    u32x4 w; w.x = cvt_pk_bf16(v0[0], v0[1]); w.y = cvt_pk_bf16(v0[2], v0[3]); w.z = cvt_pk_bf16(v1[0], v1[1]); w.w = cvt_pk_bf16(v1[2], v1[3]);
                    *(u32x4*)(rowp + bj * HALF) = w; } }
    }
};
struct EpiSwiGLU {
    static constexpr bool PERM = true;
    bf16_t* O; int ldc;
    __device__ __forceinline__ void operator()(const f32x4 (&acc)[2][2][4][2], const Unit& u, int wr, int wc, int fr, int fq) const {
        const int row0 = u.pm * BM + wr * 64 + fr, col0 = u.po * HALF + wc * 32 + 8 * fq;
#pragma unroll
        for (int ai = 0; ai < 2; ++ai)
#pragma unroll
            for (int m = 0; m < 4; ++m) { const f32x4 g0 = acc[ai][0][m][0], g1 = acc[ai][0][m][1], u0 = acc[ai][1][m][0], u1 = acc[ai][1][m][1];
                u32x4 w; w.x = cvt_pk_bf16(silu_f(g0[0]) * u0[0], silu_f(g0[1]) * u0[1]); w.y = cvt_pk_bf16(silu_f(g0[2]) * u0[2], silu_f(g0[3]) * u0[3]);
                w.z = cvt_pk_bf16(silu_f(g1[0]) * u1[0], silu_f(g1[1]) * u1[1]); w.w = cvt_pk_bf16(silu_f(g1[2]) * u1[2], silu_f(g1[3]) * u1[3]);
                *(u32x4*)(O + (size_t)(row0 + ai * HALF + m * 16) * ldc + col0) = w; }
    }
};
struct EpiRes {
    static constexpr bool PERM = false;
    const float* base; float* out; const float* gate;
    __device__ __forceinline__ void operator()(const f32x4 (&acc)[2][2][4][2], const Unit& u, int wr, int wc, int fr, int fq) const {
        const int col0 = u.po * BM + wc * 32 + 4 * fq;
        f32x4 gv[2][2];
#pragma unroll
        for (int bj = 0; bj < 2; ++bj)
#pragma unroll
            for (int n = 0; n < 2; ++n) gv[bj][n] = *(const f32x4*)(gate + col0 + bj * HALF + n * 16);
#pragma unroll
        for (int ai = 0; ai < 2; ++ai)
#pragma unroll
            for (int m = 0; m < 4; ++m) { const size_t off = (size_t)(u.pm * BM + ai * HALF + wr * 64 + m * 16 + fr) * 1024 + col0;
#pragma unroll
                for (int bj = 0; bj < 2; ++bj)
#pragma unroll
                    for (int n = 0; n < 2; ++n) { const f32x4 bs = *(const f32x4*)(base + off + bj * HALF + n * 16); *(f32x4*)(out + off + bj * HALF + n * 16) = bs + gv[bj][n] * acc[ai][bj][m][n]; } }
    }
};

template <class Epi, class Sched, bool ALIGN_EPI = true>
__device__ __forceinline__ void gemm_phase(PG8_LAS unsigned char* lds, const Gemm g, const Sched& S, const Epi& E) {
    const int tid = threadIdx.x, wid = __builtin_amdgcn_readfirstlane(tid >> 6), lane = tid & 63, wr = wid >> 2, wc = wid & 3, fr = lane & 15, fq = lane >> 4;
    const int K = g.K, nt = K / BK, lda = g.lda;
    unsigned voffA[2], voffB[2];
#pragma unroll
    for (int i = 0; i < 2; ++i) { int R, C; stage_rc(tid * 16 + i * 8192, R, C); const int Rb = Epi::PERM ? ((R & ~31) + perm32(R & 31)) : R;
        voffA[i] = (unsigned)(R * lda + C) * 2u; voffB[i] = (unsigned)(Rb * K + C) * 2u; }
    const size_t kstep = (size_t)(BK * 2);
    const size_t hstepA = (size_t)HALF * lda * 2, hstepB = (size_t)HALF * K * 2;
    const size_t tstepA = 2 * hstepA, tstepB = 2 * hstepB;
    const unsigned ldsw = (unsigned)wid * 1024u;
    const int aoff = lds_byte(wr * 64 + fr, fq * 8), boff = lds_byte(wc * 32 + fr, fq * 8);
#define PG8_SA(b, h) (((b) * 2 + (h)) * HTB)
#define PG8_SB(b, h) ((4 + (b) * 2 + (h)) * HTB)
#define PG8_STAGE(bufoff, gbase, voff) do { _Pragma("unroll") for (int _i = 0; _i < 2; ++_i) \
        __builtin_amdgcn_global_load_lds((const unsigned*)((const char*)(gbase) + (voff)[_i]), (PG8_LAS unsigned*)(lds + (bufoff) + ldsw + _i * 8192), 16, 0, 0); } while (0)
#define PG8_LDA(dst, b, h) do { _Pragma("unroll") for (int m = 0; m < 4; ++m) _Pragma("unroll") for (int k = 0; k < 2; ++k) dst[m][k] = *(const PG8_LAS bf16x8*)(lds + PG8_SA(b, h) + aoff + m * 2048 + k * 1024); } while (0)
#define PG8_LDB(dst, b, h) do { _Pragma("unroll") for (int n = 0; n < 2; ++n) _Pragma("unroll") for (int k = 0; k < 2; ++k) dst[n][k] = *(const PG8_LAS bf16x8*)(lds + PG8_SB(b, h) + boff + n * 2048 + k * 1024); } while (0)
#define PG8_MMA(ai, bj, At, Bt) do { __builtin_amdgcn_s_setprio(1); _Pragma("unroll") for (int m = 0; m < 4; ++m) _Pragma("unroll") for (int n = 0; n < 2; ++n) _Pragma("unroll") for (int k = 0; k < 2; ++k) \
        acc[ai][bj][m][n] = __builtin_amdgcn_mfma_f32_16x16x32_bf16(Bt[n][k], At[m][k], acc[ai][bj][m][n], 0, 0, 0); __builtin_amdgcn_s_setprio(0); } while (0)
#define PG8_WAIT_V(n) asm volatile("s_waitcnt vmcnt(" #n ")" ::: "memory")
#define PG8_WAIT_L(n) asm volatile("s_waitcnt lgkmcnt(" #n ")" ::: "memory")
#define PG8_BAR __builtin_amdgcn_s_barrier()
#define PG8_SCHED __builtin_amdgcn_sched_barrier(0)
    Unit cur, nxt; int ui = 0;
    if (!S.next(0, cur)) return;
    f32x4 acc[2][2][4][2];
#pragma unroll
    for (int a = 0; a < 2; ++a)
#pragma unroll
        for (int b = 0; b < 2; ++b)
#pragma unroll
            for (int m = 0; m < 4; ++m)
#pragma unroll
                for (int n = 0; n < 2; ++n) acc[a][b][m][n] = (f32x4){0.f, 0.f, 0.f, 0.f};
    bf16x8 At[4][2], B0[2][2], B1[2][2];
    const char* cA = (const char*)g.A + (size_t)cur.pm * tstepA; const char* cB = (const char*)g.Bt + (size_t)cur.pn * tstepB;
    PG8_STAGE(PG8_SB(0, 0), cB, voffB); PG8_STAGE(PG8_SB(0, 1), cB + hstepB, voffB); PG8_STAGE(PG8_SA(0, 0), cA, voffA); PG8_STAGE(PG8_SA(0, 1), cA + hstepA, voffA);
    if (wr == 1) PG8_BAR;
    PG8_WAIT_V(2); PG8_BAR;
    PG8_STAGE(PG8_SB(1, 0), cB + kstep, voffB); PG8_STAGE(PG8_SA(1, 0), cA + kstep, voffA); PG8_STAGE(PG8_SB(1, 1), cB + hstepB + kstep, voffB);
    PG8_WAIT_V(6); PG8_BAR;
    for (;;) {
        const bool has_next = S.next(ui + 1, nxt);
        const char* nA = has_next ? (const char*)g.A + (size_t)nxt.pm * tstepA : cA; const char* nB = has_next ? (const char*)g.Bt + (size_t)nxt.pn * tstepB : cB;
        for (int t = 0; t < nt; t += 2) {
            const bool last = (t == nt - 2);
            const char* a1 = cA + (size_t)(t + 1) * kstep;
            const char* a2 = last ? nA : cA + (size_t)(t + 2) * kstep; const char* b2 = last ? nB : cB + (size_t)(t + 2) * kstep;
            const char* a3 = a2 + kstep; const char* b3 = b2 + kstep;
            PG8_LDB(B0, 0, 0); PG8_LDB(B1, 0, 1); PG8_SCHED; PG8_LDA(At, 0, 0); PG8_STAGE(PG8_SA(1, 1), a1 + hstepA, voffA);
            PG8_WAIT_V(8); PG8_WAIT_L(0); PG8_BAR; PG8_MMA(0, 0, At, B0); PG8_MMA(0, 1, At, B1); PG8_BAR; PG8_SCHED;
            PG8_LDA(At, 0, 1); PG8_STAGE(PG8_SB(0, 0), b2, voffB); PG8_STAGE(PG8_SB(0, 1), b2 + hstepB, voffB); PG8_STAGE(PG8_SA(0, 0), a2, voffA);
            PG8_WAIT_V(8); PG8_WAIT_L(0); PG8_BAR; PG8_MMA(1, 0, At, B0); PG8_MMA(1, 1, At, B1); PG8_BAR; PG8_SCHED;
            PG8_LDB(B0, 1, 0); PG8_LDB(B1, 1, 1); PG8_SCHED; PG8_LDA(At, 1, 0); PG8_STAGE(PG8_SA(0, 1), a2 + hstepA, voffA);
            PG8_WAIT_V(8); PG8_WAIT_L(0); PG8_BAR; PG8_MMA(0, 0, At, B0); PG8_MMA(0, 1, At, B1); PG8_BAR; PG8_SCHED;
            PG8_LDA(At, 1, 1); PG8_STAGE(PG8_SB(1, 0), b3, voffB); PG8_STAGE(PG8_SB(1, 1), b3 + hstepB, voffB); PG8_STAGE(PG8_SA(1, 0), a3, voffA);
            PG8_WAIT_V(8); PG8_WAIT_L(0); PG8_BAR; PG8_MMA(1, 0, At, B0); PG8_MMA(1, 1, At, B1); PG8_BAR; PG8_SCHED;
        }
        if constexpr (ALIGN_EPI) { if (wr == 0) PG8_BAR; }
        E(acc, cur, wr, wc, fr, fq);
        if (!has_next) break;
#pragma unroll
        for (int a = 0; a < 2; ++a)
#pragma unroll
            for (int b = 0; b < 2; ++b)
#pragma unroll
                for (int m = 0; m < 4; ++m)
#pragma unroll
                    for (int n = 0; n < 2; ++n) acc[a][b][m][n] = (f32x4){0.f, 0.f, 0.f, 0.f};
        cur = nxt; cA = nA; cB = nB; ++ui;
        if constexpr (ALIGN_EPI) { if (wr == 1) PG8_BAR; }
    }
    PG8_WAIT_V(0);
    if constexpr (!ALIGN_EPI) { if (wr == 0) PG8_BAR; }
    PG8_BAR;
#undef PG8_SA
#undef PG8_SB
#undef PG8_STAGE
#undef PG8_LDA
#undef PG8_LDB
#undef PG8_MMA
#undef PG8_WAIT_V
#undef PG8_WAIT_L
#undef PG8_BAR
#undef PG8_SCHED
}
}

constexpr int NWAVES = 8, NTHR = 512;
constexpr int S = 16384, D = 1024;
constexpr int E_IN = 1536, D_FF = 2816, O_IN = 2112, O_INP = 2304, NE = 8, DFE = 3584;
constexpr int MOE_ROWS = 34816;
constexpr float EPS = 1e-6f;

constexpr size_t MiB = 1u << 20;
constexpr size_t WS_CTL = 0, CTL_ZERO_BYTES = 1 * MiB;
constexpr size_t WS_MODP = 1 * MiB, WS_MODF = 2 * MiB, WS_ROPE = 3 * MiB;
constexpr size_t WS_TOK = 7 * MiB;
constexpr size_t WS_WIN0 = 8 * MiB, WS_WOUT0 = 11 * MiB, WS_WGU0 = 13 * MiB, WS_WD0 = 24 * MiB, WS_WIN1 = 30 * MiB;
constexpr size_t WS_WUQ = 35 * MiB, WS_WUKV = WS_WUQ + MiB / 2, WS_WOUT1 = 36 * MiB, WS_WTRIL = 38 * MiB, WS_WGT = WS_WTRIL + 131072;
constexpr size_t WS_WGUM = 40 * MiB, WS_WDM = 152 * MiB;
constexpr size_t WS_ABUF = 208 * MiB, WS_MIX = 240 * MiB, WS_XR = 272 * MiB, WS_AMOE = 336 * MiB  , WS_BIG = 404 * MiB;
constexpr size_t WS_P0 = WS_BIG, WS_H = WS_BIG + 48 * MiB;
constexpr size_t WS_P1 = WS_BIG, WS_QR = WS_BIG + 72 * MiB, WS_KVR = WS_BIG + 104 * MiB, WS_QF = WS_BIG + 136 * MiB, WS_KIMG = WS_BIG + 160 * MiB, WS_VIMG = WS_BIG + 184 * MiB;
constexpr size_t WS_HM = WS_BIG;
constexpr size_t WS_END = 660 * MiB;
static_assert(WS_H + (size_t)S * D_FF * 2 <= WS_END && WS_VIMG + 16 * MiB <= WS_END && WS_HM + (size_t)MOE_ROWS * DFE * 2 <= WS_END, "big region");
static_assert(WS_AMOE + (size_t)MOE_ROWS * D * 2 <= WS_BIG && WS_WDM + (size_t)NE * D * DFE * 2 <= WS_ABUF && WS_WGUM + (size_t)NE * 2 * DFE * D * 2 <= WS_WDM, "map");
constexpr int CW_BAR = 4096;
constexpr int CW_CNT = 16384;

constexpr int RING_BYTES = 131072, LDSCTL_OFF = RING_BYTES, MISC_OFF = LDSCTL_OFF + 320, LDS_BYTES = 147456;

#define GAS __attribute__((address_space(1)))
#define LAS __attribute__((address_space(3)))
typedef unsigned short bf16;
typedef unsigned v4u __attribute__((ext_vector_type(4)));
typedef unsigned v2u __attribute__((ext_vector_type(2)));
typedef float f32x4 __attribute__((ext_vector_type(4)));
typedef float f32x16 __attribute__((ext_vector_type(16)));
typedef short bf16x8 __attribute__((ext_vector_type(8)));
typedef short s16x4 __attribute__((ext_vector_type(4)));
typedef GAS unsigned gu32;
#define RLX_AGENT __ATOMIC_RELAXED, __HIP_MEMORY_SCOPE_AGENT
#define LDS_WAIT() asm volatile("s_waitcnt lgkmcnt(0)" ::: "memory")
#define VM_WAIT() asm volatile("s_waitcnt vmcnt(0)" ::: "memory")
__device__ __forceinline__ unsigned f2bf(float f) { unsigned u = __builtin_bit_cast(unsigned, f); return (u + 0x7fffu + ((u >> 16) & 1u)) >> 16; }
__device__ __forceinline__ unsigned pk2(float lo, float hi) { return f2bf(lo) | (f2bf(hi) << 16); }
__device__ __forceinline__ float bflo(unsigned w) { return __builtin_bit_cast(float, w << 16); }
__device__ __forceinline__ float bfhi(unsigned w) { return __builtin_bit_cast(float, w & 0xffff0000u); }
__device__ __forceinline__ float wave_sum(float v) {
#pragma unroll
    for (int o = 1; o < 64; o <<= 1) v += __shfl_xor(v, o);
    return v;
}

#define XB_TMO      128
#define XB_XCNT(j)  (256  + 64 * (j))
#define XB_XSUB(j)  (1280 + 64 * (j))
#define XB_XGEN(j)  (2304 + 64 * (j))
#define XB_TOP      3328
#define XB_TOPGEN   3392
#define XCD_BAR_WORDS 3456
#define XB_SPIN_CAP (1u << 18)
__device__ __forceinline__ unsigned xb_ld(unsigned* p)              { return __hip_atomic_load(p, __ATOMIC_RELAXED, __HIP_MEMORY_SCOPE_AGENT); }
__device__ __forceinline__ unsigned xb_add(unsigned* p, unsigned v) { return __hip_atomic_fetch_add(p, v, __ATOMIC_RELAXED, __HIP_MEMORY_SCOPE_AGENT); }
__device__ __forceinline__ unsigned xb_xcc_id() { return (unsigned)__builtin_amdgcn_s_getreg((3 << 11) | 20) & 0xFu; }
#define XB_SPIN(cond, bar) do { unsigned _sp = 0; while (cond) { __builtin_amdgcn_s_sleep(1); \
    if ((++_sp & 255u) == 0u) { if (xb_ld(&(bar)[XB_TMO])) break; if (_sp > XB_SPIN_CAP) { atomicAdd(&(bar)[XB_TMO], 1u); break; } } } } while (0)
struct XcdBarrier { unsigned* bar; unsigned x; volatile LAS unsigned* st; };
__device__ __forceinline__ XcdBarrier xcd_barrier_post(unsigned* bar, volatile LAS unsigned* st) {
    XcdBarrier b; b.bar = bar; b.x = xb_xcc_id(); b.st = st;
    if (threadIdx.x == 0) (void)xb_add(&bar[XB_XCNT(b.x)], 1u);
    return b;
}
__device__ __forceinline__ void xcd_barrier_complete(unsigned* bar, unsigned x, unsigned& nloc, unsigned& nx) {
    const unsigned G = gridDim.x * gridDim.y * gridDim.z;
    unsigned sum, cnt, mine, sp = 0u;
    for (;;) {
        sum = 0u; cnt = 0u; mine = 0u;
#pragma unroll
        for (unsigned j = 0; j < 16; ++j) { const unsigned c = xb_ld(&bar[XB_XCNT(j)]); sum += c; cnt += (c > 0u) ? 1u : 0u; mine = (j == x) ? c : mine; }
        if (sum == G) break;
        __builtin_amdgcn_s_sleep(1);
        if ((++sp & 255u) == 0u) { if (xb_ld(&bar[XB_TMO])) break; if (sp > XB_SPIN_CAP) { atomicAdd(&bar[XB_TMO], 1u); break; } }
    }
    nloc = mine > 0u ? mine : 1u; nx = cnt > 0u ? cnt : 1u;
}
__device__ __forceinline__ void xcd_barrier(const XcdBarrier& b) {
    asm volatile("s_waitcnt vmcnt(0)" ::: "memory");
    __syncthreads();
    if (threadIdx.x == 0) {
        unsigned* bar = b.bar;
        __builtin_amdgcn_s_waitcnt(0);
        unsigned nloc = b.st[0], nx = b.st[1];
        if (nloc == 0u) { xcd_barrier_complete(bar, b.x, nloc, nx); b.st[0] = nloc; b.st[1] = nx; }
        const unsigned old = xb_add(&bar[XB_XSUB(b.x)], 1u);
        const unsigned gen = old / nloc;
        if (old + 1u == (gen + 1u) * nloc) {
            __builtin_amdgcn_fence(__ATOMIC_RELEASE, "agent");
            asm volatile("s_waitcnt vmcnt(0)" ::: "memory");
            const unsigned og = xb_add(&bar[XB_TOP], 1u);
            const unsigned tg = og / nx;
            if (og + 1u == (tg + 1u) * nx) xb_add(&bar[XB_TOPGEN], 1u);
            else XB_SPIN(xb_ld(&bar[XB_TOPGEN]) == tg, bar);
            __builtin_amdgcn_fence(__ATOMIC_ACQUIRE, "agent");
            xb_add(&bar[XB_XGEN(b.x)], 1u);
            asm volatile("s_waitcnt vmcnt(0)" ::: "memory");
        } else {
            XB_SPIN(xb_ld(&bar[XB_XGEN(b.x)]) == gen, bar);
            __builtin_amdgcn_fence(__ATOMIC_ACQUIRE, "agent");
            asm volatile("s_waitcnt vmcnt(0)" ::: "memory");
        }
    }
    __syncthreads();
}

struct Args { const void* in[29]; float* out; unsigned char* ws; int ph_lo, ph_hi; };
enum { I_X = 0, I_C, I_POS, I_NMW, I_NFW, I_ADAW, I_ADAB, I_EWIN, I_ALNW, I_ALNB, I_AWS, I_ABS, I_BWG, I_BSC, I_EWOUT, I_FGU, I_FDN,
       I_OWIN, I_CONV, I_QAN, I_WUQ, I_KVN, I_WUKV, I_QNW, I_KNW, I_OWOUT, I_RW, I_MGU, I_MDN };
constexpr int OFF_SHM = 0, OFF_SCM = 1024, OFF_GM = 2048, OFF_SHF = 3072, OFF_SCF = 4096, OFF_GF = 5120;

__device__ __forceinline__ void p0_mod(const float* c, const float* ada_w, float* modp, int vcu, int G, int tid) {
    for (int u = vcu; u < 384; u += G) {
        const int layer = u / 192, r = u % 192, ks = r / 12, cb = r % 12, col = cb * 512 + tid;
        const float* w = ada_w + ((size_t)layer * 1024 + ks * 64) * 6144 + col;
        float acc = 0.f;
#pragma unroll 8
        for (int k = 0; k < 64; ++k) { const float cv = c[ks * 64 + k]; const float sv = cv / (1.f + __expf(-cv)); acc += sv * w[(size_t)k * 6144]; }
        modp[(size_t)(layer * 16 + ks) * 6144 + col] = acc;
    }
}
__device__ __forceinline__ void conv_item(const float* src, int ldn, int k0, int n0, const float* kscale, bf16* dst, int ldk, int drow0, LAS float* scr, int lane) {
#pragma unroll
    for (int i = 0; i < 8; ++i) { const int kk = 8 * i + (lane >> 3); f32x4 v = *(const f32x4*)(src + (size_t)(k0 + kk) * ldn + n0 + (lane & 7) * 4);
        if (kscale) v = v * kscale[k0 + kk];
        LAS float* p = scr + kk * 33 + (lane & 7) * 4; p[0] = v.x; p[1] = v.y; p[2] = v.z; p[3] = v.w; }
    LDS_WAIT(); asm volatile("" ::: "memory");
    const int c = lane & 7;
#pragma unroll
    for (int j = 0; j < 4; ++j) { const int nn = (lane >> 3) + 8 * j; const LAS float* s = scr + (8 * c) * 33 + nn;
        v4u o; o.x = pk2(s[0 * 33], s[1 * 33]); o.y = pk2(s[2 * 33], s[3 * 33]); o.z = pk2(s[4 * 33], s[5 * 33]); o.w = pk2(s[6 * 33], s[7 * 33]);
        *(v4u*)(dst + (size_t)(drow0 + nn) * ldk + k0 + 8 * c) = o; }
    LDS_WAIT(); asm volatile("" ::: "memory");
}
__device__ __forceinline__ int gu_row(int n0, int half) { return n0 < half ? (n0 >> 7) * 256 + (n0 & 127) : ((n0 - half) >> 7) * 256 + 128 + ((n0 - half) & 127); }
__device__ __forceinline__ void p0_prologue(const Args& a, LAS unsigned char* lds, int vcu, int G, int tid) {
    unsigned char* ws = a.ws; const int lane = tid & 63, wave = __builtin_amdgcn_readfirstlane(tid >> 6);
    p0_mod((const float*)a.in[I_C], (const float*)a.in[I_ADAW], (float*)(ws + WS_MODP), vcu, G, tid);
    const int gt = vcu * NTHR + tid, NGT = G * NTHR;
    { const int* pos = (const int*)a.in[I_POS]; float* cosT = (float*)(ws + WS_ROPE); float* sinT = cosT + (size_t)S * 32;
      for (int i = gt; i < S * 32; i += NGT) { const int t = i >> 5, f = i & 31; const float inv = (float)exp(-(double)f * (9.210340371976184 / 32.0));
          const float ang = (float)pos[t] * inv; const double ad = (double)ang;
          const double k = __builtin_rint(ad * 0.15915494309189535); const double r = __builtin_fma(-k, 6.283185307179586, ad) - k * 2.4492935982947064e-16;
          cosT[i] = cosf((float)r); sinT[i] = sinf((float)r); } }
    { const float* aws = (const float*)a.in[I_AWS]; bf16* wt = (bf16*)(ws + WS_WTRIL);
      for (int i = gt; i < 4 * 128 * 128 / 2; i += NGT) { const int e = 2 * i, s = e & 127, t = (e >> 7) & 127; const float v0 = s <= t ? aws[e] : 0.f, v1 = (s + 1) <= t ? aws[e + 1] : 0.f; ((unsigned*)wt)[i] = pk2(v0, v1); } }
    { v4u z = {0u, 0u, 0u, 0u}; v4u* p1 = (v4u*)(ws + WS_WIN1 + (size_t)O_IN * 1024 * 2);
      for (int i = gt; i < (O_INP - O_IN) * 1024 * 2 / 16; i += NGT) p1[i] = z;
      for (int i = gt; i < 4 * 64 * 256 * 2 / 16; i += NGT) { const int h = i / (64 * 32), r = i % (64 * 32); ((v4u*)(ws + WS_WUQ + (size_t)(h * 256 + 192) * 256 * 2))[r] = z; } }
    LAS float* scr = (LAS float*)(lds + wave * 16384);
    const int gw = vcu * NWAVES + wave, NGW = G * NWAVES;
    constexpr int I0 = 16 * 48, I1 = 16 * 32, I2 = 16 * 176, I3 = 44 * 32, I4 = 16 * 66, I5 = 4 * 24, I6 = 4 * 32, I7 = 16 * 32, I8 = 4 * 8, I9 = 8 * 16 * 224, I10 = 8 * 56 * 32;
    constexpr int NITEMS = I0 + I1 + I2 + I3 + I4 + I5 + I6 + I7 + I8 + I9 + I10;
    for (int it = gw; it < NITEMS; it += NGW) {
        int r = it;
        if (r < I9) { const int e = r / (16 * 224), q = r % (16 * 224), kb = q / 224, nb = q % 224;
            conv_item((const float*)a.in[I_MGU] + (size_t)e * 1024 * 7168, 7168, kb * 64, nb * 32, nullptr, (bf16*)(ws + WS_WGUM) + (size_t)e * 7168 * 1024, 1024, gu_row(nb * 32, DFE), scr, lane); continue; } r -= I9;
        if (r < I10) { const int e = r / (56 * 32), q = r % (56 * 32), kb = q / 32, nb = q % 32;
            conv_item((const float*)a.in[I_MDN] + (size_t)e * DFE * 1024, 1024, kb * 64, nb * 32, nullptr, (bf16*)(ws + WS_WDM) + (size_t)e * 1024 * DFE, DFE, nb * 32, scr, lane); continue; } r -= I10;
        if (r < I0) { conv_item((const float*)a.in[I_EWIN], E_IN, (r / 48) * 64, (r % 48) * 32, nullptr, (bf16*)(ws + WS_WIN0), 1024, (r % 48) * 32, scr, lane); continue; } r -= I0;
        if (r < I1) { conv_item((const float*)a.in[I_EWOUT], 1024, (r / 32) * 64, (r % 32) * 32, nullptr, (bf16*)(ws + WS_WOUT0), 1024, (r % 32) * 32, scr, lane); continue; } r -= I1;
        if (r < I2) { conv_item((const float*)a.in[I_FGU], 2 * D_FF, (r / 176) * 64, (r % 176) * 32, nullptr, (bf16*)(ws + WS_WGU0), 1024, gu_row((r % 176) * 32, D_FF), scr, lane); continue; } r -= I2;
        if (r < I3) { conv_item((const float*)a.in[I_FDN], 1024, (r / 32) * 64, (r % 32) * 32, nullptr, (bf16*)(ws + WS_WD0), D_FF, (r % 32) * 32, scr, lane); continue; } r -= I3;
        if (r < I4) { conv_item((const float*)a.in[I_OWIN], O_IN, (r / 66) * 64, (r % 66) * 32, nullptr, (bf16*)(ws + WS_WIN1), 1024, (r % 66) * 32, scr, lane); continue; } r -= I4;
        if (r < I5) { const int n0 = (r % 24) * 32; conv_item((const float*)a.in[I_WUQ], 768, (r / 24) * 64, n0, (const float*)a.in[I_QAN], (bf16*)(ws + WS_WUQ), 256, (n0 / 192) * 256 + n0 % 192, scr, lane); continue; } r -= I5;
        if (r < I6) { conv_item((const float*)a.in[I_WUKV], 1024, (r / 32) * 64, (r % 32) * 32, (const float*)a.in[I_KVN], (bf16*)(ws + WS_WUKV), 256, (r % 32) * 32, scr, lane); continue; } r -= I6;
        if (r < I7) { conv_item((const float*)a.in[I_OWOUT], 1024, (r / 32) * 64, (r % 32) * 32, nullptr, (bf16*)(ws + WS_WOUT1), 1024, (r % 32) * 32, scr, lane); continue; } r -= I7;
        { const int g = r / 8, q = r % 8; conv_item((const float*)a.in[I_BWG] + (size_t)g * 16384, 128, (q / 4) * 64, (q % 4) * 32, nullptr, (bf16*)(ws + WS_WGT) + (size_t)g * 16384, 128, (q % 4) * 32, scr, lane); }
    }
}

__device__ __forceinline__ float modv_partial(const float* modp, const float* ada_b, int layer, int idx) {
    float s = ada_b[layer * 6144 + idx];
#pragma unroll
    for (int ks = 0; ks < 16; ++ks) s += modp[(size_t)(layer * 16 + ks) * 6144 + idx];
    return s;
}
template <bool PARTIAL>
__device__ __forceinline__ void norm_phase(const Args& a, const float* xin, bf16* out, const float* nw, int layer, int off_sh, int off_sc, int gw, int NGW, int lane) {
    const float* modp = (const float*)(a.ws + WS_MODP); const float* modF = (const float*)(a.ws + WS_MODF); const float* ada_b = (const float*)a.in[I_ADAB];
    f32x4 g[4], sh[4];
#pragma unroll
    for (int j = 0; j < 4; ++j)
#pragma unroll
        for (int e = 0; e < 4; ++e) { const int col = 4 * lane + e + 256 * j; float scv, shv;
            if (PARTIAL) { scv = modv_partial(modp, ada_b, layer, off_sc + col); shv = modv_partial(modp, ada_b, layer, off_sh + col); }
            else { scv = modF[layer * 6144 + off_sc + col]; shv = modF[layer * 6144 + off_sh + col]; }
            g[j][e] = nw[col] * (1.f + scv); sh[j][e] = shv; }
    for (int m = gw; m < S; m += NGW) {
        const f32x4* xr = (const f32x4*)(xin + (size_t)m * D) + lane;
        f32x4 v[4]; float s = 0.f;
#pragma unroll
        for (int j = 0; j < 4; ++j) { v[j] = xr[64 * j]; s += (v[j].x * v[j].x + v[j].y * v[j].y) + (v[j].z * v[j].z + v[j].w * v[j].w); }
        const float rstd = 1.f / sqrtf(wave_sum(s) * (1.f / D) + EPS);
        unsigned long long* o8 = (unsigned long long*)(out + (size_t)m * D) + lane;
#pragma unroll
        for (int j = 0; j < 4; ++j) { const f32x4 y = v[j] * rstd * g[j] + sh[j]; o8[64 * j] = (unsigned long long)pk2(y.x, y.y) | ((unsigned long long)pk2(y.z, y.w) << 32); }
    }
}

__device__ __forceinline__ void mixab_phase(const Args& a, LAS unsigned char* lds, int vcu, int G, int tid) {
    const bf16* P0 = (const bf16*)(a.ws + WS_P0); bf16* MIX = (bf16*)(a.ws + WS_MIX);
    const bf16* Wtril = (const bf16*)(a.ws + WS_WTRIL); const bf16* wgT = (const bf16*)(a.ws + WS_WGT);
    const float* ln_w = (const float*)a.in[I_ALNW]; const float* ln_b = (const float*)a.in[I_ALNB]; const float* b_s = (const float*)a.in[I_ABS]; const float* b_sc = (const float*)a.in[I_BSC];
    const int lane = tid & 63, wave = __builtin_amdgcn_readfirstlane(tid >> 6), fr = lane & 15, fq = lane >> 4;
    LAS bf16* vnT = (LAS bf16*)lds;
    LAS bf16* poolS = (LAS bf16*)(lds + 34816);
    LAS bf16* ppS = (LAS bf16*)(lds + 69632);
    LAS float* stat = (LAS float*)(lds + 69632 + 39168);
    for (int u = vcu; u < 512; u += G) {
        const int n = u >> 2, g = u & 3, t0 = n * 128;
        for (int rr = 0; rr < 16; ++rr) { const int row = wave * 16 + rr;
            const v4u raw = *(const v4u*)(P0 + (size_t)(t0 + row) * E_IN + 512 + lane * 8);
            float x[8] = {bflo(raw.x), bfhi(raw.x), bflo(raw.y), bfhi(raw.y), bflo(raw.z), bfhi(raw.z), bflo(raw.w), bfhi(raw.w)};
            float s = 0.f;
#pragma unroll
            for (int j = 0; j < 8; ++j) s += x[j];
            const float mu = wave_sum(s) * (1.f / 512.f); float q = 0.f;
#pragma unroll
            for (int j = 0; j < 8; ++j) { const float d = x[j] - mu; q += d * d; }
            const float rstd = 1.f / sqrtf(wave_sum(q) * (1.f / 512.f) + EPS);
            if (lane == 0) { stat[row * 2] = mu; stat[row * 2 + 1] = rstd; } }
        for (int i = tid; i < 144 * 16; i += NTHR) { const int r = i >> 4, c8 = i & 15, t = t0 - 16 + r; v4u v = {0u, 0u, 0u, 0u};
            if (t >= 0) v = *(const v4u*)(P0 + (size_t)t * E_IN + 1024 + g * 128 + c8 * 8);
            *(LAS v4u*)(ppS + r * 136 + c8 * 8) = v; }
        __syncthreads();
        { const int s = tid & 127, dq = tid >> 7; const float mu = stat[s * 2], rstd = stat[s * 2 + 1];
#pragma unroll
          for (int cc = 0; cc < 4; ++cc) { const int d0 = dq * 32 + cc * 8; const v4u raw = *(const v4u*)(P0 + (size_t)(t0 + s) * E_IN + 512 + g * 128 + d0);
              float x[8] = {bflo(raw.x), bfhi(raw.x), bflo(raw.y), bfhi(raw.y), bflo(raw.z), bfhi(raw.z), bflo(raw.w), bfhi(raw.w)};
#pragma unroll
              for (int j = 0; j < 8; ++j) { const int ch = g * 128 + d0 + j; vnT[(d0 + j) * 136 + s] = (bf16)f2bf((x[j] - mu) * rstd * ln_w[ch] + ln_b[ch]); } } }
        { const int t = tid & 127, q4 = tid >> 7, w = 2 << g, tg = t0 + t; const float inv = 1.f / (float)((tg + 1) < w ? (tg + 1) : w);
#pragma unroll
          for (int cc = 0; cc < 4; ++cc) { const int ch = q4 * 32 + cc * 8; float acc[8] = {0.f, 0.f, 0.f, 0.f, 0.f, 0.f, 0.f, 0.f};
              for (int j = 0; j < w; ++j) { const v4u r = *(const LAS v4u*)(ppS + (16 + t - j) * 136 + ch);
                  acc[0] += bflo(r.x); acc[1] += bfhi(r.x); acc[2] += bflo(r.y); acc[3] += bfhi(r.y); acc[4] += bflo(r.z); acc[5] += bfhi(r.z); acc[6] += bflo(r.w); acc[7] += bfhi(r.w); }
              const v4u c0 = *(const LAS v4u*)(ppS + (16 + t) * 136 + ch);
              v4u o; o.x = pk2(acc[0] * inv - bflo(c0.x), acc[1] * inv - bfhi(c0.x)); o.y = pk2(acc[2] * inv - bflo(c0.y), acc[3] * inv - bfhi(c0.y));
              o.z = pk2(acc[4] * inv - bflo(c0.z), acc[5] * inv - bfhi(c0.z)); o.w = pk2(acc[6] * inv - bflo(c0.w), acc[7] * inv - bfhi(c0.w));
              *(LAS v4u*)(poolS + t * 136 + ch) = o; } }
        __syncthreads();
        const int m0 = wave * 16, trow = t0 + m0 + fr;
        f32x4 acc[8];
#pragma unroll
        for (int nb = 0; nb < 8; ++nb) acc[nb] = (f32x4){0.f, 0.f, 0.f, 0.f};
#pragma unroll
        for (int kk = 0; kk < 4; ++kk) { const bf16x8 af = *(const bf16x8*)(Wtril + ((size_t)g * 128 + m0 + fr) * 128 + kk * 32 + fq * 8);
#pragma unroll
            for (int nb = 0; nb < 8; ++nb) { const bf16x8 bfr = *(const LAS bf16x8*)(vnT + (nb * 16 + fr) * 136 + kk * 32 + fq * 8); acc[nb] = __builtin_amdgcn_mfma_f32_16x16x32_bf16(bfr, af, acc[nb], 0, 0, 0); } }
        { const float bias = b_s[g * 128 + m0 + fr];
#pragma unroll
          for (int nb = 0; nb < 8; ++nb) { const int col = g * 128 + nb * 16 + 4 * fq; const v2u uv = *(const v2u*)(P0 + (size_t)trow * E_IN + col);
              v2u o; o.x = pk2(bflo(uv.x) * (acc[nb][0] + bias), bfhi(uv.x) * (acc[nb][1] + bias)); o.y = pk2(bflo(uv.y) * (acc[nb][2] + bias), bfhi(uv.y) * (acc[nb][3] + bias));
              *(v2u*)(MIX + (size_t)trow * D + col) = o; } }
#pragma unroll
        for (int nb = 0; nb < 8; ++nb) acc[nb] = (f32x4){0.f, 0.f, 0.f, 0.f};
#pragma unroll
        for (int kk = 0; kk < 4; ++kk) { const bf16x8 af = *(const LAS bf16x8*)(poolS + (m0 + fr) * 136 + kk * 32 + fq * 8);
#pragma unroll
            for (int nb = 0; nb < 8; ++nb) { const bf16x8 bfr = *(const bf16x8*)(wgT + ((size_t)g * 128 + nb * 16 + fr) * 128 + kk * 32 + fq * 8); acc[nb] = __builtin_amdgcn_mfma_f32_16x16x32_bf16(bfr, af, acc[nb], 0, 0, 0); } }
#pragma unroll
        for (int nb = 0; nb < 8; ++nb) { const int e = g * 128 + nb * 16 + 4 * fq; const f32x4 sc = *(const f32x4*)(b_sc + e);
            v2u o; o.x = pk2(acc[nb][0] * sc.x, acc[nb][1] * sc.y); o.y = pk2(acc[nb][2] * sc.z, acc[nb][3] * sc.w);
            *(v2u*)(MIX + (size_t)trow * D + 512 + e) = o; }
        __syncthreads();
    }
}

namespace att {
constexpr int KSLOT = 24576, VSLOT = 16384, LDS_K = 0, LDS_V = 2 * KSLOT, LDS_WS = LDS_V + 2 * VSLOT;
constexpr float SCALE = 0.07216878364870323f;
constexpr float THR = 8.f;
__device__ __forceinline__ int k_nope_off(int row, int colB) { return row * 256 + (colB ^ ((row & 7) << 4)); }
__device__ __forceinline__ int k_rope_off(int row, int cB) { return 16384 + row * 128 + (cB ^ (((row >> 1) & 7) << 4)); }
__device__ __forceinline__ int v_st(int k, int c) { const int kk = (k & ~0xC) | ((k & 4) << 1) | ((k & 8) >> 1); return ((kk >> 3) * 4 + (c >> 5)) * 512 + ((kk & 7) * 32 + (c & 31)) * 2; }
__device__ __forceinline__ int v_rd_base(int lane) { return ((lane & 3) << 3) | (((lane >> 2) & 3) << 6) | (((lane >> 4) & 1) << 5) | (((lane >> 5) & 1) << 8); }
constexpr int v_rd_off(int d0, int ks, int half) { return d0 * 512 + ks * 4096 + half * 2048; }
__device__ __forceinline__ int crow(int r, int hi) { return (r & 3) + 8 * (r >> 2) + 4 * hi; }
__device__ __forceinline__ unsigned cvtpk(float lo, float hi) { unsigned r; asm volatile("v_cvt_pk_bf16_f32 %0, %1, %2" : "=v"(r) : "v"(lo), "v"(hi)); return r; }
#define SBAR() __builtin_amdgcn_sched_barrier(0)
__device__ __forceinline__ void mask_tile(f32x16& p0, f32x16& p1, int dq) {
    const float NEG = -__builtin_inff();
#pragma unroll
    for (int r = 0; r < 16; ++r) { const int c = (r & 3) + 8 * (r >> 2); if (dq - c < 0) p0[r] = NEG; if (dq - c - 32 < 0) p1[r] = NEG; }
}
__device__ __forceinline__ void partialSM(f32x16& p0, f32x16& p1, float& m_reg, float& mn, float& alpha) {
    float pmax = p0[0];
#pragma unroll
    for (int r = 1; r < 16; ++r) pmax = fmaxf(pmax, p0[r]);
#pragma unroll
    for (int r = 0; r < 16; ++r) pmax = fmaxf(pmax, p1[r]);
    { auto rr = __builtin_amdgcn_permlane32_swap(__float_as_uint(pmax), __float_as_uint(pmax), false, false); pmax = fmaxf(__uint_as_float(rr[0]), __uint_as_float(rr[1])); }
    constexpr float C2 = 1.4426950408889634f * SCALE;
    if (__builtin_expect(__all((pmax - m_reg) * SCALE <= THR), 1)) { mn = m_reg; alpha = 1.f; }
    else { mn = fmaxf(m_reg, pmax); alpha = __builtin_amdgcn_exp2f((m_reg - mn) * C2); m_reg = mn; }
    const float mnL = -mn * C2;
#pragma unroll
    for (int r = 0; r < 16; ++r) p0[r] = fmaf(p0[r], C2, mnL);
#pragma unroll
    for (int r = 0; r < 16; ++r) p1[r] = fmaf(p1[r], C2, mnL);
#pragma unroll
    for (int r = 0; r < 16; ++r) p0[r] = __builtin_amdgcn_exp2f(p0[r]);
}
__device__ __forceinline__ void finishSM(f32x16& p0, f32x16& p1, float alpha, float& l_reg, bf16x8& pa0, bf16x8& pa1, bf16x8& pa2, bf16x8& pa3) {
#pragma unroll
    for (int r = 0; r < 16; ++r) p1[r] = __builtin_amdgcn_exp2f(p1[r]);
    float ps = 0;
#pragma unroll
    for (int r = 0; r < 16; ++r) ps += p0[r];
#pragma unroll
    for (int r = 0; r < 16; ++r) ps += p1[r];
    { auto rr = __builtin_amdgcn_permlane32_swap(__float_as_uint(ps), __float_as_uint(ps), false, false); ps = __uint_as_float(rr[0]) + __uint_as_float(rr[1]); }
    l_reg = l_reg * alpha + ps;
#define PK4(P, B_, OUT) do { unsigned a0 = cvtpk(P[B_+0], P[B_+1]), a1 = cvtpk(P[B_+2], P[B_+3]);                          \
        unsigned b0 = cvtpk(P[B_+4], P[B_+5]), b1 = cvtpk(P[B_+6], P[B_+7]);                                             \
        auto r0 = __builtin_amdgcn_permlane32_swap(a0, b0, false, false); auto r1 = __builtin_amdgcn_permlane32_swap(a1, b1, false, false); \
        v4u w = {r0[0], r1[0], r0[1], r1[1]}; OUT = __builtin_bit_cast(bf16x8, w); } while (0)
    PK4(p0, 0, pa0); PK4(p0, 8, pa1); PK4(p1, 0, pa2); PK4(p1, 8, pa3);
#undef PK4
}
template <int KB>
__device__ __forceinline__ void qkt(f32x16& p0, f32x16& p1, const LAS char* Kl, int r32, int hi, const bf16x8* qr) {
    p0 = f32x16{}; p1 = f32x16{};
    const LAS char* kb[4];
#pragma unroll
    for (int dd = 0; dd < 4; ++dd) kb[dd] = Kl + KB * KSLOT + k_nope_off(r32, (dd * 16 + hi * 8) * 2);
#pragma unroll
    for (int d0 = 0; d0 < 8; ++d0) { const LAS char* ap = kb[d0 & 3] + (d0 >> 2) * 128;
        const bf16x8 b0 = *(const LAS bf16x8*)ap; const bf16x8 b1 = *(const LAS bf16x8*)(ap + 32 * 256);
        p0 = __builtin_amdgcn_mfma_f32_32x32x16_bf16(b0, qr[d0], p0, 0, 0, 0);
        p1 = __builtin_amdgcn_mfma_f32_32x32x16_bf16(b1, qr[d0], p1, 0, 0, 0); }
#pragma unroll
    for (int dr = 0; dr < 4; ++dr) { const LAS char* ap = Kl + KB * KSLOT + k_rope_off(r32, dr * 32 + hi * 16);
        const bf16x8 b0 = *(const LAS bf16x8*)ap; const bf16x8 b1 = *(const LAS bf16x8*)(ap + 32 * 128);
        p0 = __builtin_amdgcn_mfma_f32_32x32x16_bf16(b0, qr[8 + dr], p0, 0, 0, 0);
        p1 = __builtin_amdgcn_mfma_f32_32x32x16_bf16(b1, qr[8 + dr], p1, 0, 0, 0); }
}
template <int VB>
__device__ __forceinline__ void pv_tile(f32x16* o, int vb0, bf16x8 pa0, bf16x8 pa1, bf16x8 pa2, bf16x8 pa3) {
#define TRRD(dst, off) asm volatile("ds_read_b64_tr_b16 %0, %1 offset:%2" : "=&v"(dst) : "v"(vb0), "i"(off) : "memory")
#define PV_D0(d0) do { s16x4 l0, l1, l2, l3, h0, h1, h2, h3; constexpr int b_ = VB * VSLOT + v_rd_off(d0, 0, 0); \
        TRRD(l0, b_); TRRD(h0, b_ + 2048); TRRD(l1, b_ + 4096); TRRD(h1, b_ + 6144); TRRD(l2, b_ + 8192); TRRD(h2, b_ + 10240); TRRD(l3, b_ + 12288); TRRD(h3, b_ + 14336); \
        asm volatile("s_waitcnt lgkmcnt(0)" ::: "memory"); SBAR(); \
        o[d0] = __builtin_amdgcn_mfma_f32_32x32x16_bf16(pa0, (bf16x8){l0[0], l0[1], l0[2], l0[3], h0[0], h0[1], h0[2], h0[3]}, o[d0], 0, 0, 0);   \
        o[d0] = __builtin_amdgcn_mfma_f32_32x32x16_bf16(pa1, (bf16x8){l1[0], l1[1], l1[2], l1[3], h1[0], h1[1], h1[2], h1[3]}, o[d0], 0, 0, 0);   \
        o[d0] = __builtin_amdgcn_mfma_f32_32x32x16_bf16(pa2, (bf16x8){l2[0], l2[1], l2[2], l2[3], h2[0], h2[1], h2[2], h2[3]}, o[d0], 0, 0, 0);   \
        o[d0] = __builtin_amdgcn_mfma_f32_32x32x16_bf16(pa3, (bf16x8){l3[0], l3[1], l3[2], l3[3], h3[0], h3[1], h3[2], h3[3]}, o[d0], 0, 0, 0); } while (0)
    PV_D0(0); PV_D0(1); PV_D0(2); PV_D0(3);
#undef PV_D0
#undef TRRD
}
__device__ __forceinline__ void glds16(const void* gsrc, unsigned lds_dst) { unsigned keep;
    asm volatile("s_mov_b32 %0, m0\n\ts_mov_b32 m0, %2\n\ts_nop 0\n\tglobal_load_lds_dwordx4 %1, off\n\ts_mov_b32 m0, %0" : "=&s"(keep) : "v"(gsrc), "s"(lds_dst) : "memory"); }
#define WAITBAR0() asm volatile("s_waitcnt vmcnt(0) lgkmcnt(0)\n\ts_barrier" ::: "memory")

__device__ __forceinline__ void attn_block(int h, int qb, const bf16* QF, const unsigned char* KIMG, const unsigned char* VIMG, bf16* MIX, char* lds) {
    const int tid = threadIdx.x, wid = __builtin_amdgcn_readfirstlane(tid >> 6), lane = tid & 63, r32 = lane & 31, hi = lane >> 5;
    const int NT = 4 * (qb + 1), q0 = qb * 256, qlo = q0 + wid * 32, qm = qlo + r32 - 4 * hi;
    const unsigned lds0 = (unsigned)(uintptr_t)lds;
    const LAS char* Kl = (const LAS char*)lds + LDS_K;
    LAS float* wsf = (LAS float*)((LAS char*)lds + LDS_WS) + wid * 64; LAS float* li_l = wsf; LAS float* al_l = wsf + 32;
    const int vb0 = (int)(lds0 + LDS_V) + v_rd_base(lane);
    const unsigned char* kimg = KIMG + (size_t)h * 256 * KSLOT + (size_t)(3 * wid) * 1024 + lane * 16;
    const unsigned char* vimg = VIMG + (size_t)h * 256 * VSLOT + (size_t)(2 * wid) * 1024 + lane * 16;
    const unsigned kdst = lds0 + LDS_K + (3 * wid) * 1024, vdst = lds0 + LDS_V + (2 * wid) * 1024;
#define DMA_K(t, slot) do { const unsigned char* s_ = kimg + (size_t)(t) * KSLOT; const unsigned d_ = (unsigned)__builtin_amdgcn_readfirstlane(kdst + (slot) * KSLOT); \
        glds16(s_, d_); glds16(s_ + 1024, d_ + 1024); glds16(s_ + 2048, d_ + 2048); } while (0)
#define DMA_V(t, slot) do { const unsigned char* s_ = vimg + (size_t)(t) * VSLOT; const unsigned d_ = (unsigned)__builtin_amdgcn_readfirstlane(vdst + (slot) * VSLOT); \
        glds16(s_, d_); glds16(s_ + 1024, d_ + 1024); } while (0)
    DMA_K(0, 0);
    bf16x8 qr[12];
    { const bf16* qp = QF + ((size_t)h * S + q0 + wid * 32 + r32) * 192 + hi * 8;
#pragma unroll
      for (int d0 = 0; d0 < 12; ++d0) qr[d0] = *(const bf16x8*)(qp + d0 * 16); }
    float m_reg = -1e30f, l_reg = 0.f; f32x16 o[4]; o[0] = f32x16{}; o[1] = f32x16{}; o[2] = f32x16{}; o[3] = f32x16{};
    f32x16 pA0, pA1, pB0, pB1; float mnA, mnB, alA = 1.f, alB = 1.f; bf16x8 pa0, pa1, pa2, pa3;
#define RESC(a_) do { if (__any((a_) < 1.f)) { if (hi == 0) al_l[r32] = (a_); asm volatile("s_waitcnt lgkmcnt(0)" ::: "memory"); \
        _Pragma("unroll") for (int d_ = 0; d_ < 4; ++d_) _Pragma("unroll") for (int r = 0; r < 16; ++r) o[d_][r] *= al_l[crow(r, hi)]; } } while (0)
#define MASKT(P0_, P1_, t) do { const int kb_ = (t) * 64; if (kb_ + 63 > qlo) mask_tile(P0_, P1_, qm - kb_); } while (0)
    WAITBAR0();
    DMA_K(1, 1); DMA_V(0, 0);
    SBAR(); qkt<0>(pA0, pA1, Kl, r32, hi, qr); MASKT(pA0, pA1, 0); partialSM(pA0, pA1, m_reg, mnA, alA);
#define STEP(PX0, PX1, mnX, alX, PY0, PY1, alY, t, KB, VB) do { \
        WAITBAR0(); \
        if ((t) + 1 < NT) DMA_K((t) + 1, (KB) ^ 1); DMA_V((t), (VB) ^ 1); \
        SBAR(); qkt<KB>(PX0, PX1, Kl, r32, hi, qr); \
        finishSM(PY0, PY1, alY, l_reg, pa0, pa1, pa2, pa3); SBAR(); \
        pv_tile<VB>(o, vb0, pa0, pa1, pa2, pa3); MASKT(PX0, PX1, (t)); partialSM(PX0, PX1, m_reg, mnX, alX); \
        RESC(alX); } while (0)
    int t = 1;
    for (; t + 1 < NT; t += 2) {
        STEP(pB0, pB1, mnB, alB, pA0, pA1, alA, t, 1, 0);
        STEP(pA0, pA1, mnA, alA, pB0, pB1, alB, t + 1, 0, 1);
    }
    STEP(pB0, pB1, mnB, alB, pA0, pA1, alA, NT - 1, 1, 0);
    WAITBAR0();
    finishSM(pB0, pB1, alB, l_reg, pa0, pa1, pa2, pa3); SBAR();
    pv_tile<1>(o, vb0, pa0, pa1, pa2, pa3);
    if (hi == 0) li_l[r32] = l_reg; asm volatile("s_waitcnt lgkmcnt(0)" ::: "memory");
    float rli[16];
#pragma unroll
    for (int r = 0; r < 16; ++r) rli[r] = __builtin_amdgcn_rcpf(li_l[crow(r, hi)]);
    bf16* Ow = MIX + (size_t)(q0 + wid * 32) * D + 512 + h * 128;
#pragma unroll
    for (int r = 0; r < 16; ++r) { const int orow = crow(r, hi);
#pragma unroll
        for (int d0 = 0; d0 < 4; ++d0) { const float v = o[d0][r] * rli[r]; const float vn = __shfl_xor(v, 1);
            if ((r32 & 1) == 0) *(unsigned*)(Ow + (size_t)orow * D + d0 * 32 + r32) = cvtpk(v, vn); } }
    asm volatile("s_waitcnt lgkmcnt(0)\n\ts_barrier" ::: "memory");
#undef DMA_K
#undef DMA_V
#undef RESC
#undef MASKT
#undef STEP
}
}

__device__ __forceinline__ void fin_phase(const Args& a, int gw, int NGW, int lane) {
    unsigned char* ws = a.ws;
    const bf16* P1 = (const bf16*)(ws + WS_P1); const bf16* QR = (const bf16*)(ws + WS_QR); const bf16* KVR = (const bf16*)(ws + WS_KVR);
    bf16* QF = (bf16*)(ws + WS_QF); unsigned char* KIMG = ws + WS_KIMG; unsigned char* VIMG = ws + WS_VIMG; bf16* MIX = (bf16*)(ws + WS_MIX);
    const float* cosT = (const float*)(ws + WS_ROPE); const float* sinT = cosT + (size_t)S * 32;
    const float* qnw = (const float*)a.in[I_QNW]; const float* knw = (const float*)a.in[I_KNW]; const float* cw = (const float*)a.in[I_CONV];
    const int hl = lane & 15, h = lane >> 4, c4 = lane & 3;
    float wq[16], wk[16], wkr[16];
#pragma unroll
    for (int e = 0; e < 16; ++e) { wq[e] = hl < 12 ? qnw[hl * 16 + e] : 0.f; wk[e] = hl < 8 ? knw[hl * 16 + e] : 0.f; wkr[e] = knw[128 + c4 * 16 + e]; }
    float cw0[8], cw1[8], cw2[8];
#pragma unroll
    for (int e = 0; e < 8; ++e) { cw0[e] = cw[lane * 8 + e]; cw1[e] = cw[512 + lane * 8 + e]; cw2[e] = cw[1024 + lane * 8 + e]; }
    for (int t = gw; t < S; t += NGW) {
        const bf16* prow = P1 + (size_t)t * O_INP;
        float s_q, s_kv;
        { const v2u r = *(const v2u*)(prow + 1536 + lane * 4); const float x0 = bflo(r.x), x1 = bfhi(r.x), x2 = bflo(r.y), x3 = bfhi(r.y);
          s_q = 1.f / sqrtf(wave_sum((x0 * x0 + x1 * x1) + (x2 * x2 + x3 * x3)) * (1.f / 256.f) + EPS); }
        { const v2u r = *(const v2u*)(prow + 1792 + lane * 4); const float x0 = bflo(r.x), x1 = bfhi(r.x), x2 = bflo(r.y), x3 = bfhi(r.y);
          s_kv = 1.f / sqrtf(wave_sum((x0 * x0 + x1 * x1) + (x2 * x2 + x3 * x3)) * (1.f / 256.f) + EPS); }
        const int fi = (hl & 1) * 16;
        float cs[16], sn[16];
        { const f32x4* cp = (const f32x4*)(cosT + (size_t)t * 32 + fi); const f32x4* sp = (const f32x4*)(sinT + (size_t)t * 32 + fi);
#pragma unroll
          for (int q = 0; q < 4; ++q) { const f32x4 c_ = cp[q], s_ = sp[q]; cs[4 * q] = c_.x; cs[4 * q + 1] = c_.y; cs[4 * q + 2] = c_.z; cs[4 * q + 3] = c_.w; sn[4 * q] = s_.x; sn[4 * q + 1] = s_.y; sn[4 * q + 2] = s_.z; sn[4 * q + 3] = s_.w; } }
        { const v4u r0 = *(const v4u*)(QR + (size_t)t * 1024 + lane * 16), r1 = *(const v4u*)(QR + (size_t)t * 1024 + lane * 16 + 8);
          float x[16] = {bflo(r0.x), bfhi(r0.x), bflo(r0.y), bfhi(r0.y), bflo(r0.z), bfhi(r0.z), bflo(r0.w), bfhi(r0.w), bflo(r1.x), bfhi(r1.x), bflo(r1.y), bfhi(r1.y), bflo(r1.z), bfhi(r1.z), bflo(r1.w), bfhi(r1.w)};
          float ss = 0.f;
#pragma unroll
          for (int e = 0; e < 16; ++e) { x[e] *= s_q; ss += x[e] * x[e]; }
          ss += __shfl_xor(ss, 1); ss += __shfl_xor(ss, 2); ss += __shfl_xor(ss, 4); ss += __shfl_xor(ss, 8);
          const float rq = 1.f / sqrtf(ss * (1.f / 192.f) + EPS);
          float y[16];
#pragma unroll
          for (int e = 0; e < 16; ++e) { const float v = x[e] * rq * wq[e]; const float pr = __shfl_xor(v, 2);
              y[e] = hl < 8 ? v : (hl < 10 ? v * cs[e] - pr * sn[e] : v * cs[e] + pr * sn[e]); }
          if (hl < 12) { v4u o0, o1; o0.x = pk2(y[0], y[1]); o0.y = pk2(y[2], y[3]); o0.z = pk2(y[4], y[5]); o0.w = pk2(y[6], y[7]); o1.x = pk2(y[8], y[9]); o1.y = pk2(y[10], y[11]); o1.z = pk2(y[12], y[13]); o1.w = pk2(y[14], y[15]);
              bf16* qd = QF + ((size_t)h * S + t) * 192 + hl * 16; *(v4u*)qd = o0; *(v4u*)(qd + 8) = o1; } }
        { const v4u r0 = *(const v4u*)(KVR + (size_t)t * 1024 + lane * 16), r1 = *(const v4u*)(KVR + (size_t)t * 1024 + lane * 16 + 8);
          float x[16] = {bflo(r0.x), bfhi(r0.x), bflo(r0.y), bfhi(r0.y), bflo(r0.z), bfhi(r0.z), bflo(r0.w), bfhi(r0.w), bflo(r1.x), bfhi(r1.x), bflo(r1.y), bfhi(r1.y), bflo(r1.z), bfhi(r1.z), bflo(r1.w), bfhi(r1.w)};
          const v4u p0 = *(const v4u*)(prow + 2048 + c4 * 16), p1 = *(const v4u*)(prow + 2048 + c4 * 16 + 8);
          float kp[16] = {bflo(p0.x), bfhi(p0.x), bflo(p0.y), bfhi(p0.y), bflo(p0.z), bfhi(p0.z), bflo(p0.w), bfhi(p0.w), bflo(p1.x), bfhi(p1.x), bflo(p1.y), bfhi(p1.y), bflo(p1.z), bfhi(p1.z), bflo(p1.w), bfhi(p1.w)};
          float ssk = 0.f, ssp = 0.f;
#pragma unroll
          for (int e = 0; e < 16; ++e) { x[e] *= s_kv; ssk += x[e] * x[e]; ssp += kp[e] * kp[e]; }
          if (hl >= 8) ssk = 0.f;
          ssk += __shfl_xor(ssk, 1); ssk += __shfl_xor(ssk, 2); ssk += __shfl_xor(ssk, 4); ssk += __shfl_xor(ssk, 8);
          ssp += __shfl_xor(ssp, 1); ssp += __shfl_xor(ssp, 2);
          const float rk = 1.f / sqrtf((ssk + ssp) * (1.f / 192.f) + EPS);
          const int krow = t & 63, tile = t >> 6;
          unsigned char* kt = KIMG + ((size_t)h * 256 + tile) * att::KSLOT; unsigned char* vt = VIMG + ((size_t)h * 256 + tile) * att::VSLOT;
          float y[16];
#pragma unroll
          for (int e = 0; e < 16; ++e) y[e] = hl < 8 ? x[e] * rk * wk[e] : x[e];
          { v4u o0, o1; o0.x = pk2(y[0], y[1]); o0.y = pk2(y[2], y[3]); o0.z = pk2(y[4], y[5]); o0.w = pk2(y[6], y[7]); o1.x = pk2(y[8], y[9]); o1.y = pk2(y[10], y[11]); o1.z = pk2(y[12], y[13]); o1.w = pk2(y[14], y[15]);
            if (hl < 8) { *(v4u*)(kt + att::k_nope_off(krow, hl * 32)) = o0; *(v4u*)(kt + att::k_nope_off(krow, hl * 32 + 16)) = o1; }
            else { *(v4u*)(vt + att::v_st(krow, (hl - 8) * 16)) = o0; *(v4u*)(vt + att::v_st(krow, (hl - 8) * 16 + 8)) = o1; } }
          float z[16];
#pragma unroll
          for (int e = 0; e < 16; ++e) { const float v = kp[e] * rk * wkr[e]; const float pr = __shfl_xor(v, 2); z[e] = c4 < 2 ? v * cs[e] - pr * sn[e] : v * cs[e] + pr * sn[e]; }
          if (hl < 4) { v4u o0, o1; o0.x = pk2(z[0], z[1]); o0.y = pk2(z[2], z[3]); o0.z = pk2(z[4], z[5]); o0.w = pk2(z[6], z[7]); o1.x = pk2(z[8], z[9]); o1.y = pk2(z[10], z[11]); o1.z = pk2(z[12], z[13]); o1.w = pk2(z[14], z[15]);
              *(v4u*)(kt + att::k_rope_off(krow, c4 * 32)) = o0; *(v4u*)(kt + att::k_rope_off(krow, c4 * 32 + 16)) = o1; } }
        { const int ch = lane * 8; float conv[8] = {0.f, 0.f, 0.f, 0.f, 0.f, 0.f, 0.f, 0.f};
#pragma unroll
          for (int k = 0; k < 3; ++k) { const int tt = t - 2 + k; if (tt >= 0) { const bf16* pr = P1 + (size_t)tt * O_INP; const v4u cg = *(const v4u*)(pr + 512 + ch), hh = *(const v4u*)(pr + 1024 + ch);
              const float* wv = k == 0 ? cw0 : (k == 1 ? cw1 : cw2);
              conv[0] += wv[0] * bflo(cg.x) * bflo(hh.x); conv[1] += wv[1] * bfhi(cg.x) * bfhi(hh.x); conv[2] += wv[2] * bflo(cg.y) * bflo(hh.y); conv[3] += wv[3] * bfhi(cg.y) * bfhi(hh.y);
              conv[4] += wv[4] * bflo(cg.z) * bflo(hh.z); conv[5] += wv[5] * bfhi(cg.z) * bfhi(hh.z); conv[6] += wv[6] * bflo(cg.w) * bflo(hh.w); conv[7] += wv[7] * bfhi(cg.w) * bfhi(hh.w); } }
          const v4u bg = *(const v4u*)(prow + ch);
          v4u o; o.x = pk2(bflo(bg.x) * conv[0], bfhi(bg.x) * conv[1]); o.y = pk2(bflo(bg.y) * conv[2], bfhi(bg.y) * conv[3]); o.z = pk2(bflo(bg.z) * conv[4], bfhi(bg.z) * conv[5]); o.w = pk2(bflo(bg.w) * conv[6], bfhi(bg.w) * conv[7]);
          *(v4u*)(MIX + (size_t)t * D + ch) = o; }
    }
}

__device__ __forceinline__ void route1_phase(const Args& a, LAS unsigned char* lds, int vcu, int G, int tid) {
    unsigned char* ws = a.ws; const float* XR = (const float*)(ws + WS_XR); const float* modF = (const float*)(ws + WS_MODF) + 6144;
    const float* nw = (const float*)a.in[I_NFW] + 1024; const float* rw = (const float*)a.in[I_RW];
    unsigned* tok = (unsigned*)(ws + WS_TOK); unsigned* cnt = (unsigned*)(ws + WS_CTL) + CW_CNT;
    const int lane = tid & 63, wave = __builtin_amdgcn_readfirstlane(tid >> 6);
    LAS int* tokE = (LAS int*)lds;
    LAS int* tokL = (LAS int*)(lds + 512);
    LAS int* offS = (LAS int*)(lds + 1024);
    f32x4 g[4], sh[4];
#pragma unroll
    for (int j = 0; j < 4; ++j)
#pragma unroll
        for (int e = 0; e < 4; ++e) { const int col = 4 * lane + e + 256 * j; g[j][e] = nw[col] * (1.f + modF[OFF_SCF + col]); sh[j][e] = modF[OFF_SHF + col]; }
    for (int chunk = vcu; chunk < S / 64; chunk += G) {
        for (int i = 0; i < 8; ++i) { const int ti = wave * 8 + i, t = chunk * 64 + ti;
            const f32x4* xr = (const f32x4*)(XR + (size_t)t * D) + lane; f32x4 v[4]; float s = 0.f;
#pragma unroll
            for (int j = 0; j < 4; ++j) { v[j] = xr[64 * j]; s += (v[j].x * v[j].x + v[j].y * v[j].y) + (v[j].z * v[j].z + v[j].w * v[j].w); }
            const float rstd = 1.f / sqrtf(wave_sum(s) * (1.f / D) + EPS);
            float lg[8] = {0.f, 0.f, 0.f, 0.f, 0.f, 0.f, 0.f, 0.f};
#pragma unroll
            for (int j = 0; j < 4; ++j) { const f32x4 hv = v[j] * rstd * g[j] + sh[j];
#pragma unroll
                for (int e = 0; e < 4; ++e) { const int col = 4 * lane + e + 256 * j; const f32x4 w0 = *(const f32x4*)(rw + col * 8), w1 = *(const f32x4*)(rw + col * 8 + 4); const float hx = hv[e];
                    lg[0] += hx * w0.x; lg[1] += hx * w0.y; lg[2] += hx * w0.z; lg[3] += hx * w0.w; lg[4] += hx * w1.x; lg[5] += hx * w1.y; lg[6] += hx * w1.z; lg[7] += hx * w1.w; } }
#pragma unroll
            for (int e = 0; e < 8; ++e) lg[e] = wave_sum(lg[e]);
            int e1 = 0; float l1 = lg[0];
#pragma unroll
            for (int e = 1; e < 8; ++e) if (lg[e] > l1) { l1 = lg[e]; e1 = e; }
            int e2 = -1; float l2 = -__builtin_inff();
#pragma unroll
            for (int e = 0; e < 8; ++e) if (e != e1 && lg[e] > l2) { l2 = lg[e]; e2 = e; }
            const float g1 = 1.f / (1.f + __expf(l2 - l1)), g2 = 1.f - g1;
            if (lane == 0) { unsigned* rec = tok + (size_t)t * 8; rec[0] = (unsigned)e1; rec[1] = (unsigned)e2; rec[4] = __float_as_uint(g1); rec[5] = __float_as_uint(g2); rec[6] = __float_as_uint(rstd);
                tokE[2 * ti] = e1; tokE[2 * ti + 1] = e2; } }
        __syncthreads();
        if (tid < 8) { int c = 0; for (int i = 0; i < 128; ++i) if (tokE[i] == tid) { tokL[i] = c; ++c; }
            offS[tid] = (int)__hip_atomic_fetch_add(cnt + 64 * tid, (unsigned)c, RLX_AGENT); }
        __syncthreads();
        if (tid < 128) { const int t = chunk * 64 + (tid >> 1); tok[(size_t)t * 8 + 2 + (tid & 1)] = (unsigned)(offS[tokE[tid]] + tokL[tid]); }
        __syncthreads();
    }
}
__device__ __forceinline__ void route2_phase(const Args& a, int gw, int NGW, int lane) {
    unsigned char* ws = a.ws; const float* XR = (const float*)(ws + WS_XR); const float* modF = (const float*)(ws + WS_MODF) + 6144;
    const float* nw = (const float*)a.in[I_NFW] + 1024; unsigned* tok = (unsigned*)(ws + WS_TOK); const unsigned* cnt = (const unsigned*)(ws + WS_CTL) + CW_CNT;
    bf16* AM = (bf16*)(ws + WS_AMOE);
    f32x4 g[4], sh[4];
#pragma unroll
    for (int j = 0; j < 4; ++j)
#pragma unroll
        for (int e = 0; e < 4; ++e) { const int col = 4 * lane + e + 256 * j; g[j][e] = nw[col] * (1.f + modF[OFF_SCF + col]); sh[j][e] = modF[OFF_SHF + col]; }
    int base[8]; { int b = 0;
#pragma unroll
      for (int e = 0; e < 8; ++e) { base[e] = b; b += (int)((cnt[64 * e] + 255u) >> 8) * 256; } }
    for (int t = gw; t < S; t += NGW) {
        unsigned* rec = tok + (size_t)t * 8; const int e1 = (int)rec[0], e2 = (int)rec[1]; const float rstd = __uint_as_float(rec[6]);
        int b1 = 0, b2 = 0;
#pragma unroll
        for (int e = 0; e < 8; ++e) { b1 = e1 == e ? base[e] : b1; b2 = e2 == e ? base[e] : b2; }
        const int s1 = b1 + (int)rec[2], s2 = b2 + (int)rec[3];
        const f32x4* xr = (const f32x4*)(XR + (size_t)t * D) + lane;
        unsigned long long* o1 = (unsigned long long*)(AM + (size_t)s1 * D) + lane; unsigned long long* o2 = (unsigned long long*)(AM + (size_t)s2 * D) + lane;
#pragma unroll
        for (int j = 0; j < 4; ++j) { const f32x4 y = xr[64 * j] * rstd * g[j] + sh[j]; const unsigned long long w = (unsigned long long)pk2(y.x, y.y) | ((unsigned long long)pk2(y.z, y.w) << 32); o1[64 * j] = w; o2[64 * j] = w; }
        if (lane == 0) { rec[2] = (unsigned)s1; rec[3] = (unsigned)s2; }
    }
}
__device__ __forceinline__ void combine_phase(const Args& a, int gw, int NGW, int lane) {
    unsigned char* ws = a.ws; const float* XR = (const float*)(ws + WS_XR); const float* gf = (const float*)(ws + WS_MODF) + 6144 + OFF_GF;
    const unsigned* tok = (const unsigned*)(ws + WS_TOK); const bf16* Y = (const bf16*)(ws + WS_AMOE);
    f32x4 gg[4];
#pragma unroll
    for (int j = 0; j < 4; ++j) gg[j] = *(const f32x4*)(gf + 4 * lane + 256 * j);
    for (int t = gw; t < S; t += NGW) {
        const unsigned* rec = tok + (size_t)t * 8; const int s1 = (int)rec[2], s2 = (int)rec[3]; const float g1 = __uint_as_float(rec[4]), g2 = __uint_as_float(rec[5]);
        const f32x4* xr = (const f32x4*)(XR + (size_t)t * D) + lane; f32x4* orow = (f32x4*)(a.out + (size_t)t * D) + lane;
        const v2u* y1 = (const v2u*)(Y + (size_t)s1 * D) + lane; const v2u* y2 = (const v2u*)(Y + (size_t)s2 * D) + lane;
#pragma unroll
        for (int j = 0; j < 4; ++j) { const v2u a1 = y1[64 * j], a2 = y2[64 * j];
            f32x4 m; m.x = g1 * bflo(a1.x) + g2 * bflo(a2.x); m.y = g1 * bfhi(a1.x) + g2 * bfhi(a2.x); m.z = g1 * bflo(a1.y) + g2 * bflo(a2.y); m.w = g1 * bfhi(a1.y) + g2 * bfhi(a2.y);
            orow[64 * j] = xr[64 * j] + gg[j] * m; }
    }
}

constexpr int N_PHASES = 19;
__global__ void __launch_bounds__(NTHR, 2) fwd_kernel(Args args) {
    extern __shared__ __attribute__((aligned(16))) unsigned char lds[];
    LAS unsigned char* L = (LAS unsigned char*)lds;
    const int tid = threadIdx.x, lane = tid & 63, wave = __builtin_amdgcn_readfirstlane(tid >> 6);
    const int G = gridDim.x; const int bx = blockIdx.x; const int vcu = (G % 8 == 0) ? (bx % 8) * (G / 8) + bx / 8 : bx;
    const int gw = vcu * NWAVES + wave, NGW = G * NWAVES;
    unsigned char* ws = args.ws;
    for (int u = tid; u < (LDS_BYTES - LDSCTL_OFF) / 4; u += NTHR) ((LAS unsigned*)(L + LDSCTL_OFF))[u] = 0u;
    __syncthreads();
    XcdBarrier bar; bar.bar = (unsigned*)(ws + WS_CTL) + CW_BAR; bar.x = 0; bar.st = nullptr;
#if !MK_MULTI
    bar = xcd_barrier_post((unsigned*)(ws + WS_CTL) + CW_BAR, (volatile LAS unsigned*)(L + MISC_OFF) + 8);
#define GRID_BAR() xcd_barrier(bar)
#else
#define GRID_BAR() do {} while (0)
#endif
    const int lo = args.ph_lo, hi = args.ph_hi;
#define IN(k) (lo <= (k) && (k) < hi)
#define BOTH(k) (IN(k) && IN((k) + 1))
    const float* modF = (const float*)(ws + WS_MODF);
    bf16* ABUF = (bf16*)(ws + WS_ABUF); bf16* MIX = (bf16*)(ws + WS_MIX); float* XR = (float*)(ws + WS_XR);

    if (IN(0)) { p0_prologue(args, L, vcu, G, tid); if (BOTH(0)) GRID_BAR(); }
    if (IN(1)) {
        { float* mf = (float*)(ws + WS_MODF); for (int i = vcu * NTHR + tid; i < 2 * 6144; i += G * NTHR) mf[i] = modv_partial((const float*)(ws + WS_MODP), (const float*)args.in[I_ADAB], i / 6144, i % 6144); }
        norm_phase<true>(args, (const float*)args.in[I_X], ABUF, (const float*)args.in[I_NMW], 0, OFF_SHM, OFF_SCM, gw, NGW, lane);
        if (BOTH(1)) GRID_BAR(); }
    if (IN(2)) { pg8::Gemm g{ABUF, (const bf16*)(ws + WS_WIN0), 1024, 1024}; pg8::StaticOrder So; So.init(S, E_IN, G, bx);
        pg8::EpiBf16G E{(bf16*)(ws + WS_P0), E_IN, 4}; pg8::gemm_phase(L, g, So, E); if (BOTH(2)) GRID_BAR(); }
    if (IN(3)) { mixab_phase(args, L, vcu, G, tid); if (BOTH(3)) GRID_BAR(); }
    if (IN(4)) { pg8::Gemm g{MIX, (const bf16*)(ws + WS_WOUT0), 1024, 1024}; pg8::StaticOrder So; So.init(S, 1024, G, bx);
        pg8::EpiRes E{(const float*)args.in[I_X], XR, modF + OFF_GM}; pg8::gemm_phase(L, g, So, E); if (BOTH(4)) GRID_BAR(); }
    if (IN(5)) { norm_phase<false>(args, XR, ABUF, (const float*)args.in[I_NFW], 0, OFF_SHF, OFF_SCF, gw, NGW, lane); if (BOTH(5)) GRID_BAR(); }
    if (IN(6)) { pg8::Gemm g{ABUF, (const bf16*)(ws + WS_WGU0), 1024, 1024}; pg8::StaticOrder So; So.init(S, 2 * D_FF, G, bx);
        pg8::EpiSwiGLU E{(bf16*)(ws + WS_H), D_FF}; pg8::gemm_phase(L, g, So, E); if (BOTH(6)) GRID_BAR(); }
    if (IN(7)) { pg8::Gemm g{(const bf16*)(ws + WS_H), (const bf16*)(ws + WS_WD0), D_FF, D_FF}; pg8::StaticOrder So; So.init(S, 1024, G, bx);
        pg8::EpiRes E{XR, XR, modF + OFF_GF}; pg8::gemm_phase(L, g, So, E); if (BOTH(7)) GRID_BAR(); }
    if (IN(8)) { norm_phase<false>(args, XR, ABUF, (const float*)args.in[I_NMW] + 1024, 1, OFF_SHM, OFF_SCM, gw, NGW, lane); if (BOTH(8)) GRID_BAR(); }
    if (IN(9)) { pg8::Gemm g{ABUF, (const bf16*)(ws + WS_WIN1), 1024, 1024}; pg8::StaticOrder So; So.init(S, O_INP, G, bx);
        pg8::EpiBf16G E{(bf16*)(ws + WS_P1), O_INP, 0}; pg8::gemm_phase(L, g, So, E); if (BOTH(9)) GRID_BAR(); }
    if (IN(10)) {
        { pg8::Gemm g{(const bf16*)(ws + WS_P1) + 1536, (const bf16*)(ws + WS_WUQ), O_INP, 256}; pg8::StaticOrder So; So.init(S, 1024, G, bx);
          pg8::EpiBf16G E{(bf16*)(ws + WS_QR), 1024, 0}; pg8::gemm_phase(L, g, So, E); }
        { pg8::Gemm g{(const bf16*)(ws + WS_P1) + 1792, (const bf16*)(ws + WS_WUKV), O_INP, 256}; pg8::StaticOrder So; So.init(S, 1024, G, bx);
          pg8::EpiBf16G E{(bf16*)(ws + WS_KVR), 1024, 0}; pg8::gemm_phase(L, g, So, E); }
        if (BOTH(10)) GRID_BAR(); }
    if (IN(11)) { fin_phase(args, gw, NGW, lane); if (BOTH(11)) GRID_BAR(); }
    if (IN(12)) {
        for (int u = bx; u < 256; u += G) { const int qb = 63 - (u >> 2), h = u & 3;
            att::attn_block(h, qb, (const bf16*)(ws + WS_QF), ws + WS_KIMG, ws + WS_VIMG, MIX, (char*)lds); }
        if (BOTH(12)) GRID_BAR(); }
    if (IN(13)) { pg8::Gemm g{MIX, (const bf16*)(ws + WS_WOUT1), 1024, 1024}; pg8::StaticOrder So; So.init(S, 1024, G, bx);
        pg8::EpiRes E{XR, XR, modF + 6144 + OFF_GM}; pg8::gemm_phase(L, g, So, E); if (BOTH(13)) GRID_BAR(); }
    if (IN(14)) { route1_phase(args, L, vcu, G, tid); if (BOTH(14)) GRID_BAR(); }
    if (IN(15)) { route2_phase(args, gw, NGW, lane); if (BOTH(15)) GRID_BAR(); }
    if (IN(16)) { pg8::Gemm g{(const bf16*)(ws + WS_AMOE), (const bf16*)(ws + WS_WGUM), 1024, 1024}; pg8::MoeOrder Mo; Mo.init((const unsigned*)(ws + WS_CTL) + CW_CNT, 28, G, vcu);
        pg8::EpiSwiGLU E{(bf16*)(ws + WS_HM), DFE}; pg8::gemm_phase(L, g, Mo, E); if (BOTH(16)) GRID_BAR(); }
    if (IN(17)) { pg8::Gemm g{(const bf16*)(ws + WS_HM), (const bf16*)(ws + WS_WDM), DFE, DFE}; pg8::MoeOrder Mo; Mo.init((const unsigned*)(ws + WS_CTL) + CW_CNT, 4, G, vcu);
        pg8::EpiBf16G E{(bf16*)(ws + WS_AMOE), 1024, 0}; pg8::gemm_phase(L, g, Mo, E); if (BOTH(17)) GRID_BAR(); }
    if (IN(18)) { combine_phase(args, gw, NGW, lane); }
    if (IN(19)) { const f32x4* src = (const f32x4*)(DBG_STOP < 4 ? (const float*)args.in[I_X] : (const float*)XR); f32x4* dst = (f32x4*)args.out;
        for (size_t i = (size_t)vcu * NTHR + tid; i < (size_t)S * D / 4; i += (size_t)G * NTHR) dst[i] = src[i]; }
#undef IN
#undef BOTH
}

extern "C" void kernel_launch(void* const* d_in, const int* in_sizes, int n_in, void* d_out, int out_size, void* d_ws, size_t ws_size, hipStream_t stream) {
    static int grid = 0;
    if (grid == 0) {
        if (n_in != 29 || out_size != S * D || ws_size < WS_END) { fprintf(stderr, "kernel_launch: unexpected shapes (n_in %d out %d ws %zu)\n", n_in, out_size, ws_size); grid = -1; return; }
        int dev = 0, cus = 0;
        if (hipGetDevice(&dev) != hipSuccess || hipDeviceGetAttribute(&cus, hipDeviceAttributeMultiprocessorCount, dev) != hipSuccess) { grid = -1; return; }
        if (hipFuncSetAttribute((const void*)fwd_kernel, hipFuncAttributeMaxDynamicSharedMemorySize, LDS_BYTES) != hipSuccess) { grid = -1; return; }
        int per_cu = 0;
        if (hipOccupancyMaxActiveBlocksPerMultiprocessor(&per_cu, (const void*)fwd_kernel, NTHR, LDS_BYTES) != hipSuccess || per_cu < 1) fprintf(stderr, "kernel_launch: occupancy query says %d\n", per_cu);
        (void)hipGetLastError();
        grid = cus;
    }
    if (grid < 0) return;
    (void)hipMemsetAsync((char*)d_ws + WS_CTL, 0, CTL_ZERO_BYTES, stream);
    Args a{};
    for (int i = 0; i < 29; ++i) a.in[i] = d_in[i];
    a.out = (float*)d_out; a.ws = (unsigned char*)d_ws;
#if MK_MULTI
    { const int last = DBG_STOP < 0 ? N_PHASES - 1 : DBG_STOP;
      for (int p = 0; p <= last; ++p) { a.ph_lo = p; a.ph_hi = p + 1; hipLaunchKernelGGL(fwd_kernel, dim3(grid), dim3(NTHR), LDS_BYTES, stream, a); }
      if (DBG_STOP >= 0) { a.ph_lo = 19; a.ph_hi = 20; hipLaunchKernelGGL(fwd_kernel, dim3(grid), dim3(NTHR), LDS_BYTES, stream, a); } }
#else
    a.ph_lo = 0; a.ph_hi = N_PHASES;
    hipLaunchKernelGGL(fwd_kernel, dim3(grid), dim3(NTHR), LDS_BYTES, stream, a);
#endif
}
```

```cpp
#include <hip/hip_runtime.h>
#include <cstdio>
#include <cstdint>

#ifndef MK_MULTI
#define MK_MULTI 0
#endif
#ifndef DBG_REP
#define DBG_REP -1
#endif
#ifndef DBG_STOP
#define DBG_STOP -1
#endif

namespace pg8 {
#define PG8_LAS __attribute__((address_space(3)))
typedef unsigned short bf16_t;
typedef short bf16x8 __attribute__((ext_vector_type(8)));
typedef float f32x4 __attribute__((ext_vector_type(4)));
typedef float f32x2 __attribute__((ext_vector_type(2)));
typedef unsigned u32x4 __attribute__((ext_vector_type(4)));
constexpr int BM = 256, BK = 64, HALF = 128, HTB = HALF * BK * 2, STAGE_BYTES = 8 * HTB, NXCD = 8, WGM = 8;

__host__ __device__ __forceinline__ int lds_byte(int r, int c) { const int st = (r >> 4) * 2 + (c >> 5), rr = r & 15, cc = c & 31, ob = rr * 64 + cc * 2; return st * 1024 + (ob ^ (((ob >> 9) & 1) << 5)); }
__host__ __device__ __forceinline__ void stage_rc(int b, int& R, int& C) { const int st = b / 1024, sb = b % 1024, swz = sb ^ (((sb >> 9) & 1) << 5); R = (st >> 1) * 16 + swz / 64; C = (st & 1) * 32 + (swz % 64) / 2; }
__host__ __device__ __forceinline__ int perm32(int rho) { const int n = rho >> 4, i = rho & 15; return 8 * (i >> 2) + 4 * n + (i & 3); }

struct Unit { int pm, pn, po; };
struct Gemm { const bf16_t* A; const bf16_t* Bt; int lda, K; };

struct StaticOrder {
    int nM, nN, nwg, G, c;
    __device__ void init(int M, int N, int G_, int c_) { nM = M / BM; nN = N / BM; nwg = nM * nN; G = G_; c = c_; }
    __device__ bool next(int i, Unit& u) const {
        const long L = (long)i * G + c; if (L >= nwg) return false;
        int wgid = (int)L; { const int q = nwg / NXCD, r = nwg % NXCD, xcd = wgid % NXCD, off = wgid / NXCD; wgid = (xcd < r ? xcd * (q + 1) : r * (q + 1) + (xcd - r) * q) + off; }
        const int nig = WGM * nN, gid = wgid / nig, fm = gid * WGM, gsz = (nM - fm) < WGM ? (nM - fm) : WGM;
        u.pm = fm + ((wgid % nig) % gsz); u.pn = (wgid % nig) / gsz; u.po = u.pn; return true;
    }
};
struct MoeOrder {
    int rt0, rt1, rt2, rt3, rt4, rt5, rt6, rt7, nct, G, c;
    __device__ void init(const unsigned* cnt, int nct_, int G_, int c_) {
        rt0 = (int)((cnt[0] + 255u) >> 8); rt1 = (int)((cnt[64] + 255u) >> 8); rt2 = (int)((cnt[128] + 255u) >> 8); rt3 = (int)((cnt[192] + 255u) >> 8);
        rt4 = (int)((cnt[256] + 255u) >> 8); rt5 = (int)((cnt[320] + 255u) >> 8); rt6 = (int)((cnt[384] + 255u) >> 8); rt7 = (int)((cnt[448] + 255u) >> 8);
        nct = nct_; G = G_; c = c_;
    }
    __device__ bool next(int i, Unit& u) const {
        const int L = i * G + c; int cum = 0, tb = 0; bool found = false;
#define MO_STEP(e, rte) { const int n_ = (rte) * nct; if (!found && L < cum + n_) { const int r_ = L - cum; u.pm = tb + r_ % (rte); u.po = r_ / (rte); u.pn = (e) * nct + u.po; found = true; } cum += n_; tb += (rte); }
        MO_STEP(0, rt0) MO_STEP(1, rt1) MO_STEP(2, rt2) MO_STEP(3, rt3) MO_STEP(4, rt4) MO_STEP(5, rt5) MO_STEP(6, rt6) MO_STEP(7, rt7)
#undef MO_STEP
        return found;
    }
};

__device__ __forceinline__ unsigned cvt_pk_bf16(float lo, float hi) { unsigned r; asm volatile("v_cvt_pk_bf16_f32 %0, %1, %2" : "=v"(r) : "v"(lo), "v"(hi)); return r; }
__device__ __forceinline__ float gelu_tanh(float x) {
    const float u2 = x * (1.5957691216057308f + 0.07135481282599649f * x * x);
    return x * __builtin_amdgcn_rcpf(1.0f + __builtin_amdgcn_exp2f(-1.4426950408889634f * u2));
}
__device__ __forceinline__ float silu_f(float x) { return x * __builtin_amdgcn_rcpf(1.0f + __builtin_amdgcn_exp2f(-1.4426950408889634f * x)); }

struct EpiBf16G {
    static constexpr bool PERM = true;
    bf16_t* O; int ldc; int gelu_tiles;
    __device__ __forceinline__ void operator()(const f32x4 (&acc)[2][2][4][2], const Unit& u, int wr, int wc, int fr, int fq) const {
        const int row0 = u.pm * BM + wr * 64 + fr, col0 = u.po * BM + wc * 32 + 8 * fq; const bool g = u.po < gelu_tiles;
#pragma unroll
        for (int ai = 0; ai < 2; ++ai)
#pragma unroll
            for (int m = 0; m < 4; ++m) { bf16_t* rowp = O + (size_t)(row0 + ai * HALF + m * 16) * ldc + col0;
#pragma unroll
                for (int bj = 0; bj < 2; ++bj) { f32x4 v0 = acc[ai][bj][m][0], v1 = acc[ai][bj][m][1];
                    if (g) { v0 = (f32x4){gelu_tanh(v0[0]), gelu_tanh(v0[1]), gelu_tanh(v0[2]), gelu_tanh(v0[3])}; v1 = (f32x4){gelu_tanh(v1[0]), gelu_tanh(v1[1]), gelu_tanh(v1[2]), gelu_tanh(v1[3])}; }
                    u32x4 w; w.x = cvt_pk_bf16(v0[0], v0[1]); w.y = cvt_pk_bf16(v0[2], v0[3]); w.z = cvt_pk_bf16(v1[0], v1[1]); w.w = cvt_pk_bf16(v1[2], v1[3]);
                    *(u32x4*)(rowp + bj * HALF) = w; } }
    }
};
struct EpiSwiGLU {
    static constexpr bool PERM = true;
    bf16_t* O; int ldc;
    __device__ __forceinline__ void operator()(const f32x4 (&acc)[2][2][4][2], const Unit& u, int wr, int wc, int fr, int fq) const {
        const int row0 = u.pm * BM + wr * 64 + fr, col0 = u.po * HALF + wc * 32 + 8 * fq;
#pragma unroll
        for (int ai = 0; ai < 2; ++ai)
#pragma unroll
            for (int m = 0; m < 4; ++m) { const f32x4 g0 = acc[ai][0][m][0], g1 = acc[ai][0][m][1], u0 = acc[ai][1][m][0], u1 = acc[ai][1][m][1];
                u32x4 w; w.x = cvt_pk_bf16(silu_f(g0[0]) * u0[0], silu_f(g0[1]) * u0[1]); w.y = cvt_pk_bf16(silu_f(g0[2]) * u0[2], silu_f(g0[3]) * u0[3]);
                w.z = cvt_pk_bf16(silu_f(g1[0]) * u1[0], silu_f(g1[1]) * u1[1]); w.w = cvt_pk_bf16(silu_f(g1[2]) * u1[2], silu_f(g1[3]) * u1[3]);
                *(u32x4*)(O + (size_t)(row0 + ai * HALF + m * 16) * ldc + col0) = w; }
    }
};
struct EpiRes {
    static constexpr bool PERM = false;
    const float* base; float* out; const float* gate;
    __device__ __forceinline__ void operator()(const f32x4 (&acc)[2][2][4][2], const Unit& u, int wr, int wc, int fr, int fq) const {
        const int col0 = u.po * BM + wc * 32 + 4 * fq;
        f32x4 gv[2][2];
#pragma unroll
        for (int bj = 0; bj < 2; ++bj)
#pragma unroll
            for (int n = 0; n < 2; ++n) gv[bj][n] = *(const f32x4*)(gate + col0 + bj * HALF + n * 16);
#pragma unroll
        for (int ai = 0; ai < 2; ++ai)
#pragma unroll
            for (int m = 0; m < 4; ++m) { const size_t off = (size_t)(u.pm * BM + ai * HALF + wr * 64 + m * 16 + fr) * 1024 + col0;
#pragma unroll
                for (int bj = 0; bj < 2; ++bj)
#pragma unroll
                    for (int n = 0; n < 2; ++n) { const f32x4 bs = *(const f32x4*)(base + off + bj * HALF + n * 16); *(f32x4*)(out + off + bj * HALF + n * 16) = bs + gv[bj][n] * acc[ai][bj][m][n]; } }
    }
};

template <class Epi, class Sched, bool ALIGN_EPI = true>
__device__ __forceinline__ void gemm_phase(PG8_LAS unsigned char* lds, const Gemm g, const Sched& S, const Epi& E) {
    const int tid = threadIdx.x, wid = __builtin_amdgcn_readfirstlane(tid >> 6), lane = tid & 63, wr = wid >> 2, wc = wid & 3, fr = lane & 15, fq = lane >> 4;
    const int K = g.K, nt = K / BK, lda = g.lda;
    unsigned voffA[2], voffB[2];
#pragma unroll
    for (int i = 0; i < 2; ++i) { int R, C; stage_rc(tid * 16 + i * 8192, R, C); const int Rb = Epi::PERM ? ((R & ~31) + perm32(R & 31)) : R;
        voffA[i] = (unsigned)(R * lda + C) * 2u; voffB[i] = (unsigned)(Rb * K + C) * 2u; }
    const size_t kstep = (size_t)(BK * 2);
    const size_t hstepA = (size_t)HALF * lda * 2, hstepB = (size_t)HALF * K * 2;
    const size_t tstepA = 2 * hstepA, tstepB = 2 * hstepB;
    const unsigned ldsw = (unsigned)wid * 1024u;
    const int aoff = lds_byte(wr * 64 + fr, fq * 8), boff = lds_byte(wc * 32 + fr, fq * 8);
#define PG8_SA(b, h) (((b) * 2 + (h)) * HTB)
#define PG8_SB(b, h) ((4 + (b) * 2 + (h)) * HTB)
#define PG8_STAGE(bufoff, gbase, voff) do { _Pragma("unroll") for (int _i = 0; _i < 2; ++_i) \
        __builtin_amdgcn_global_load_lds((const unsigned*)((const char*)(gbase) + (voff)[_i]), (PG8_LAS unsigned*)(lds + (bufoff) + ldsw + _i * 8192), 16, 0, 0); } while (0)
#define PG8_LDA(dst, b, h) do { _Pragma("unroll") for (int m = 0; m < 4; ++m) _Pragma("unroll") for (int k = 0; k < 2; ++k) dst[m][k] = *(const PG8_LAS bf16x8*)(lds + PG8_SA(b, h) + aoff + m * 2048 + k * 1024); } while (0)
#define PG8_LDB(dst, b, h) do { _Pragma("unroll") for (int n = 0; n < 2; ++n) _Pragma("unroll") for (int k = 0; k < 2; ++k) dst[n][k] = *(const PG8_LAS bf16x8*)(lds + PG8_SB(b, h) + boff + n * 2048 + k * 1024); } while (0)
#define PG8_MMA(ai, bj, At, Bt) do { __builtin_amdgcn_s_setprio(1); _Pragma("unroll") for (int m = 0; m < 4; ++m) _Pragma("unroll") for (int n = 0; n < 2; ++n) _Pragma("unroll") for (int k = 0; k < 2; ++k) \
        acc[ai][bj][m][n] = __builtin_amdgcn_mfma_f32_16x16x32_bf16(Bt[n][k], At[m][k], acc[ai][bj][m][n], 0, 0, 0); __builtin_amdgcn_s_setprio(0); } while (0)
#define PG8_WAIT_V(n) asm volatile("s_waitcnt vmcnt(" #n ")" ::: "memory")
#define PG8_WAIT_L(n) asm volatile("s_waitcnt lgkmcnt(" #n ")" ::: "memory")
#define PG8_BAR __builtin_amdgcn_s_barrier()
#define PG8_SCHED __builtin_amdgcn_sched_barrier(0)
    Unit cur, nxt; int ui = 0;
    if (!S.next(0, cur)) return;
    f32x4 acc[2][2][4][2];
#pragma unroll
    for (int a = 0; a < 2; ++a)
#pragma unroll
        for (int b = 0; b < 2; ++b)
#pragma unroll
            for (int m = 0; m < 4; ++m)
#pragma unroll
                for (int n = 0; n < 2; ++n) acc[a][b][m][n] = (f32x4){0.f, 0.f, 0.f, 0.f};
    bf16x8 At[4][2], B0[2][2], B1[2][2];
    const char* cA = (const char*)g.A + (size_t)cur.pm * tstepA; const char* cB = (const char*)g.Bt + (size_t)cur.pn * tstepB;
    PG8_STAGE(PG8_SB(0, 0), cB, voffB); PG8_STAGE(PG8_SB(0, 1), cB + hstepB, voffB); PG8_STAGE(PG8_SA(0, 0), cA, voffA); PG8_STAGE(PG8_SA(0, 1), cA + hstepA, voffA);
    if (wr == 1) PG8_BAR;
    PG8_WAIT_V(2); PG8_BAR;
    PG8_STAGE(PG8_SB(1, 0), cB + kstep, voffB); PG8_STAGE(PG8_SA(1, 0), cA + kstep, voffA); PG8_STAGE(PG8_SB(1, 1), cB + hstepB + kstep, voffB);
    PG8_WAIT_V(6); PG8_BAR;
    for (;;) {
        const bool has_next = S.next(ui + 1, nxt);
        const char* nA = has_next ? (const char*)g.A + (size_t)nxt.pm * tstepA : cA; const char* nB = has_next ? (const char*)g.Bt + (size_t)nxt.pn * tstepB : cB;
        for (int t = 0; t < nt; t += 2) {
            const bool last = (t == nt - 2);
            const char* a1 = cA + (size_t)(t + 1) * kstep;
            const char* a2 = last ? nA : cA + (size_t)(t + 2) * kstep; const char* b2 = last ? nB : cB + (size_t)(t + 2) * kstep;
            const char* a3 = a2 + kstep; const char* b3 = b2 + kstep;
            PG8_LDB(B0, 0, 0); PG8_LDB(B1, 0, 1); PG8_SCHED; PG8_LDA(At, 0, 0); PG8_STAGE(PG8_SA(1, 1), a1 + hstepA, voffA);
            PG8_WAIT_V(8); PG8_WAIT_L(0); PG8_BAR; PG8_MMA(0, 0, At, B0); PG8_MMA(0, 1, At, B1); PG8_BAR; PG8_SCHED;
            PG8_LDA(At, 0, 1); PG8_STAGE(PG8_SB(0, 0), b2, voffB); PG8_STAGE(PG8_SB(0, 1), b2 + hstepB, voffB); PG8_STAGE(PG8_SA(0, 0), a2, voffA);
            PG8_WAIT_V(8); PG8_WAIT_L(0); PG8_BAR; PG8_MMA(1, 0, At, B0); PG8_MMA(1, 1, At, B1); PG8_BAR; PG8_SCHED;
            PG8_LDB(B0, 1, 0); PG8_LDB(B1, 1, 1); PG8_SCHED; PG8_LDA(At, 1, 0); PG8_STAGE(PG8_SA(0, 1), a2 + hstepA, voffA);
            PG8_WAIT_V(8); PG8_WAIT_L(0); PG8_BAR; PG8_MMA(0, 0, At, B0); PG8_MMA(0, 1, At, B1); PG8_BAR; PG8_SCHED;
            PG8_LDA(At, 1, 1); PG8_STAGE(PG8_SB(1, 0), b3, voffB); PG8_STAGE(PG8_SB(1, 1), b3 + hstepB, voffB); PG8_STAGE(PG8_SA(1, 0), a3, voffA);
            PG8_WAIT_V(8); PG8_WAIT_L(0); PG8_BAR; PG8_MMA(1, 0, At, B0); PG8_MMA(1, 1, At, B1); PG8_BAR; PG8_SCHED;
        }
        if constexpr (ALIGN_EPI) { if (wr == 0) PG8_BAR; }
        E(acc, cur, wr, wc, fr, fq);
        if (!has_next) break;
#pragma unroll
        for (int a = 0; a < 2; ++a)
#pragma unroll
            for (int b = 0; b < 2; ++b)
#pragma unroll
                for (int m = 0; m < 4; ++m)
#pragma unroll
                    for (int n = 0; n < 2; ++n) acc[a][b][m][n] = (f32x4){0.f, 0.f, 0.f, 0.f};
        cur = nxt; cA = nA; cB = nB; ++ui;
        if constexpr (ALIGN_EPI) { if (wr == 1) PG8_BAR; }
    }
    PG8_WAIT_V(0);
    if constexpr (!ALIGN_EPI) { if (wr == 0) PG8_BAR; }
    PG8_BAR;
#undef PG8_SA
#undef PG8_SB
#undef PG8_STAGE
#undef PG8_LDA
#undef PG8_LDB
#undef PG8_MMA
#undef PG8_WAIT_V
#undef PG8_WAIT_L
#undef PG8_BAR
#undef PG8_SCHED
}
}

constexpr int NWAVES = 8, NTHR = 512;
constexpr int S = 16384, D = 1024;
constexpr int E_IN = 1536, D_FF = 2816, O_IN = 2112, O_INP = 2304, NE = 8, DFE = 3584;
constexpr int MOE_ROWS = 34816;
constexpr float EPS = 1e-6f;

constexpr size_t MiB = 1u << 20;
constexpr size_t WS_CTL = 0, CTL_ZERO_BYTES = 1 * MiB;
constexpr size_t WS_MODP = 1 * MiB, WS_MODF = 2 * MiB, WS_ROPE = 3 * MiB;
constexpr size_t WS_TOK = 7 * MiB;
constexpr size_t WS_WIN0 = 8 * MiB, WS_WOUT0 = 11 * MiB, WS_WGU0 = 13 * MiB, WS_WD0 = 24 * MiB, WS_WIN1 = 30 * MiB;
constexpr size_t WS_WUQ = 35 * MiB, WS_WUKV = WS_WUQ + MiB / 2, WS_WOUT1 = 36 * MiB, WS_WTRIL = 38 * MiB, WS_WGT = WS_WTRIL + 131072;
constexpr size_t WS_WGUM = 40 * MiB, WS_WDM = 152 * MiB;
constexpr size_t WS_ABUF = 208 * MiB, WS_MIX = 240 * MiB, WS_XR = 272 * MiB, WS_AMOE = 336 * MiB  , WS_BIG = 404 * MiB;
constexpr size_t WS_P0 = WS_BIG, WS_H = WS_BIG + 48 * MiB;
constexpr size_t WS_P1 = WS_BIG, WS_QR = WS_BIG + 72 * MiB, WS_KVR = WS_BIG + 104 * MiB, WS_QF = WS_BIG + 136 * MiB, WS_KIMG = WS_BIG + 160 * MiB, WS_VIMG = WS_BIG + 184 * MiB;
constexpr size_t WS_PART = WS_BIG + 200 * MiB, WS_PML = WS_BIG + 232 * MiB;
constexpr size_t WS_HM = WS_BIG;
constexpr size_t WS_END = 660 * MiB;
static_assert(WS_H + (size_t)S * D_FF * 2 <= WS_END && WS_VIMG + 16 * MiB <= WS_END && WS_HM + (size_t)MOE_ROWS * DFE * 2 <= WS_END, "big region");
static_assert(WS_AMOE + (size_t)MOE_ROWS * D * 2 <= WS_BIG && WS_WDM + (size_t)NE * D * DFE * 2 <= WS_ABUF && WS_WGUM + (size_t)NE * 2 * DFE * D * 2 <= WS_WDM, "map");
constexpr int CW_BAR = 4096;
constexpr int CW_CNT = 16384;

constexpr int RING_BYTES = 131072, LDSCTL_OFF = RING_BYTES, MISC_OFF = LDSCTL_OFF + 320, LDS_BYTES = 147456;

#define GAS __attribute__((address_space(1)))
#define LAS __attribute__((address_space(3)))
typedef unsigned short bf16;
typedef unsigned v4u __attribute__((ext_vector_type(4)));
typedef unsigned v2u __attribute__((ext_vector_type(2)));
typedef float f32x4 __attribute__((ext_vector_type(4)));
typedef float f32x16 __attribute__((ext_vector_type(16)));
typedef short bf16x8 __attribute__((ext_vector_type(8)));
typedef short s16x4 __attribute__((ext_vector_type(4)));
typedef GAS unsigned gu32;
#define RLX_AGENT __ATOMIC_RELAXED, __HIP_MEMORY_SCOPE_AGENT
#define LDS_WAIT() asm volatile("s_waitcnt lgkmcnt(0)" ::: "memory")
#define VM_WAIT() asm volatile("s_waitcnt vmcnt(0)" ::: "memory")
__device__ __forceinline__ unsigned f2bf(float f) { unsigned u = __builtin_bit_cast(unsigned, f); return (u + 0x7fffu + ((u >> 16) & 1u)) >> 16; }
__device__ __forceinline__ unsigned pk2(float lo, float hi) { return f2bf(lo) | (f2bf(hi) << 16); }
__device__ __forceinline__ float bflo(unsigned w) { return __builtin_bit_cast(float, w << 16); }
__device__ __forceinline__ float bfhi(unsigned w) { return __builtin_bit_cast(float, w & 0xffff0000u); }
__device__ __forceinline__ float wave_sum(float v) {
#pragma unroll
    for (int o = 1; o < 64; o <<= 1) v += __shfl_xor(v, o);
    return v;
}

#define XB_TMO      128
#define XB_XCNT(j)  (256  + 64 * (j))
#define XB_XSUB(j)  (1280 + 64 * (j))
#define XB_XGEN(j)  (2304 + 64 * (j))
#define XB_TOP      3328
#define XB_TOPGEN   3392
#define XCD_BAR_WORDS 3456
#define XB_SPIN_CAP (1u << 18)
__device__ __forceinline__ unsigned xb_ld(unsigned* p)              { return __hip_atomic_load(p, __ATOMIC_RELAXED, __HIP_MEMORY_SCOPE_AGENT); }
__device__ __forceinline__ unsigned xb_add(unsigned* p, unsigned v) { return __hip_atomic_fetch_add(p, v, __ATOMIC_RELAXED, __HIP_MEMORY_SCOPE_AGENT); }
__device__ __forceinline__ unsigned xb_xcc_id() { return (unsigned)__builtin_amdgcn_s_getreg((3 << 11) | 20) & 0xFu; }
#define XB_SPIN(cond, bar) do { unsigned _sp = 0; while (cond) { __builtin_amdgcn_s_sleep(1); \
    if ((++_sp & 255u) == 0u) { if (xb_ld(&(bar)[XB_TMO])) break; if (_sp > XB_SPIN_CAP) { atomicAdd(&(bar)[XB_TMO], 1u); break; } } } } while (0)
struct XcdBarrier { unsigned* bar; unsigned x; volatile LAS unsigned* st; };
__device__ __forceinline__ XcdBarrier xcd_barrier_post(unsigned* bar, volatile LAS unsigned* st) {
    XcdBarrier b; b.bar = bar; b.x = xb_xcc_id(); b.st = st;
    if (threadIdx.x == 0) (void)xb_add(&bar[XB_XCNT(b.x)], 1u);
    return b;
}
__device__ __forceinline__ void xcd_barrier_complete(unsigned* bar, unsigned x, unsigned& nloc, unsigned& nx) {
    const unsigned G = gridDim.x * gridDim.y * gridDim.z;
    unsigned sum, cnt, mine, sp = 0u;
    for (;;) {
        sum = 0u; cnt = 0u; mine = 0u;
#pragma unroll
        for (unsigned j = 0; j < 16; ++j) { const unsigned c = xb_ld(&bar[XB_XCNT(j)]); sum += c; cnt += (c > 0u) ? 1u : 0u; mine = (j == x) ? c : mine; }
        if (sum == G) break;
        __builtin_amdgcn_s_sleep(1);
        if ((++sp & 255u) == 0u) { if (xb_ld(&bar[XB_TMO])) break; if (sp > XB_SPIN_CAP) { atomicAdd(&bar[XB_TMO], 1u); break; } }
    }
    nloc = mine > 0u ? mine : 1u; nx = cnt > 0u ? cnt : 1u;
}
__device__ __forceinline__ void xcd_barrier(const XcdBarrier& b) {
    asm volatile("s_waitcnt vmcnt(0)" ::: "memory");
    __syncthreads();
    if (threadIdx.x == 0) {
        unsigned* bar = b.bar;
        __builtin_amdgcn_s_waitcnt(0);
        unsigned nloc = b.st[0], nx = b.st[1];
        if (nloc == 0u) { xcd_barrier_complete(bar, b.x, nloc, nx); b.st[0] = nloc; b.st[1] = nx; }
        const unsigned old = xb_add(&bar[XB_XSUB(b.x)], 1u);
        const unsigned gen = old / nloc;
        if (old + 1u == (gen + 1u) * nloc) {
            __builtin_amdgcn_fence(__ATOMIC_RELEASE, "agent");
            asm volatile("s_waitcnt vmcnt(0)" ::: "memory");
            const unsigned og = xb_add(&bar[XB_TOP], 1u);
            const unsigned tg = og / nx;
            if (og + 1u == (tg + 1u) * nx) xb_add(&bar[XB_TOPGEN], 1u);
            else XB_SPIN(xb_ld(&bar[XB_TOPGEN]) == tg, bar);
            __builtin_amdgcn_fence(__ATOMIC_ACQUIRE, "agent");
            xb_add(&bar[XB_XGEN(b.x)], 1u);
            asm volatile("s_waitcnt vmcnt(0)" ::: "memory");
        } else {
            XB_SPIN(xb_ld(&bar[XB_XGEN(b.x)]) == gen, bar);
            __builtin_amdgcn_fence(__ATOMIC_ACQUIRE, "agent");
            asm volatile("s_waitcnt vmcnt(0)" ::: "memory");
        }
    }
    __syncthreads();
}

struct Args { const void* in[29]; float* out; unsigned char* ws; int ph_lo, ph_hi; };
enum { I_X = 0, I_C, I_POS, I_NMW, I_NFW, I_ADAW, I_ADAB, I_EWIN, I_ALNW, I_ALNB, I_AWS, I_ABS, I_BWG, I_BSC, I_EWOUT, I_FGU, I_FDN,
       I_OWIN, I_CONV, I_QAN, I_WUQ, I_KVN, I_WUKV, I_QNW, I_KNW, I_OWOUT, I_RW, I_MGU, I_MDN };
constexpr int OFF_SHM = 0, OFF_SCM = 1024, OFF_GM = 2048, OFF_SHF = 3072, OFF_SCF = 4096, OFF_GF = 5120;

__device__ __forceinline__ void p0_mod(const float* c, const float* ada_w, float* modp, int vcu, int G, int tid) {
    for (int u = vcu; u < 384; u += G) {
        const int layer = u / 192, r = u % 192, ks = r / 12, cb = r % 12, col = cb * 512 + tid;
        const float* w = ada_w + ((size_t)layer * 1024 + ks * 64) * 6144 + col;
        float acc = 0.f;
#pragma unroll 8
        for (int k = 0; k < 64; ++k) { const float cv = c[ks * 64 + k]; const float sv = cv / (1.f + __expf(-cv)); acc += sv * w[(size_t)k * 6144]; }
        modp[(size_t)(layer * 16 + ks) * 6144 + col] = acc;
    }
}
__device__ __forceinline__ void conv_item(const float* src, int ldn, int k0, int n0, const float* kscale, bf16* dst, int ldk, int drow0, LAS float* scr, int lane) {
#pragma unroll
    for (int i = 0; i < 8; ++i) { const int kk = 8 * i + (lane >> 3); f32x4 v = *(const f32x4*)(src + (size_t)(k0 + kk) * ldn + n0 + (lane & 7) * 4);
        if (kscale) v = v * kscale[k0 + kk];
        LAS float* p = scr + kk * 33 + (lane & 7) * 4; p[0] = v.x; p[1] = v.y; p[2] = v.z; p[3] = v.w; }
    LDS_WAIT(); asm volatile("" ::: "memory");
    const int c = lane & 7;
#pragma unroll
    for (int j = 0; j < 4; ++j) { const int nn = (lane >> 3) + 8 * j; const LAS float* s = scr + (8 * c) * 33 + nn;
        v4u o; o.x = pk2(s[0 * 33], s[1 * 33]); o.y = pk2(s[2 * 33], s[3 * 33]); o.z = pk2(s[4 * 33], s[5 * 33]); o.w = pk2(s[6 * 33], s[7 * 33]);
        *(v4u*)(dst + (size_t)(drow0 + nn) * ldk + k0 + 8 * c) = o; }
    LDS_WAIT(); asm volatile("" ::: "memory");
}
__device__ __forceinline__ int gu_row(int n0, int half) { return n0 < half ? (n0 >> 7) * 256 + (n0 & 127) : ((n0 - half) >> 7) * 256 + 128 + ((n0 - half) & 127); }
__device__ __forceinline__ void p0_prologue(const Args& a, LAS unsigned char* lds, int vcu, int G, int tid) {
    unsigned char* ws = a.ws; const int lane = tid & 63, wave = __builtin_amdgcn_readfirstlane(tid >> 6);
    p0_mod((const float*)a.in[I_C], (const float*)a.in[I_ADAW], (float*)(ws + WS_MODP), vcu, G, tid);
    const int gt = vcu * NTHR + tid, NGT = G * NTHR;
    { const int* pos = (const int*)a.in[I_POS]; float* cosT = (float*)(ws + WS_ROPE); float* sinT = cosT + (size_t)S * 32;
      for (int i = gt; i < S * 32; i += NGT) { const int t = i >> 5, f = i & 31; const float inv = (float)exp(-(double)f * (9.210340371976184 / 32.0));
          const float ang = (float)pos[t] * inv; const double ad = (double)ang;
          const double k = __builtin_rint(ad * 0.15915494309189535); const double r = __builtin_fma(-k, 6.283185307179586, ad) - k * 2.4492935982947064e-16;
          cosT[i] = cosf((float)r); sinT[i] = sinf((float)r); } }
    { const float* aws = (const float*)a.in[I_AWS]; bf16* wt = (bf16*)(ws + WS_WTRIL);
      for (int i = gt; i < 4 * 128 * 128 / 2; i += NGT) { const int e = 2 * i, s = e & 127, t = (e >> 7) & 127; const float v0 = s <= t ? aws[e] : 0.f, v1 = (s + 1) <= t ? aws[e + 1] : 0.f; ((unsigned*)wt)[i] = pk2(v0, v1); } }
    { v4u z = {0u, 0u, 0u, 0u}; v4u* p1 = (v4u*)(ws + WS_WIN1 + (size_t)O_IN * 1024 * 2);
      for (int i = gt; i < (O_INP - O_IN) * 1024 * 2 / 16; i += NGT) p1[i] = z;
      for (int i = gt; i < 4 * 64 * 256 * 2 / 16; i += NGT) { const int h = i / (64 * 32), r = i % (64 * 32); ((v4u*)(ws + WS_WUQ + (size_t)(h * 256 + 192) * 256 * 2))[r] = z; } }
    LAS float* scr = (LAS float*)(lds + wave * 16384);
    const int gw = vcu * NWAVES + wave, NGW = G * NWAVES;
    constexpr int I0 = 16 * 48, I1 = 16 * 32, I2 = 16 * 176, I3 = 44 * 32, I4 = 16 * 66, I5 = 4 * 24, I6 = 4 * 32, I7 = 16 * 32, I8 = 4 * 8, I9 = 8 * 16 * 224, I10 = 8 * 56 * 32;
    constexpr int NITEMS = I0 + I1 + I2 + I3 + I4 + I5 + I6 + I7 + I8 + I9 + I10;
    for (int it = gw; it < NITEMS; it += NGW) {
        int r = it;
        if (r < I9) { const int e = r / (16 * 224), q = r % (16 * 224), kb = q / 224, nb = q % 224;
            conv_item((const float*)a.in[I_MGU] + (size_t)e * 1024 * 7168, 7168, kb * 64, nb * 32, nullptr, (bf16*)(ws + WS_WGUM) + (size_t)e * 7168 * 1024, 1024, gu_row(nb * 32, DFE), scr, lane); continue; } r -= I9;
        if (r < I10) { const int e = r / (56 * 32), q = r % (56 * 32), kb = q / 32, nb = q % 32;
            conv_item((const float*)a.in[I_MDN] + (size_t)e * DFE * 1024, 1024, kb * 64, nb * 32, nullptr, (bf16*)(ws + WS_WDM) + (size_t)e * 1024 * DFE, DFE, nb * 32, scr, lane); continue; } r -= I10;
        if (r < I0) { conv_item((const float*)a.in[I_EWIN], E_IN, (r / 48) * 64, (r % 48) * 32, nullptr, (bf16*)(ws + WS_WIN0), 1024, (r % 48) * 32, scr, lane); continue; } r -= I0;
        if (r < I1) { conv_item((const float*)a.in[I_EWOUT], 1024, (r / 32) * 64, (r % 32) * 32, nullptr, (bf16*)(ws + WS_WOUT0), 1024, (r % 32) * 32, scr, lane); continue; } r -= I1;
        if (r < I2) { conv_item((const float*)a.in[I_FGU], 2 * D_FF, (r / 176) * 64, (r % 176) * 32, nullptr, (bf16*)(ws + WS_WGU0), 1024, gu_row((r % 176) * 32, D_FF), scr, lane); continue; } r -= I2;
        if (r < I3) { conv_item((const float*)a.in[I_FDN], 1024, (r / 32) * 64, (r % 32) * 32, nullptr, (bf16*)(ws + WS_WD0), D_FF, (r % 32) * 32, scr, lane); continue; } r -= I3;
        if (r < I4) { conv_item((const float*)a.in[I_OWIN], O_IN, (r / 66) * 64, (r % 66) * 32, nullptr, (bf16*)(ws + WS_WIN1), 1024, (r % 66) * 32, scr, lane); continue; } r -= I4;
        if (r < I5) { const int n0 = (r % 24) * 32; conv_item((const float*)a.in[I_WUQ], 768, (r / 24) * 64, n0, (const float*)a.in[I_QAN], (bf16*)(ws + WS_WUQ), 256, (n0 / 192) * 256 + n0 % 192, scr, lane); continue; } r -= I5;
        if (r < I6) { conv_item((const float*)a.in[I_WUKV], 1024, (r / 32) * 64, (r % 32) * 32, (const float*)a.in[I_KVN], (bf16*)(ws + WS_WUKV), 256, (r % 32) * 32, scr, lane); continue; } r -= I6;
        if (r < I7) { conv_item((const float*)a.in[I_OWOUT], 1024, (r / 32) * 64, (r % 32) * 32, nullptr, (bf16*)(ws + WS_WOUT1), 1024, (r % 32) * 32, scr, lane); continue; } r -= I7;
        { const int g = r / 8, q = r % 8; conv_item((const float*)a.in[I_BWG] + (size_t)g * 16384, 128, (q / 4) * 64, (q % 4) * 32, nullptr, (bf16*)(ws + WS_WGT) + (size_t)g * 16384, 128, (q % 4) * 32, scr, lane); }
    }
}

__device__ __forceinline__ float modv_partial(const float* modp, const float* ada_b, int layer, int idx) {
    float s = ada_b[layer * 6144 + idx];
#pragma unroll
    for (int ks = 0; ks < 16; ++ks) s += modp[(size_t)(layer * 16 + ks) * 6144 + idx];
    return s;
}
template <bool PARTIAL>
__device__ __forceinline__ void norm_phase(const Args& a, const float* xin, bf16* out, const float* nw, int layer, int off_sh, int off_sc, int gw, int NGW, int lane) {
    const float* modp = (const float*)(a.ws + WS_MODP); const float* modF = (const float*)(a.ws + WS_MODF); const float* ada_b = (const float*)a.in[I_ADAB];
    f32x4 g[4], sh[4];
#pragma unroll
    for (int j = 0; j < 4; ++j)
#pragma unroll
        for (int e = 0; e < 4; ++e) { const int col = 4 * lane + e + 256 * j; float scv, shv;
            if (PARTIAL) { scv = modv_partial(modp, ada_b, layer, off_sc + col); shv = modv_partial(modp, ada_b, layer, off_sh + col); }
            else { scv = modF[layer * 6144 + off_sc + col]; shv = modF[layer * 6144 + off_sh + col]; }
            g[j][e] = nw[col] * (1.f + scv); sh[j][e] = shv; }
    for (int m = gw; m < S; m += NGW) {
        const f32x4* xr = (const f32x4*)(xin + (size_t)m * D) + lane;
        f32x4 v[4]; float s = 0.f;
#pragma unroll
        for (int j = 0; j < 4; ++j) { v[j] = xr[64 * j]; s += (v[j].x * v[j].x + v[j].y * v[j].y) + (v[j].z * v[j].z + v[j].w * v[j].w); }
        const float rstd = 1.f / sqrtf(wave_sum(s) * (1.f / D) + EPS);
        unsigned long long* o8 = (unsigned long long*)(out + (size_t)m * D) + lane;
#pragma unroll
        for (int j = 0; j < 4; ++j) { const f32x4 y = v[j] * rstd * g[j] + sh[j]; o8[64 * j] = (unsigned long long)pk2(y.x, y.y) | ((unsigned long long)pk2(y.z, y.w) << 32); }
    }
}

__device__ __forceinline__ void mixab_phase(const Args& a, LAS unsigned char* lds, int vcu, int G, int tid) {
    const bf16* P0 = (const bf16*)(a.ws + WS_P0); bf16* MIX = (bf16*)(a.ws + WS_MIX);
    const bf16* Wtril = (const bf16*)(a.ws + WS_WTRIL); const bf16* wgT = (const bf16*)(a.ws + WS_WGT);
    const float* ln_w = (const float*)a.in[I_ALNW]; const float* ln_b = (const float*)a.in[I_ALNB]; const float* b_s = (const float*)a.in[I_ABS]; const float* b_sc = (const float*)a.in[I_BSC];
    const int lane = tid & 63, wave = __builtin_amdgcn_readfirstlane(tid >> 6), fr = lane & 15, fq = lane >> 4;
    LAS bf16* vnT = (LAS bf16*)lds;
    LAS bf16* poolS = (LAS bf16*)(lds + 34816);
    LAS bf16* ppS = (LAS bf16*)(lds + 69632);
    LAS float* stat = (LAS float*)(lds + 69632 + 39168);
    for (int u = vcu; u < 512; u += G) {
        const int n = u >> 2, g = u & 3, t0 = n * 128;
        for (int rr = 0; rr < 16; ++rr) { const int row = wave * 16 + rr;
            const v4u raw = *(const v4u*)(P0 + (size_t)(t0 + row) * E_IN + 512 + lane * 8);
            float x[8] = {bflo(raw.x), bfhi(raw.x), bflo(raw.y), bfhi(raw.y), bflo(raw.z), bfhi(raw.z), bflo(raw.w), bfhi(raw.w)};
            float s = 0.f;
#pragma unroll
            for (int j = 0; j < 8; ++j) s += x[j];
            const float mu = wave_sum(s) * (1.f / 512.f); float q = 0.f;
#pragma unroll
            for (int j = 0; j < 8; ++j) { const float d = x[j] - mu; q += d * d; }
            const float rstd = 1.f / sqrtf(wave_sum(q) * (1.f / 512.f) + EPS);
            if (lane == 0) { stat[row * 2] = mu; stat[row * 2 + 1] = rstd; } }
        for (int i = tid; i < 144 * 16; i += NTHR) { const int r = i >> 4, c8 = i & 15, t = t0 - 16 + r; v4u v = {0u, 0u, 0u, 0u};
            if (t >= 0) v = *(const v4u*)(P0 + (size_t)t * E_IN + 1024 + g * 128 + c8 * 8);
            *(LAS v4u*)(ppS + r * 136 + c8 * 8) = v; }
        __syncthreads();
        { const int s = tid & 127, dq = tid >> 7; const float mu = stat[s * 2], rstd = stat[s * 2 + 1];
#pragma unroll
          for (int cc = 0; cc < 4; ++cc) { const int d0 = dq * 32 + cc * 8; const v4u raw = *(const v4u*)(P0 + (size_t)(t0 + s) * E_IN + 512 + g * 128 + d0);
              float x[8] = {bflo(raw.x), bfhi(raw.x), bflo(raw.y), bfhi(raw.y), bflo(raw.z), bfhi(raw.z), bflo(raw.w), bfhi(raw.w)};
#pragma unroll
              for (int j = 0; j < 8; ++j) { const int ch = g * 128 + d0 + j; vnT[(d0 + j) * 136 + s] = (bf16)f2bf((x[j] - mu) * rstd * ln_w[ch] + ln_b[ch]); } } }
        { const int t = tid & 127, q4 = tid >> 7, w = 2 << g, tg = t0 + t; const float inv = 1.f / (float)((tg + 1) < w ? (tg + 1) : w);
#pragma unroll
          for (int cc = 0; cc < 4; ++cc) { const int ch = q4 * 32 + cc * 8; float acc[8] = {0.f, 0.f, 0.f, 0.f, 0.f, 0.f, 0.f, 0.f};
              for (int j = 0; j < w; ++j) { const v4u r = *(const LAS v4u*)(ppS + (16 + t - j) * 136 + ch);
                  acc[0] += bflo(r.x); acc[1] += bfhi(r.x); acc[2] += bflo(r.y); acc[3] += bfhi(r.y); acc[4] += bflo(r.z); acc[5] += bfhi(r.z); acc[6] += bflo(r.w); acc[7] += bfhi(r.w); }
              const v4u c0 = *(const LAS v4u*)(ppS + (16 + t) * 136 + ch);
              v4u o; o.x = pk2(acc[0] * inv - bflo(c0.x), acc[1] * inv - bfhi(c0.x)); o.y = pk2(acc[2] * inv - bflo(c0.y), acc[3] * inv - bfhi(c0.y));
              o.z = pk2(acc[4] * inv - bflo(c0.z), acc[5] * inv - bfhi(c0.z)); o.w = pk2(acc[6] * inv - bflo(c0.w), acc[7] * inv - bfhi(c0.w));
              *(LAS v4u*)(poolS + t * 136 + ch) = o; } }
        __syncthreads();
        const int m0 = wave * 16, trow = t0 + m0 + fr;
        f32x4 acc[8];
#pragma unroll
        for (int nb = 0; nb < 8; ++nb) acc[nb] = (f32x4){0.f, 0.f, 0.f, 0.f};
#pragma unroll
        for (int kk = 0; kk < 4; ++kk) { const bf16x8 af = *(const bf16x8*)(Wtril + ((size_t)g * 128 + m0 + fr) * 128 + kk * 32 + fq * 8);
#pragma unroll
            for (int nb = 0; nb < 8; ++nb) { const bf16x8 bfr = *(const LAS bf16x8*)(vnT + (nb * 16 + fr) * 136 + kk * 32 + fq * 8); acc[nb] = __builtin_amdgcn_mfma_f32_16x16x32_bf16(bfr, af, acc[nb], 0, 0, 0); } }
        { const float bias = b_s[g * 128 + m0 + fr];
#pragma unroll
          for (int nb = 0; nb < 8; ++nb) { const int col = g * 128 + nb * 16 + 4 * fq; const v2u uv = *(const v2u*)(P0 + (size_t)trow * E_IN + col);
              v2u o; o.x = pk2(bflo(uv.x) * (acc[nb][0] + bias), bfhi(uv.x) * (acc[nb][1] + bias)); o.y = pk2(bflo(uv.y) * (acc[nb][2] + bias), bfhi(uv.y) * (acc[nb][3] + bias));
              *(v2u*)(MIX + (size_t)trow * D + col) = o; } }
#pragma unroll
        for (int nb = 0; nb < 8; ++nb) acc[nb] = (f32x4){0.f, 0.f, 0.f, 0.f};
#pragma unroll
        for (int kk = 0; kk < 4; ++kk) { const bf16x8 af = *(const LAS bf16x8*)(poolS + (m0 + fr) * 136 + kk * 32 + fq * 8);
#pragma unroll
            for (int nb = 0; nb < 8; ++nb) { const bf16x8 bfr = *(const bf16x8*)(wgT + ((size_t)g * 128 + nb * 16 + fr) * 128 + kk * 32 + fq * 8); acc[nb] = __builtin_amdgcn_mfma_f32_16x16x32_bf16(bfr, af, acc[nb], 0, 0, 0); } }
#pragma unroll
        for (int nb = 0; nb < 8; ++nb) { const int e = g * 128 + nb * 16 + 4 * fq; const f32x4 sc = *(const f32x4*)(b_sc + e);
            v2u o; o.x = pk2(acc[nb][0] * sc.x, acc[nb][1] * sc.y); o.y = pk2(acc[nb][2] * sc.z, acc[nb][3] * sc.w);
            *(v2u*)(MIX + (size_t)trow * D + 512 + e) = o; }
        __syncthreads();
    }
}

namespace att {
constexpr int KSLOT = 24576, VSLOT = 16384, LDS_K = 0, LDS_V = 2 * KSLOT, LDS_WS = LDS_V + 2 * VSLOT;
constexpr float SCALE = 0.07216878364870323f;
constexpr float THR = 8.f;
__device__ __forceinline__ int k_nope_off(int row, int colB) { return row * 256 + (colB ^ ((row & 7) << 4)); }
__device__ __forceinline__ int k_rope_off(int row, int cB) { return 16384 + row * 128 + (cB ^ (((row >> 1) & 7) << 4)); }
__device__ __forceinline__ int v_st(int k, int c) { const int kk = (k & ~0xC) | ((k & 4) << 1) | ((k & 8) >> 1); return ((kk >> 3) * 4 + (c >> 5)) * 512 + ((kk & 7) * 32 + (c & 31)) * 2; }
__device__ __forceinline__ int v_rd_base(int lane) { return ((lane & 3) << 3) | (((lane >> 2) & 3) << 6) | (((lane >> 4) & 1) << 5) | (((lane >> 5) & 1) << 8); }
constexpr int v_rd_off(int d0, int ks, int half) { return d0 * 512 + ks * 4096 + half * 2048; }
__device__ __forceinline__ int crow(int r, int hi) { return (r & 3) + 8 * (r >> 2) + 4 * hi; }
__device__ __forceinline__ unsigned cvtpk(float lo, float hi) { unsigned r; asm volatile("v_cvt_pk_bf16_f32 %0, %1, %2" : "=v"(r) : "v"(lo), "v"(hi)); return r; }
#define SBAR() __builtin_amdgcn_sched_barrier(0)
__device__ __forceinline__ void mask_tile(f32x16& p0, f32x16& p1, int dq) {
    const float NEG = -__builtin_inff();
#pragma unroll
    for (int r = 0; r < 16; ++r) { const int c = (r & 3) + 8 * (r >> 2); if (dq - c < 0) p0[r] = NEG; if (dq - c - 32 < 0) p1[r] = NEG; }
}
__device__ __forceinline__ void partialSM(f32x16& p0, f32x16& p1, float& m_reg, float& mn, float& alpha) {
    float pmax = p0[0];
#pragma unroll
    for (int r = 1; r < 16; ++r) pmax = fmaxf(pmax, p0[r]);
#pragma unroll
    for (int r = 0; r < 16; ++r) pmax = fmaxf(pmax, p1[r]);
    { auto rr = __builtin_amdgcn_permlane32_swap(__float_as_uint(pmax), __float_as_uint(pmax), false, false); pmax = fmaxf(__uint_as_float(rr[0]), __uint_as_float(rr[1])); }
    constexpr float C2 = 1.4426950408889634f * SCALE;
    if (__builtin_expect(__all((pmax - m_reg) * SCALE <= THR), 1)) { mn = m_reg; alpha = 1.f; }
    else { mn = fmaxf(m_reg, pmax); alpha = __builtin_amdgcn_exp2f((m_reg - mn) * C2); m_reg = mn; }
    const float mnL = -mn * C2;
#pragma unroll
    for (int r = 0; r < 16; ++r) p0[r] = fmaf(p0[r], C2, mnL);
#pragma unroll
    for (int r = 0; r < 16; ++r) p1[r] = fmaf(p1[r], C2, mnL);
#pragma unroll
    for (int r = 0; r < 16; ++r) p0[r] = __builtin_amdgcn_exp2f(p0[r]);
}
__device__ __forceinline__ void finishSM(f32x16& p0, f32x16& p1, float alpha, float& l_reg, bf16x8& pa0, bf16x8& pa1, bf16x8& pa2, bf16x8& pa3) {
#pragma unroll
    for (int r = 0; r < 16; ++r) p1[r] = __builtin_amdgcn_exp2f(p1[r]);
    float ps = 0;
#pragma unroll
    for (int r = 0; r < 16; ++r) ps += p0[r];
#pragma unroll
    for (int r = 0; r < 16; ++r) ps += p1[r];
    { auto rr = __builtin_amdgcn_permlane32_swap(__float_as_uint(ps), __float_as_uint(ps), false, false); ps = __uint_as_float(rr[0]) + __uint_as_float(rr[1]); }
    l_reg = l_reg * alpha + ps;
#define PK4(P, B_, OUT) do { unsigned a0 = cvtpk(P[B_+0], P[B_+1]), a1 = cvtpk(P[B_+2], P[B_+3]);                          \
        unsigned b0 = cvtpk(P[B_+4], P[B_+5]), b1 = cvtpk(P[B_+6], P[B_+7]);                                             \
        auto r0 = __builtin_amdgcn_permlane32_swap(a0, b0, false, false); auto r1 = __builtin_amdgcn_permlane32_swap(a1, b1, false, false); \
        v4u w = {r0[0], r1[0], r0[1], r1[1]}; OUT = __builtin_bit_cast(bf16x8, w); } while (0)
    PK4(p0, 0, pa0); PK4(p0, 8, pa1); PK4(p1, 0, pa2); PK4(p1, 8, pa3);
#undef PK4
}
template <int KB>
__device__ __forceinline__ void qkt(f32x16& p0, f32x16& p1, const LAS char* Kl, int r32, int hi, const bf16x8* qr) {
    p0 = f32x16{}; p1 = f32x16{};
    const LAS char* kb[4];
#pragma unroll
    for (int dd = 0; dd < 4; ++dd) kb[dd] = Kl + KB * KSLOT + k_nope_off(r32, (dd * 16 + hi * 8) * 2);
#pragma unroll
    for (int d0 = 0; d0 < 8; ++d0) { const LAS char* ap = kb[d0 & 3] + (d0 >> 2) * 128;
        const bf16x8 b0 = *(const LAS bf16x8*)ap; const bf16x8 b1 = *(const LAS bf16x8*)(ap + 32 * 256);
        p0 = __builtin_amdgcn_mfma_f32_32x32x16_bf16(b0, qr[d0], p0, 0, 0, 0);
        p1 = __builtin_amdgcn_mfma_f32_32x32x16_bf16(b1, qr[d0], p1, 0, 0, 0); }
#pragma unroll
    for (int dr = 0; dr < 4; ++dr) { const LAS char* ap = Kl + KB * KSLOT + k_rope_off(r32, dr * 32 + hi * 16);
        const bf16x8 b0 = *(const LAS bf16x8*)ap; const bf16x8 b1 = *(const LAS bf16x8*)(ap + 32 * 128);
        p0 = __builtin_amdgcn_mfma_f32_32x32x16_bf16(b0, qr[8 + dr], p0, 0, 0, 0);
        p1 = __builtin_amdgcn_mfma_f32_32x32x16_bf16(b1, qr[8 + dr], p1, 0, 0, 0); }
}
template <int VB>
__device__ __forceinline__ void pv_tile(f32x16* o, int vb0, bf16x8 pa0, bf16x8 pa1, bf16x8 pa2, bf16x8 pa3) {
#define TRRD(dst, off) asm volatile("ds_read_b64_tr_b16 %0, %1 offset:%2" : "=&v"(dst) : "v"(vb0), "i"(off) : "memory")
#define PV_D0(d0) do { s16x4 l0, l1, l2, l3, h0, h1, h2, h3; constexpr int b_ = VB * VSLOT + v_rd_off(d0, 0, 0); \
        TRRD(l0, b_); TRRD(h0, b_ + 2048); TRRD(l1, b_ + 4096); TRRD(h1, b_ + 6144); TRRD(l2, b_ + 8192); TRRD(h2, b_ + 10240); TRRD(l3, b_ + 12288); TRRD(h3, b_ + 14336); \
        asm volatile("s_waitcnt lgkmcnt(0)" ::: "memory"); SBAR(); \
        o[d0] = __builtin_amdgcn_mfma_f32_32x32x16_bf16(pa0, (bf16x8){l0[0], l0[1], l0[2], l0[3], h0[0], h0[1], h0[2], h0[3]}, o[d0], 0, 0, 0);   \
        o[d0] = __builtin_amdgcn_mfma_f32_32x32x16_bf16(pa1, (bf16x8){l1[0], l1[1], l1[2], l1[3], h1[0], h1[1], h1[2], h1[3]}, o[d0], 0, 0, 0);   \
        o[d0] = __builtin_amdgcn_mfma_f32_32x32x16_bf16(pa2, (bf16x8){l2[0], l2[1], l2[2], l2[3], h2[0], h2[1], h2[2], h2[3]}, o[d0], 0, 0, 0);   \
        o[d0] = __builtin_amdgcn_mfma_f32_32x32x16_bf16(pa3, (bf16x8){l3[0], l3[1], l3[2], l3[3], h3[0], h3[1], h3[2], h3[3]}, o[d0], 0, 0, 0); } while (0)
    PV_D0(0); PV_D0(1); PV_D0(2); PV_D0(3);
#undef PV_D0
#undef TRRD
}
__device__ __forceinline__ void glds16(const void* gsrc, unsigned lds_dst) { unsigned keep;
    asm volatile("s_mov_b32 %0, m0\n\ts_mov_b32 m0, %2\n\ts_nop 0\n\tglobal_load_lds_dwordx4 %1, off\n\ts_mov_b32 m0, %0" : "=&s"(keep) : "v"(gsrc), "s"(lds_dst) : "memory"); }
#define WAITBAR0() asm volatile("s_waitcnt vmcnt(0) lgkmcnt(0)\n\ts_barrier" ::: "memory")

__device__ __forceinline__ void attn_block(int h, int qb, int j_lo, int j_hi, int part, const bf16* QF, const unsigned char* KIMG, const unsigned char* VIMG, bf16* MIX, float* PART, float* PML, char* lds) {
    const int tid = threadIdx.x, wid = __builtin_amdgcn_readfirstlane(tid >> 6), lane = tid & 63, r32 = lane & 31, hi = lane >> 5;
    const int NT = j_hi - j_lo, q0 = qb * 256, qlo = q0 + wid * 32, qm = qlo + r32 - 4 * hi;
    const unsigned lds0 = (unsigned)(uintptr_t)lds;
    const LAS char* Kl = (const LAS char*)lds + LDS_K;
    LAS float* wsf = (LAS float*)((LAS char*)lds + LDS_WS) + wid * 64; LAS float* li_l = wsf; LAS float* al_l = wsf + 32;
    const int vb0 = (int)(lds0 + LDS_V) + v_rd_base(lane);
    const unsigned char* kimg = KIMG + ((size_t)h * 256 + j_lo) * KSLOT + (size_t)(3 * wid) * 1024 + lane * 16;
    const unsigned char* vimg = VIMG + ((size_t)h * 256 + j_lo) * VSLOT + (size_t)(2 * wid) * 1024 + lane * 16;
    const unsigned kdst = lds0 + LDS_K + (3 * wid) * 1024, vdst = lds0 + LDS_V + (2 * wid) * 1024;
#define DMA_K(t, slot) do { const unsigned char* s_ = kimg + (size_t)(t) * KSLOT; const unsigned d_ = (unsigned)__builtin_amdgcn_readfirstlane(kdst + (slot) * KSLOT); \
        glds16(s_, d_); glds16(s_ + 1024, d_ + 1024); glds16(s_ + 2048, d_ + 2048); } while (0)
#define DMA_V(t, slot) do { const unsigned char* s_ = vimg + (size_t)(t) * VSLOT; const unsigned d_ = (unsigned)__builtin_amdgcn_readfirstlane(vdst + (slot) * VSLOT); \
        glds16(s_, d_); glds16(s_ + 1024, d_ + 1024); } while (0)
    DMA_K(0, 0);
    bf16x8 qr[12];
    { const bf16* qp = QF + ((size_t)h * S + q0 + wid * 32 + r32) * 192 + hi * 8;
#pragma unroll
      for (int d0 = 0; d0 < 12; ++d0) qr[d0] = *(const bf16x8*)(qp + d0 * 16); }
    float m_reg = -1e30f, l_reg = 0.f; f32x16 o[4]; o[0] = f32x16{}; o[1] = f32x16{}; o[2] = f32x16{}; o[3] = f32x16{};
    f32x16 pA0, pA1, pB0, pB1; float mnA, mnB, alA = 1.f, alB = 1.f; bf16x8 pa0, pa1, pa2, pa3;
#define RESC(a_) do { if (__any((a_) < 1.f)) { if (hi == 0) al_l[r32] = (a_); asm volatile("s_waitcnt lgkmcnt(0)" ::: "memory"); \
        _Pragma("unroll") for (int d_ = 0; d_ < 4; ++d_) _Pragma("unroll") for (int r = 0; r < 16; ++r) o[d_][r] *= al_l[crow(r, hi)]; } } while (0)
#define MASKT(P0_, P1_, t) do { const int kb_ = (j_lo + (t)) * 64; if (kb_ + 63 > qlo) mask_tile(P0_, P1_, qm - kb_); } while (0)
    WAITBAR0();
    DMA_K(1, 1); DMA_V(0, 0);
    SBAR(); qkt<0>(pA0, pA1, Kl, r32, hi, qr); MASKT(pA0, pA1, 0); partialSM(pA0, pA1, m_reg, mnA, alA);
#define STEP(PX0, PX1, mnX, alX, PY0, PY1, alY, t, KB, VB) do { \
        WAITBAR0(); \
        if ((t) + 1 < NT) DMA_K((t) + 1, (KB) ^ 1); DMA_V((t), (VB) ^ 1); \
        SBAR(); qkt<KB>(PX0, PX1, Kl, r32, hi, qr); \
        finishSM(PY0, PY1, alY, l_reg, pa0, pa1, pa2, pa3); SBAR(); \
        pv_tile<VB>(o, vb0, pa0, pa1, pa2, pa3); MASKT(PX0, PX1, (t)); partialSM(PX0, PX1, m_reg, mnX, alX); \
        RESC(alX); } while (0)
    int t = 1;
    for (; t + 1 < NT; t += 2) {
        STEP(pB0, pB1, mnB, alB, pA0, pA1, alA, t, 1, 0);
        STEP(pA0, pA1, mnA, alA, pB0, pB1, alB, t + 1, 0, 1);
    }
    STEP(pB0, pB1, mnB, alB, pA0, pA1, alA, NT - 1, 1, 0);
    WAITBAR0();
    finishSM(pB0, pB1, alB, l_reg, pa0, pa1, pa2, pa3); SBAR();
    pv_tile<1>(o, vb0, pa0, pa1, pa2, pa3);
    if (part < 0) {
    if (hi == 0) li_l[r32] = l_reg; asm volatile("s_waitcnt lgkmcnt(0)" ::: "memory");
    float rli[16];
#pragma unroll
    for (int r = 0; r < 16; ++r) rli[r] = __builtin_amdgcn_rcpf(li_l[crow(r, hi)]);
    bf16* Ow = MIX + (size_t)(q0 + wid * 32) * D + 512 + h * 128;
#pragma unroll
    for (int r = 0; r < 16; ++r) { const int orow = crow(r, hi);
#pragma unroll
        for (int d0 = 0; d0 < 4; ++d0) { const float v = o[d0][r] * rli[r]; const float vn = __shfl_xor(v, 1);
            if ((r32 & 1) == 0) *(unsigned*)(Ow + (size_t)orow * D + d0 * 32 + r32) = cvtpk(v, vn); } }
    } else {
    float* Pw = PART + ((size_t)part * 256 + wid * 32) * 128;
#pragma unroll
    for (int r = 0; r < 16; ++r) { const int orow = crow(r, hi);
#pragma unroll
        for (int d0 = 0; d0 < 4; ++d0) Pw[(size_t)orow * 128 + d0 * 32 + r32] = o[d0][r]; }
    if (hi == 0) { float* ml = PML + ((size_t)part * 256 + wid * 32 + r32) * 2; ml[0] = m_reg; ml[1] = l_reg; }
    }
    asm volatile("s_waitcnt lgkmcnt(0)\n\ts_barrier" ::: "memory");
#undef DMA_K
#undef DMA_V
#undef RESC
#undef MASKT
#undef STEP
}
}

__device__ __forceinline__ void fin_phase(const Args& a, int gw, int NGW, int lane) {
    unsigned char* ws = a.ws;
    const bf16* P1 = (const bf16*)(ws + WS_P1); const bf16* QR = (const bf16*)(ws + WS_QR); const bf16* KVR = (const bf16*)(ws + WS_KVR);
    bf16* QF = (bf16*)(ws + WS_QF); unsigned char* KIMG = ws + WS_KIMG; unsigned char* VIMG = ws + WS_VIMG; bf16* MIX = (bf16*)(ws + WS_MIX);
    const float* cosT = (const float*)(ws + WS_ROPE); const float* sinT = cosT + (size_t)S * 32;
    const float* qnw = (const float*)a.in[I_QNW]; const float* knw = (const float*)a.in[I_KNW]; const float* cw = (const float*)a.in[I_CONV];
    const int hl = lane & 15, h = lane >> 4, c4 = lane & 3;
    float wq[16], wk[16], wkr[16];
#pragma unroll
    for (int e = 0; e < 16; ++e) { wq[e] = hl < 12 ? qnw[hl * 16 + e] : 0.f; wk[e] = hl < 8 ? knw[hl * 16 + e] : 0.f; wkr[e] = knw[128 + c4 * 16 + e]; }
    float cw0[8], cw1[8], cw2[8];
#pragma unroll
    for (int e = 0; e < 8; ++e) { cw0[e] = cw[lane * 8 + e]; cw1[e] = cw[512 + lane * 8 + e]; cw2[e] = cw[1024 + lane * 8 + e]; }
    for (int t = gw; t < S; t += NGW) {
        const bf16* prow = P1 + (size_t)t * O_INP;
        float s_q, s_kv;
        { const v2u r = *(const v2u*)(prow + 1536 + lane * 4); const float x0 = bflo(r.x), x1 = bfhi(r.x), x2 = bflo(r.y), x3 = bfhi(r.y);
          s_q = 1.f / sqrtf(wave_sum((x0 * x0 + x1 * x1) + (x2 * x2 + x3 * x3)) * (1.f / 256.f) + EPS); }
        { const v2u r = *(const v2u*)(prow + 1792 + lane * 4); const float x0 = bflo(r.x), x1 = bfhi(r.x), x2 = bflo(r.y), x3 = bfhi(r.y);
          s_kv = 1.f / sqrtf(wave_sum((x0 * x0 + x1 * x1) + (x2 * x2 + x3 * x3)) * (1.f / 256.f) + EPS); }
        const int fi = (hl & 1) * 16;
        float cs[16], sn[16];
        { const f32x4* cp = (const f32x4*)(cosT + (size_t)t * 32 + fi); const f32x4* sp = (const f32x4*)(sinT + (size_t)t * 32 + fi);
#pragma unroll
          for (int q = 0; q < 4; ++q) { const f32x4 c_ = cp[q], s_ = sp[q]; cs[4 * q] = c_.x; cs[4 * q + 1] = c_.y; cs[4 * q + 2] = c_.z; cs[4 * q + 3] = c_.w; sn[4 * q] = s_.x; sn[4 * q + 1] = s_.y; sn[4 * q + 2] = s_.z; sn[4 * q + 3] = s_.w; } }
        { const v4u r0 = *(const v4u*)(QR + (size_t)t * 1024 + lane * 16), r1 = *(const v4u*)(QR + (size_t)t * 1024 + lane * 16 + 8);
          float x[16] = {bflo(r0.x), bfhi(r0.x), bflo(r0.y), bfhi(r0.y), bflo(r0.z), bfhi(r0.z), bflo(r0.w), bfhi(r0.w), bflo(r1.x), bfhi(r1.x), bflo(r1.y), bfhi(r1.y), bflo(r1.z), bfhi(r1.z), bflo(r1.w), bfhi(r1.w)};
          float ss = 0.f;
#pragma unroll
          for (int e = 0; e < 16; ++e) { x[e] *= s_q; ss += x[e] * x[e]; }
          ss += __shfl_xor(ss, 1); ss += __shfl_xor(ss, 2); ss += __shfl_xor(ss, 4); ss += __shfl_xor(ss, 8);
          const float rq = 1.f / sqrtf(ss * (1.f / 192.f) + EPS);
          float y[16];
#pragma unroll
          for (int e = 0; e < 16; ++e) { const float v = x[e] * rq * wq[e]; const float pr = __shfl_xor(v, 2);
              y[e] = hl < 8 ? v : (hl < 10 ? v * cs[e] - pr * sn[e] : v * cs[e] + pr * sn[e]); }
          if (hl < 12) { v4u o0, o1; o0.x = pk2(y[0], y[1]); o0.y = pk2(y[2], y[3]); o0.z = pk2(y[4], y[5]); o0.w = pk2(y[6], y[7]); o1.x = pk2(y[8], y[9]); o1.y = pk2(y[10], y[11]); o1.z = pk2(y[12], y[13]); o1.w = pk2(y[14], y[15]);
              bf16* qd = QF + ((size_t)h * S + t) * 192 + hl * 16; *(v4u*)qd = o0; *(v4u*)(qd + 8) = o1; } }
        { const v4u r0 = *(const v4u*)(KVR + (size_t)t * 1024 + lane * 16), r1 = *(const v4u*)(KVR + (size_t)t * 1024 + lane * 16 + 8);
          float x[16] = {bflo(r0.x), bfhi(r0.x), bflo(r0.y), bfhi(r0.y), bflo(r0.z), bfhi(r0.z), bflo(r0.w), bfhi(r0.w), bflo(r1.x), bfhi(r1.x), bflo(r1.y), bfhi(r1.y), bflo(r1.z), bfhi(r1.z), bflo(r1.w), bfhi(r1.w)};
          const v4u p0 = *(const v4u*)(prow + 2048 + c4 * 16), p1 = *(const v4u*)(prow + 2048 + c4 * 16 + 8);
          float kp[16] = {bflo(p0.x), bfhi(p0.x), bflo(p0.y), bfhi(p0.y), bflo(p0.z), bfhi(p0.z), bflo(p0.w), bfhi(p0.w), bflo(p1.x), bfhi(p1.x), bflo(p1.y), bfhi(p1.y), bflo(p1.z), bfhi(p1.z), bflo(p1.w), bfhi(p1.w)};
          float ssk = 0.f, ssp = 0.f;
#pragma unroll
          for (int e = 0; e < 16; ++e) { x[e] *= s_kv; ssk += x[e] * x[e]; ssp += kp[e] * kp[e]; }
          if (hl >= 8) ssk = 0.f;
          ssk += __shfl_xor(ssk, 1); ssk += __shfl_xor(ssk, 2); ssk += __shfl_xor(ssk, 4); ssk += __shfl_xor(ssk, 8);
          ssp += __shfl_xor(ssp, 1); ssp += __shfl_xor(ssp, 2);
          const float rk = 1.f / sqrtf((ssk + ssp) * (1.f / 192.f) + EPS);
          const int krow = t & 63, tile = t >> 6;
          unsigned char* kt = KIMG + ((size_t)h * 256 + tile) * att::KSLOT; unsigned char* vt = VIMG + ((size_t)h * 256 + tile) * att::VSLOT;
          float y[16];
#pragma unroll
          for (int e = 0; e < 16; ++e) y[e] = hl < 8 ? x[e] * rk * wk[e] : x[e];
          { v4u o0, o1; o0.x = pk2(y[0], y[1]); o0.y = pk2(y[2], y[3]); o0.z = pk2(y[4], y[5]); o0.w = pk2(y[6], y[7]); o1.x = pk2(y[8], y[9]); o1.y = pk2(y[10], y[11]); o1.z = pk2(y[12], y[13]); o1.w = pk2(y[14], y[15]);
            if (hl < 8) { *(v4u*)(kt + att::k_nope_off(krow, hl * 32)) = o0; *(v4u*)(kt + att::k_nope_off(krow, hl * 32 + 16)) = o1; }
            else { *(v4u*)(vt + att::v_st(krow, (hl - 8) * 16)) = o0; *(v4u*)(vt + att::v_st(krow, (hl - 8) * 16 + 8)) = o1; } }
          float z[16];
#pragma unroll
          for (int e = 0; e < 16; ++e) { const float v = kp[e] * rk * wkr[e]; const float pr = __shfl_xor(v, 2); z[e] = c4 < 2 ? v * cs[e] - pr * sn[e] : v * cs[e] + pr * sn[e]; }
          if (hl < 4) { v4u o0, o1; o0.x = pk2(z[0], z[1]); o0.y = pk2(z[2], z[3]); o0.z = pk2(z[4], z[5]); o0.w = pk2(z[6], z[7]); o1.x = pk2(z[8], z[9]); o1.y = pk2(z[10], z[11]); o1.z = pk2(z[12], z[13]); o1.w = pk2(z[14], z[15]);
              *(v4u*)(kt + att::k_rope_off(krow, c4 * 32)) = o0; *(v4u*)(kt + att::k_rope_off(krow, c4 * 32 + 16)) = o1; } }
        { const int ch = lane * 8; float conv[8] = {0.f, 0.f, 0.f, 0.f, 0.f, 0.f, 0.f, 0.f};
#pragma unroll
          for (int k = 0; k < 3; ++k) { const int tt = t - 2 + k; if (tt >= 0) { const bf16* pr = P1 + (size_t)tt * O_INP; const v4u cg = *(const v4u*)(pr + 512 + ch), hh = *(const v4u*)(pr + 1024 + ch);
              const float* wv = k == 0 ? cw0 : (k == 1 ? cw1 : cw2);
              conv[0] += wv[0] * bflo(cg.x) * bflo(hh.x); conv[1] += wv[1] * bfhi(cg.x) * bfhi(hh.x); conv[2] += wv[2] * bflo(cg.y) * bflo(hh.y); conv[3] += wv[3] * bfhi(cg.y) * bfhi(hh.y);
              conv[4] += wv[4] * bflo(cg.z) * bflo(hh.z); conv[5] += wv[5] * bfhi(cg.z) * bfhi(hh.z); conv[6] += wv[6] * bflo(cg.w) * bflo(hh.w); conv[7] += wv[7] * bfhi(cg.w) * bfhi(hh.w); } }
          const v4u bg = *(const v4u*)(prow + ch);
          v4u o; o.x = pk2(bflo(bg.x) * conv[0], bfhi(bg.x) * conv[1]); o.y = pk2(bflo(bg.y) * conv[2], bfhi(bg.y) * conv[3]); o.z = pk2(bflo(bg.z) * conv[4], bfhi(bg.z) * conv[5]); o.w = pk2(bflo(bg.w) * conv[6], bfhi(bg.w) * conv[7]);
          *(v4u*)(MIX + (size_t)t * D + ch) = o; }
    }
}

__device__ __forceinline__ void route1_phase(const Args& a, LAS unsigned char* lds, int vcu, int G, int tid) {
    unsigned char* ws = a.ws; const float* XR = (const float*)(ws + WS_XR); const float* modF = (const float*)(ws + WS_MODF) + 6144;
    const float* nw = (const float*)a.in[I_NFW] + 1024; const float* rw = (const float*)a.in[I_RW];
    unsigned* tok = (unsigned*)(ws + WS_TOK); unsigned* cnt = (unsigned*)(ws + WS_CTL) + CW_CNT;
    const int lane = tid & 63, wave = __builtin_amdgcn_readfirstlane(tid >> 6);
    LAS int* tokE = (LAS int*)lds;
    LAS int* tokL = (LAS int*)(lds + 512);
    LAS int* offS = (LAS int*)(lds + 1024);
    f32x4 g[4], sh[4];
#pragma unroll
    for (int j = 0; j < 4; ++j)
#pragma unroll
        for (int e = 0; e < 4; ++e) { const int col = 4 * lane + e + 256 * j; g[j][e] = nw[col] * (1.f + modF[OFF_SCF + col]); sh[j][e] = modF[OFF_SHF + col]; }
    for (int chunk = vcu; chunk < S / 64; chunk += G) {
        for (int i = 0; i < 8; ++i) { const int ti = wave * 8 + i, t = chunk * 64 + ti;
            const f32x4* xr = (const f32x4*)(XR + (size_t)t * D) + lane; f32x4 v[4]; float s = 0.f;
#pragma unroll
            for (int j = 0; j < 4; ++j) { v[j] = xr[64 * j]; s += (v[j].x * v[j].x + v[j].y * v[j].y) + (v[j].z * v[j].z + v[j].w * v[j].w); }
            const float rstd = 1.f / sqrtf(wave_sum(s) * (1.f / D) + EPS);
            float lg[8] = {0.f, 0.f, 0.f, 0.f, 0.f, 0.f, 0.f, 0.f};
#pragma unroll
            for (int j = 0; j < 4; ++j) { const f32x4 hv = v[j] * rstd * g[j] + sh[j];
#pragma unroll
                for (int e = 0; e < 4; ++e) { const int col = 4 * lane + e + 256 * j; const f32x4 w0 = *(const f32x4*)(rw + col * 8), w1 = *(const f32x4*)(rw + col * 8 + 4); const float hx = hv[e];
                    lg[0] += hx * w0.x; lg[1] += hx * w0.y; lg[2] += hx * w0.z; lg[3] += hx * w0.w; lg[4] += hx * w1.x; lg[5] += hx * w1.y; lg[6] += hx * w1.z; lg[7] += hx * w1.w; } }
#pragma unroll
            for (int e = 0; e < 8; ++e) lg[e] = wave_sum(lg[e]);
            int e1 = 0; float l1 = lg[0];
#pragma unroll
            for (int e = 1; e < 8; ++e) if (lg[e] > l1) { l1 = lg[e]; e1 = e; }
            int e2 = -1; float l2 = -__builtin_inff();
#pragma unroll
            for (int e = 0; e < 8; ++e) if (e != e1 && lg[e] > l2) { l2 = lg[e]; e2 = e; }
            const float g1 = 1.f / (1.f + __expf(l2 - l1)), g2 = 1.f - g1;
            if (lane == 0) { unsigned* rec = tok + (size_t)t * 8; rec[0] = (unsigned)e1; rec[1] = (unsigned)e2; rec[4] = __float_as_uint(g1); rec[5] = __float_as_uint(g2); rec[6] = __float_as_uint(rstd);
                tokE[2 * ti] = e1; tokE[2 * ti + 1] = e2; } }
        __syncthreads();
        if (tid < 8) { int c = 0; for (int i = 0; i < 128; ++i) if (tokE[i] == tid) { tokL[i] = c; ++c; }
            offS[tid] = (int)__hip_atomic_fetch_add(cnt + 64 * tid, (unsigned)c, RLX_AGENT); }
        __syncthreads();
        if (tid < 128) { const int t = chunk * 64 + (tid >> 1); tok[(size_t)t * 8 + 2 + (tid & 1)] = (unsigned)(offS[tokE[tid]] + tokL[tid]); }
        __syncthreads();
    }
}
__device__ __forceinline__ void route2_phase(const Args& a, int gw, int NGW, int lane) {
    unsigned char* ws = a.ws; const float* XR = (const float*)(ws + WS_XR); const float* modF = (const float*)(ws + WS_MODF) + 6144;
    const float* nw = (const float*)a.in[I_NFW] + 1024; unsigned* tok = (unsigned*)(ws + WS_TOK); const unsigned* cnt = (const unsigned*)(ws + WS_CTL) + CW_CNT;
    bf16* AM = (bf16*)(ws + WS_AMOE);
    f32x4 g[4], sh[4];
#pragma unroll
    for (int j = 0; j < 4; ++j)
#pragma unroll
        for (int e = 0; e < 4; ++e) { const int col = 4 * lane + e + 256 * j; g[j][e] = nw[col] * (1.f + modF[OFF_SCF + col]); sh[j][e] = modF[OFF_SHF + col]; }
    int base[8]; { int b = 0;
#pragma unroll
      for (int e = 0; e < 8; ++e) { base[e] = b; b += (int)((cnt[64 * e] + 255u) >> 8) * 256; } }
    for (int t = gw; t < S; t += NGW) {
        unsigned* rec = tok + (size_t)t * 8; const int e1 = (int)rec[0], e2 = (int)rec[1]; const float rstd = __uint_as_float(rec[6]);
        int b1 = 0, b2 = 0;
#pragma unroll
        for (int e = 0; e < 8; ++e) { b1 = e1 == e ? base[e] : b1; b2 = e2 == e ? base[e] : b2; }
        const int s1 = b1 + (int)rec[2], s2 = b2 + (int)rec[3];
        const f32x4* xr = (const f32x4*)(XR + (size_t)t * D) + lane;
        unsigned long long* o1 = (unsigned long long*)(AM + (size_t)s1 * D) + lane; unsigned long long* o2 = (unsigned long long*)(AM + (size_t)s2 * D) + lane;
#pragma unroll
        for (int j = 0; j < 4; ++j) { const f32x4 y = xr[64 * j] * rstd * g[j] + sh[j]; const unsigned long long w = (unsigned long long)pk2(y.x, y.y) | ((unsigned long long)pk2(y.z, y.w) << 32); o1[64 * j] = w; o2[64 * j] = w; }
        if (lane == 0) { rec[2] = (unsigned)s1; rec[3] = (unsigned)s2; }
    }
}
__device__ __forceinline__ void combine_phase(const Args& a, int gw, int NGW, int lane) {
    unsigned char* ws = a.ws; const float* XR = (const float*)(ws + WS_XR); const float* gf = (const float*)(ws + WS_MODF) + 6144 + OFF_GF;
    const unsigned* tok = (const unsigned*)(ws + WS_TOK); const bf16* Y = (const bf16*)(ws + WS_AMOE);
    f32x4 gg[4];
#pragma unroll
    for (int j = 0; j < 4; ++j) gg[j] = *(const f32x4*)(gf + 4 * lane + 256 * j);
    for (int t = gw; t < S; t += NGW) {
        const unsigned* rec = tok + (size_t)t * 8; const int s1 = (int)rec[2], s2 = (int)rec[3]; const float g1 = __uint_as_float(rec[4]), g2 = __uint_as_float(rec[5]);
        const f32x4* xr = (const f32x4*)(XR + (size_t)t * D) + lane; f32x4* orow = (f32x4*)(a.out + (size_t)t * D) + lane;
        const v2u* y1 = (const v2u*)(Y + (size_t)s1 * D) + lane; const v2u* y2 = (const v2u*)(Y + (size_t)s2 * D) + lane;
#pragma unroll
        for (int j = 0; j < 4; ++j) { const v2u a1 = y1[64 * j], a2 = y2[64 * j];
            f32x4 m; m.x = g1 * bflo(a1.x) + g2 * bflo(a2.x); m.y = g1 * bfhi(a1.x) + g2 * bfhi(a2.x); m.z = g1 * bflo(a1.y) + g2 * bflo(a2.y); m.w = g1 * bfhi(a1.y) + g2 * bfhi(a2.y);
            orow[64 * j] = xr[64 * j] + gg[j] * m; }
    }
}

constexpr int N_PHASES = 19;
__global__ void __launch_bounds__(NTHR, 2) fwd_kernel(Args args) {
    extern __shared__ __attribute__((aligned(16))) unsigned char lds[];
    LAS unsigned char* L = (LAS unsigned char*)lds;
    const int tid = threadIdx.x, lane = tid & 63, wave = __builtin_amdgcn_readfirstlane(tid >> 6);
    const int G = gridDim.x; const int bx = blockIdx.x; const int vcu = (G % 8 == 0) ? (bx % 8) * (G / 8) + bx / 8 : bx;
    const int gw = vcu * NWAVES + wave, NGW = G * NWAVES;
    unsigned char* ws = args.ws;
    for (int u = tid; u < (LDS_BYTES - LDSCTL_OFF) / 4; u += NTHR) ((LAS unsigned*)(L + LDSCTL_OFF))[u] = 0u;
    __syncthreads();
    XcdBarrier bar; bar.bar = (unsigned*)(ws + WS_CTL) + CW_BAR; bar.x = 0; bar.st = nullptr;
#if !MK_MULTI
    bar = xcd_barrier_post((unsigned*)(ws + WS_CTL) + CW_BAR, (volatile LAS unsigned*)(L + MISC_OFF) + 8);
#define GRID_BAR() xcd_barrier(bar)
#else
#define GRID_BAR() do {} while (0)
#endif
    const int lo = args.ph_lo, hi = args.ph_hi;
#define IN(k) (lo <= (k) && (k) < hi)
#define BOTH(k) (IN(k) && IN((k) + 1))
    const float* modF = (const float*)(ws + WS_MODF);
    bf16* ABUF = (bf16*)(ws + WS_ABUF); bf16* MIX = (bf16*)(ws + WS_MIX); float* XR = (float*)(ws + WS_XR);

    if (IN(0)) { p0_prologue(args, L, vcu, G, tid); if (DBG_REP == 0) { GRID_BAR(); p0_prologue(args, L, vcu, G, tid); } if (BOTH(0)) GRID_BAR(); }
    if (IN(1)) {
        { float* mf = (float*)(ws + WS_MODF); for (int i = vcu * NTHR + tid; i < 2 * 6144; i += G * NTHR) mf[i] = modv_partial((const float*)(ws + WS_MODP), (const float*)args.in[I_ADAB], i / 6144, i % 6144); }
        norm_phase<true>(args, (const float*)args.in[I_X], ABUF, (const float*)args.in[I_NMW], 0, OFF_SHM, OFF_SCM, gw, NGW, lane);
        if (BOTH(1)) GRID_BAR(); }
    if (IN(2)) { pg8::Gemm g{ABUF, (const bf16*)(ws + WS_WIN0), 1024, 1024}; pg8::StaticOrder So; So.init(S, E_IN, G, bx);
        pg8::EpiBf16G E{(bf16*)(ws + WS_P0), E_IN, 4}; pg8::gemm_phase(L, g, So, E); if (BOTH(2)) GRID_BAR(); }
    if (IN(3)) { mixab_phase(args, L, vcu, G, tid); if (BOTH(3)) GRID_BAR(); }
    if (IN(4)) { pg8::Gemm g{MIX, (const bf16*)(ws + WS_WOUT0), 1024, 1024}; pg8::StaticOrder So; So.init(S, 1024, G, bx);
        pg8::EpiRes E{(const float*)args.in[I_X], XR, modF + OFF_GM}; pg8::gemm_phase(L, g, So, E); if (BOTH(4)) GRID_BAR(); }
    if (IN(5)) { norm_phase<false>(args, XR, ABUF, (const float*)args.in[I_NFW], 0, OFF_SHF, OFF_SCF, gw, NGW, lane); if (BOTH(5)) GRID_BAR(); }
    if (IN(6)) { pg8::Gemm g{ABUF, (const bf16*)(ws + WS_WGU0), 1024, 1024}; pg8::StaticOrder So; So.init(S, 2 * D_FF, G, bx);
        pg8::EpiSwiGLU E{(bf16*)(ws + WS_H), D_FF}; pg8::gemm_phase(L, g, So, E); if (BOTH(6)) GRID_BAR(); }
    if (IN(7)) { pg8::Gemm g{(const bf16*)(ws + WS_H), (const bf16*)(ws + WS_WD0), D_FF, D_FF}; pg8::StaticOrder So; So.init(S, 1024, G, bx);
        pg8::EpiRes E{XR, XR, modF + OFF_GF}; pg8::gemm_phase(L, g, So, E); if (BOTH(7)) GRID_BAR(); }
    if (IN(8)) { norm_phase<false>(args, XR, ABUF, (const float*)args.in[I_NMW] + 1024, 1, OFF_SHM, OFF_SCM, gw, NGW, lane); if (BOTH(8)) GRID_BAR(); }
    if (IN(9)) { pg8::Gemm g{ABUF, (const bf16*)(ws + WS_WIN1), 1024, 1024}; pg8::StaticOrder So; So.init(S, O_INP, G, bx);
        pg8::EpiBf16G E{(bf16*)(ws + WS_P1), O_INP, 0}; pg8::gemm_phase(L, g, So, E); if (BOTH(9)) GRID_BAR(); }
    if (IN(10)) {
        { pg8::Gemm g{(const bf16*)(ws + WS_P1) + 1536, (const bf16*)(ws + WS_WUQ), O_INP, 256}; pg8::StaticOrder So; So.init(S, 1024, G, bx);
          pg8::EpiBf16G E{(bf16*)(ws + WS_QR), 1024, 0}; pg8::gemm_phase(L, g, So, E); }
        { pg8::Gemm g{(const bf16*)(ws + WS_P1) + 1792, (const bf16*)(ws + WS_WUKV), O_INP, 256}; pg8::StaticOrder So; So.init(S, 1024, G, bx);
          pg8::EpiBf16G E{(bf16*)(ws + WS_KVR), 1024, 0}; pg8::gemm_phase(L, g, So, E); }
        if (BOTH(10)) GRID_BAR(); }
    if (IN(11)) { fin_phase(args, gw, NGW, lane); if (BOTH(11)) GRID_BAR(); }
    if (IN(12)) {
        for (int rep = 0; rep < (DBG_REP == 12 ? 2 : 1); ++rep) { if (rep) GRID_BAR();
        for (int u = bx; u < 256; u += G) { const int h = u & 3, v = u >> 2, sb = v >> 1, role = v & 1, nA = 126 - 4 * sb, pi = (h * 32 + sb) * 2;
            const bf16* QF = (const bf16*)(ws + WS_QF); float* PART = (float*)(ws + WS_PART); float* PML = (float*)(ws + WS_PML);
            if (role == 0) { att::attn_block(h, sb, 0, 4 * (sb + 1), -1, QF, ws + WS_KIMG, ws + WS_VIMG, MIX, PART, PML, (char*)lds);
                             att::attn_block(h, 63 - sb, 0, nA, pi, QF, ws + WS_KIMG, ws + WS_VIMG, MIX, PART, PML, (char*)lds); }
            else att::attn_block(h, 63 - sb, nA, 4 * (64 - sb), pi + 1, QF, ws + WS_KIMG, ws + WS_VIMG, MIX, PART, PML, (char*)lds); } }
        GRID_BAR();
        { const float* PART = (const float*)(ws + WS_PART); const float* PML = (const float*)(ws + WS_PML); constexpr float C2 = 1.4426950408889634f * att::SCALE;
          for (int rw = gw; rw < 128 * 256; rw += NGW) { const int blk = rw >> 8, row = rw & 255, h = blk >> 5, sb = blk & 31, pi = blk * 2;
              const float mA = PML[((size_t)pi * 256 + row) * 2], lA = PML[((size_t)pi * 256 + row) * 2 + 1], mB = PML[((size_t)(pi + 1) * 256 + row) * 2], lB = PML[((size_t)(pi + 1) * 256 + row) * 2 + 1];
              const float m = fmaxf(mA, mB), wA = __builtin_amdgcn_exp2f((mA - m) * C2), wB = __builtin_amdgcn_exp2f((mB - m) * C2), inv = 1.f / (lA * wA + lB * wB);
              const float* oa = PART + ((size_t)pi * 256 + row) * 128 + lane * 2; const float* ob = PART + ((size_t)(pi + 1) * 256 + row) * 128 + lane * 2;
              const float v0 = (oa[0] * wA + ob[0] * wB) * inv, v1 = (oa[1] * wA + ob[1] * wB) * inv;
              *(unsigned*)(MIX + (size_t)((63 - sb) * 256 + row) * D + 512 + h * 128 + lane * 2) = pk2(v0, v1); } }
        if (BOTH(12)) GRID_BAR(); }
    if (IN(13)) { pg8::Gemm g{MIX, (const bf16*)(ws + WS_WOUT1), 1024, 1024}; pg8::StaticOrder So; So.init(S, 1024, G, bx);
        pg8::EpiRes E{XR, XR, modF + 6144 + OFF_GM}; pg8::gemm_phase(L, g, So, E); if (BOTH(13)) GRID_BAR(); }
    if (IN(14)) { route1_phase(args, L, vcu, G, tid); if (BOTH(14)) GRID_BAR(); }
    if (IN(15)) { route2_phase(args, gw, NGW, lane); if (BOTH(15)) GRID_BAR(); }
    if (IN(16)) { pg8::Gemm g{(const bf16*)(ws + WS_AMOE), (const bf16*)(ws + WS_WGUM), 1024, 1024}; pg8::MoeOrder Mo; Mo.init((const unsigned*)(ws + WS_CTL) + CW_CNT, 28, G, vcu);
        pg8::EpiSwiGLU E{(bf16*)(ws + WS_HM), DFE}; pg8::gemm_phase(L, g, Mo, E); if (BOTH(16)) GRID_BAR(); }
    if (IN(17)) { pg8::Gemm g{(const bf16*)(ws + WS_HM), (const bf16*)(ws + WS_WDM), DFE, DFE}; pg8::MoeOrder Mo; Mo.init((const unsigned*)(ws + WS_CTL) + CW_CNT, 4, G, vcu);
        pg8::EpiBf16G E{(bf16*)(ws + WS_AMOE), 1024, 0}; pg8::gemm_phase(L, g, Mo, E); if (BOTH(17)) GRID_BAR(); }
    if (IN(18)) { combine_phase(args, gw, NGW, lane); }
    if (IN(19)) { const f32x4* src = (const f32x4*)(DBG_STOP < 4 ? (const float*)args.in[I_X] : (const float*)XR); f32x4* dst = (f32x4*)args.out;
        for (size_t i = (size_t)vcu * NTHR + tid; i < (size_t)S * D / 4; i += (size_t)G * NTHR) dst[i] = src[i]; }
#undef IN
#undef BOTH
}

extern "C" void kernel_launch(void* const* d_in, const int* in_sizes, int n_in, void* d_out, int out_size, void* d_ws, size_t ws_size, hipStream_t stream) {
    static int grid = 0;
    if (grid == 0) {
        if (n_in != 29 || out_size != S * D || ws_size < WS_END) { fprintf(stderr, "kernel_launch: unexpected shapes (n_in %d out %d ws %zu)\n", n_in, out_size, ws_size); grid = -1; return; }
        int dev = 0, cus = 0;
        if (hipGetDevice(&dev) != hipSuccess || hipDeviceGetAttribute(&cus, hipDeviceAttributeMultiprocessorCount, dev) != hipSuccess) { grid = -1; return; }
        if (hipFuncSetAttribute((const void*)fwd_kernel, hipFuncAttributeMaxDynamicSharedMemorySize, LDS_BYTES) != hipSuccess) { grid = -1; return; }
        int per_cu = 0;
        if (hipOccupancyMaxActiveBlocksPerMultiprocessor(&per_cu, (const void*)fwd_kernel, NTHR, LDS_BYTES) != hipSuccess || per_cu < 1) fprintf(stderr, "kernel_launch: occupancy query says %d\n", per_cu);
        (void)hipGetLastError();
        grid = cus;
    }
    if (grid < 0) return;
    (void)hipMemsetAsync((char*)d_ws + WS_CTL, 0, CTL_ZERO_BYTES, stream);
    Args a{};
    for (int i = 0; i < 29; ++i) a.in[i] = d_in[i];
    a.out = (float*)d_out; a.ws = (unsigned char*)d_ws;
#if MK_MULTI
    { const int last = DBG_STOP < 0 ? N_PHASES - 1 : DBG_STOP;
      for (int p = 0; p <= last; ++p) { a.ph_lo = p; a.ph_hi = p + 1; hipLaunchKernelGGL(fwd_kernel, dim3(grid), dim3(NTHR), LDS_BYTES, stream, a); }
      if (DBG_STOP >= 0) { a.ph_lo = 19; a.ph_hi = 20; hipLaunchKernelGGL(fwd_kernel, dim3(grid), dim3(NTHR), LDS_BYTES, stream, a); } }
#else
    a.ph_lo = 0; a.ph_hi = N_PHASES;
    hipLaunchKernelGGL(fwd_kernel, dim3(grid), dim3(NTHR), LDS_BYTES, stream, a);
#endif
}
```

```cpp
#include <hip/hip_runtime.h>
#include <cstdio>
#include <cstdint>

#ifndef MK_MULTI
#define MK_MULTI 0
#endif
#ifndef DBG_REP
#define DBG_REP -1
#endif
#ifndef DBG_STOP
#define DBG_STOP -1
#endif

namespace pg8 {
#define PG8_LAS __attribute__((address_space(3)))
typedef unsigned short bf16_t;
typedef short bf16x8 __attribute__((ext_vector_type(8)));
typedef float f32x4 __attribute__((ext_vector_type(4)));
typedef float f32x2 __attribute__((ext_vector_type(2)));
typedef unsigned u32x4 __attribute__((ext_vector_type(4)));
typedef unsigned u32x2 __attribute__((ext_vector_type(2)));
typedef int i32x4 __attribute__((ext_vector_type(4)));
typedef int i32x8 __attribute__((ext_vector_type(8)));
constexpr int BM = 256, BK = 64, HALF = 128, HTB = HALF * BK * 2, STAGE_BYTES = 8 * HTB, NXCD = 8, WGM = 8;

__host__ __device__ __forceinline__ int lds_byte(int r, int c) { const int st = (r >> 4) * 2 + (c >> 5), rr = r & 15, cc = c & 31, ob = rr * 64 + cc * 2; return st * 1024 + (ob ^ (((ob >> 9) & 1) << 5)); }
__host__ __device__ __forceinline__ void stage_rc(int b, int& R, int& C) { const int st = b / 1024, sb = b % 1024, swz = sb ^ (((sb >> 9) & 1) << 5); R = (st >> 1) * 16 + swz / 64; C = (st & 1) * 32 + (swz % 64) / 2; }
__host__ __device__ __forceinline__ int perm32(int rho) { const int n = rho >> 4, i = rho & 15; return 8 * (i >> 2) + 4 * n + (i & 3); }

struct Unit { int pm, pn, po; };
struct Gemm { const void* A; const void* Bt; int ldaB, KB; };

struct StaticOrder {
    int nM, nN, nwg, G, c;
    __device__ void init(int M, int N, int G_, int c_) { nM = M / BM; nN = N / BM; nwg = nM * nN; G = G_; c = c_; }
    __device__ bool next(int i, Unit& u) const {
        const long L = (long)i * G + c; if (L >= nwg) return false;
        int wgid = (int)L; { const int q = nwg / NXCD, r = nwg % NXCD, xcd = wgid % NXCD, off = wgid / NXCD; wgid = (xcd < r ? xcd * (q + 1) : r * (q + 1) + (xcd - r) * q) + off; }
        const int nig = WGM * nN, gid = wgid / nig, fm = gid * WGM, gsz = (nM - fm) < WGM ? (nM - fm) : WGM;
        u.pm = fm + ((wgid % nig) % gsz); u.pn = (wgid % nig) / gsz; u.po = u.pn; return true;
    }
};
struct MoeOrder {
    const unsigned* cnt; int nct, G, c;
    __device__ void init(const unsigned* cnt_, int nct_, int G_, int c_) { cnt = cnt_; nct = nct_; G = G_; c = c_; }
    __device__ bool next(int i, Unit& u) const {
        const int L = i * G + c; int cum = 0, tb = 0; bool found = false;
#pragma unroll
        for (int e = 0; e < 8; ++e) { const int rte = (int)((cnt[64 * e] + 255u) >> 8); const int n_ = rte * nct;
            if (!found && L < cum + n_) { const int r_ = L - cum; u.pm = tb + r_ % rte; u.po = r_ / rte; u.pn = e * nct + u.po; found = true; } cum += n_; tb += rte; }
        return found;
    }
};

__device__ __forceinline__ unsigned cvt_pk_bf16(float lo, float hi) { unsigned r; asm volatile("v_cvt_pk_bf16_f32 %0, %1, %2" : "=v"(r) : "v"(lo), "v"(hi)); return r; }
__device__ __forceinline__ float gelu_tanh(float x) {
    const float u2 = x * (1.5957691216057308f + 0.07135481282599649f * x * x);
    return x * __builtin_amdgcn_rcpf(1.0f + __builtin_amdgcn_exp2f(-1.4426950408889634f * u2));
}
__device__ __forceinline__ float silu_f(float x) { return x * __builtin_amdgcn_rcpf(1.0f + __builtin_amdgcn_exp2f(-1.4426950408889634f * x)); }

struct EpiBf16G {
    static constexpr bool PERM = true;
    bf16_t* O; int ldc; int gelu_tiles; float scale;
    __device__ __forceinline__ void operator()(const f32x4 (&acc)[2][2][4][2], const Unit& u, int wr, int wc, int fr, int fq) const {
        const int row0 = u.pm * BM + wr * 64 + fr, col0 = u.po * BM + wc * 32 + 8 * fq; const bool g = u.po < gelu_tiles;
#pragma unroll
        for (int ai = 0; ai < 2; ++ai)
#pragma unroll
            for (int m = 0; m < 4; ++m) { bf16_t* rowp = O + (size_t)(row0 + ai * HALF + m * 16) * ldc + col0;
#pragma unroll
                for (int bj = 0; bj < 2; ++bj) { f32x4 v0 = acc[ai][bj][m][0] * scale, v1 = acc[ai][bj][m][1] * scale;
                    if (g) { v0 = (f32x4){gelu_tanh(v0[0]), gelu_tanh(v0[1]), gelu_tanh(v0[2]), gelu_tanh(v0[3])}; v1 = (f32x4){gelu_tanh(v1[0]), gelu_tanh(v1[1]), gelu_tanh(v1[2]), gelu_tanh(v1[3])}; }
                    u32x4 w; w.x = cvt_pk_bf16(v0[0], v0[1]); w.y = cvt_pk_bf16(v0[2], v0[3]); w.z = cvt_pk_bf16(v1[0], v1[1]); w.w = cvt_pk_bf16(v1[2], v1[3]);
                    *(u32x4*)(rowp + bj * HALF) = w; } }
    }
};
struct EpiSwiGLU {
    static constexpr bool PERM = true;
    bf16_t* O; int ldc;
    __device__ __forceinline__ void operator()(const f32x4 (&acc)[2][2][4][2], const Unit& u, int wr, int wc, int fr, int fq) const {
        const int row0 = u.pm * BM + wr * 64 + fr, col0 = u.po * HALF + wc * 32 + 8 * fq;
#pragma unroll
        for (int ai = 0; ai < 2; ++ai)
#pragma unroll
            for (int m = 0; m < 4; ++m) { const f32x4 g0 = acc[ai][0][m][0], g1 = acc[ai][0][m][1], u0 = acc[ai][1][m][0], u1 = acc[ai][1][m][1];
                u32x4 w; w.x = cvt_pk_bf16(silu_f(g0[0]) * u0[0], silu_f(g0[1]) * u0[1]); w.y = cvt_pk_bf16(silu_f(g0[2]) * u0[2], silu_f(g0[3]) * u0[3]);
                w.z = cvt_pk_bf16(silu_f(g1[0]) * u1[0], silu_f(g1[1]) * u1[1]); w.w = cvt_pk_bf16(silu_f(g1[2]) * u1[2], silu_f(g1[3]) * u1[3]);
                *(u32x4*)(O + (size_t)(row0 + ai * HALF + m * 16) * ldc + col0) = w; }
    }
};
__device__ __forceinline__ unsigned pk4_fp8(float a, float b, float c, float d) { int w = 0; w = __builtin_amdgcn_cvt_pk_fp8_f32(a, b, w, false); w = __builtin_amdgcn_cvt_pk_fp8_f32(c, d, w, true); return (unsigned)w; }
struct EpiSwiGLU8 {
    static constexpr bool PERM = true;
    unsigned char* O; int ldc; float scale;
    __device__ __forceinline__ void operator()(const f32x4 (&acc)[2][2][4][2], const Unit& u, int wr, int wc, int fr, int fq) const {
        const int row0 = u.pm * BM + wr * 64 + fr, col0 = u.po * HALF + wc * 32 + 8 * fq;
#pragma unroll
        for (int ai = 0; ai < 2; ++ai)
#pragma unroll
            for (int m = 0; m < 4; ++m) { const f32x4 g0 = acc[ai][0][m][0] * scale, g1 = acc[ai][0][m][1] * scale, u0 = acc[ai][1][m][0] * scale, u1 = acc[ai][1][m][1] * scale;
                u32x2 w; w.x = pk4_fp8(silu_f(g0[0]) * u0[0], silu_f(g0[1]) * u0[1], silu_f(g0[2]) * u0[2], silu_f(g0[3]) * u0[3]);
                w.y = pk4_fp8(silu_f(g1[0]) * u1[0], silu_f(g1[1]) * u1[1], silu_f(g1[2]) * u1[2], silu_f(g1[3]) * u1[3]);
                *(u32x2*)(O + (size_t)(row0 + ai * HALF + m * 16) * ldc + col0) = w; }
    }
};
struct EpiRes {
    static constexpr bool PERM = false;
    const float* base; float* out; const float* gate;
    __device__ __forceinline__ void operator()(const f32x4 (&acc)[2][2][4][2], const Unit& u, int wr, int wc, int fr, int fq) const {
        const int col0 = u.po * BM + wc * 32 + 4 * fq;
        f32x4 gv[2][2];
#pragma unroll
        for (int bj = 0; bj < 2; ++bj)
#pragma unroll
            for (int n = 0; n < 2; ++n) gv[bj][n] = *(const f32x4*)(gate + col0 + bj * HALF + n * 16);
#pragma unroll
        for (int ai = 0; ai < 2; ++ai)
#pragma unroll
            for (int m = 0; m < 4; ++m) { const size_t off = (size_t)(u.pm * BM + ai * HALF + wr * 64 + m * 16 + fr) * 1024 + col0;
#pragma unroll
                for (int bj = 0; bj < 2; ++bj)
#pragma unroll
                    for (int n = 0; n < 2; ++n) { const f32x4 bs = *(const f32x4*)(base + off + bj * HALF + n * 16); *(f32x4*)(out + off + bj * HALF + n * 16) = bs + gv[bj][n] * acc[ai][bj][m][n]; } }
    }
};

template <class Epi, class Sched, bool FP8 = false, bool ALIGN_EPI = true>
__device__ __forceinline__ void gemm_phase(PG8_LAS unsigned char* lds, const Gemm g, const Sched& S, const Epi& E) {
    const int tid = threadIdx.x, wid = __builtin_amdgcn_readfirstlane(tid >> 6), lane = tid & 63, wr = wid >> 2, wc = wid & 3, fr = lane & 15, fq = lane >> 4;
    const int KB = g.KB, nt = KB / (BK * 2), ldaB = g.ldaB;
    unsigned voffA[2], voffB[2];
#pragma unroll
    for (int i = 0; i < 2; ++i) { int R, C; stage_rc(tid * 16 + i * 8192, R, C); const int Rb = Epi::PERM ? ((R & ~31) + perm32(R & 31)) : R;
        voffA[i] = (unsigned)(R * ldaB + C * 2); voffB[i] = (unsigned)(Rb * KB + C * 2); }
    const size_t kstep = (size_t)(BK * 2);
    const size_t hstepA = (size_t)HALF * ldaB, hstepB = (size_t)HALF * KB;
    const size_t tstepA = 2 * hstepA, tstepB = 2 * hstepB;
    const unsigned ldsw = (unsigned)wid * 1024u;
    const int aoff = lds_byte(wr * 64 + fr, fq * 8), boff = lds_byte(wc * 32 + fr, fq * 8);
#define PG8_SA(b, h) (((b) * 2 + (h)) * HTB)
#define PG8_SB(b, h) ((4 + (b) * 2 + (h)) * HTB)
#define PG8_STAGE(bufoff, gbase, voff) do { _Pragma("unroll") for (int _i = 0; _i < 2; ++_i) \
        __builtin_amdgcn_global_load_lds((const unsigned*)((const char*)(gbase) + (voff)[_i]), (PG8_LAS unsigned*)(lds + (bufoff) + ldsw + _i * 8192), 16, 0, 0); } while (0)
#define PG8_RD8(p_) __builtin_shufflevector(*(const PG8_LAS i32x4*)(p_), *(const PG8_LAS i32x4*)((p_) + 1024), 0, 1, 2, 3, 4, 5, 6, 7)
#define PG8_LDA(dst, b, h) do { if constexpr (FP8) { _Pragma("unroll") for (int m = 0; m < 4; ++m) dst##8[m] = PG8_RD8(lds + PG8_SA(b, h) + aoff + m * 2048); } \
        else { _Pragma("unroll") for (int m = 0; m < 4; ++m) _Pragma("unroll") for (int k = 0; k < 2; ++k) dst[m][k] = *(const PG8_LAS bf16x8*)(lds + PG8_SA(b, h) + aoff + m * 2048 + k * 1024); } } while (0)
#define PG8_LDB(dst, b, h) do { if constexpr (FP8) { _Pragma("unroll") for (int n = 0; n < 2; ++n) dst##8[n] = PG8_RD8(lds + PG8_SB(b, h) + boff + n * 2048); } \
        else { _Pragma("unroll") for (int n = 0; n < 2; ++n) _Pragma("unroll") for (int k = 0; k < 2; ++k) dst[n][k] = *(const PG8_LAS bf16x8*)(lds + PG8_SB(b, h) + boff + n * 2048 + k * 1024); } } while (0)
#define PG8_MMA(ai, bj, At, Bt) do { __builtin_amdgcn_s_setprio(1); \
        if constexpr (FP8) { _Pragma("unroll") for (int m = 0; m < 4; ++m) _Pragma("unroll") for (int n = 0; n < 2; ++n) \
            asm volatile("v_mfma_scale_f32_16x16x128_f8f6f4 %0, %1, %2, %0, %3, %3 op_sel_hi:[0,0,0]" : "+v"(acc[ai][bj][m][n]) : "v"(Bt##8[n]), "v"(At##8[m]), "v"(sc7f)); } \
        else { _Pragma("unroll") for (int m = 0; m < 4; ++m) _Pragma("unroll") for (int n = 0; n < 2; ++n) _Pragma("unroll") for (int k = 0; k < 2; ++k) \
            acc[ai][bj][m][n] = __builtin_amdgcn_mfma_f32_16x16x32_bf16(Bt[n][k], At[m][k], acc[ai][bj][m][n], 0, 0, 0); } \
        __builtin_amdgcn_s_setprio(0); } while (0)
#define PG8_WAIT_V(n) asm volatile("s_waitcnt vmcnt(" #n ")" ::: "memory")
#define PG8_WAIT_L(n) asm volatile("s_waitcnt lgkmcnt(" #n ")" ::: "memory")
#define PG8_BAR __builtin_amdgcn_s_barrier()
#define PG8_SCHED __builtin_amdgcn_sched_barrier(0)
    Unit cur, nxt; int ui = 0;
    if (!S.next(0, cur)) return;
    f32x4 acc[2][2][4][2];
#pragma unroll
    for (int a = 0; a < 2; ++a)
#pragma unroll
        for (int b = 0; b < 2; ++b)
#pragma unroll
            for (int m = 0; m < 4; ++m)
#pragma unroll
                for (int n = 0; n < 2; ++n) acc[a][b][m][n] = (f32x4){0.f, 0.f, 0.f, 0.f};
    const int sc7f = 0x7f7f7f7f;
    bf16x8 At[4][2], B0[2][2], B1[2][2]; i32x8 At8[4], B08[2], B18[2];
    const char* cA = (const char*)g.A + (size_t)cur.pm * tstepA; const char* cB = (const char*)g.Bt + (size_t)cur.pn * tstepB;
    PG8_STAGE(PG8_SB(0, 0), cB, voffB); PG8_STAGE(PG8_SB(0, 1), cB + hstepB, voffB); PG8_STAGE(PG8_SA(0, 0), cA, voffA); PG8_STAGE(PG8_SA(0, 1), cA + hstepA, voffA);
    if (wr == 1) PG8_BAR;
    PG8_WAIT_V(2); PG8_BAR;
    PG8_STAGE(PG8_SB(1, 0), cB + kstep, voffB); PG8_STAGE(PG8_SA(1, 0), cA + kstep, voffA); PG8_STAGE(PG8_SB(1, 1), cB + hstepB + kstep, voffB);
    PG8_WAIT_V(6); PG8_BAR;
    for (;;) {
        const bool has_next = S.next(ui + 1, nxt);
        const char* nA = has_next ? (const char*)g.A + (size_t)nxt.pm * tstepA : cA; const char* nB = has_next ? (const char*)g.Bt + (size_t)nxt.pn * tstepB : cB;
#pragma nounroll
        for (int t = 0; t < nt; t += 2) {
            const bool last = (t == nt - 2);
            const char* a1 = cA + (size_t)(t + 1) * kstep;
            const char* a2 = last ? nA : cA + (size_t)(t + 2) * kstep; const char* b2 = last ? nB : cB + (size_t)(t + 2) * kstep;
            const char* a3 = a2 + kstep; const char* b3 = b2 + kstep;
            PG8_LDB(B0, 0, 0); PG8_LDB(B1, 0, 1); PG8_SCHED; PG8_LDA(At, 0, 0); PG8_STAGE(PG8_SA(1, 1), a1 + hstepA, voffA);
            PG8_WAIT_V(8); PG8_WAIT_L(0); PG8_BAR; PG8_MMA(0, 0, At, B0); PG8_MMA(0, 1, At, B1); PG8_BAR; PG8_SCHED;
            PG8_LDA(At, 0, 1); PG8_STAGE(PG8_SB(0, 0), b2, voffB); PG8_STAGE(PG8_SB(0, 1), b2 + hstepB, voffB); PG8_STAGE(PG8_SA(0, 0), a2, voffA);
            PG8_WAIT_V(8); PG8_WAIT_L(0); PG8_BAR; PG8_MMA(1, 0, At, B0); PG8_MMA(1, 1, At, B1); PG8_BAR; PG8_SCHED;
            PG8_LDB(B0, 1, 0); PG8_LDB(B1, 1, 1); PG8_SCHED; PG8_LDA(At, 1, 0); PG8_STAGE(PG8_SA(0, 1), a2 + hstepA, voffA);
            PG8_WAIT_V(8); PG8_WAIT_L(0); PG8_BAR; PG8_MMA(0, 0, At, B0); PG8_MMA(0, 1, At, B1); PG8_BAR; PG8_SCHED;
            PG8_LDA(At, 1, 1); PG8_STAGE(PG8_SB(1, 0), b3, voffB); PG8_STAGE(PG8_SB(1, 1), b3 + hstepB, voffB); PG8_STAGE(PG8_SA(1, 0), a3, voffA);
            PG8_WAIT_V(8); PG8_WAIT_L(0); PG8_BAR; PG8_MMA(1, 0, At, B0); PG8_MMA(1, 1, At, B1); PG8_BAR; PG8_SCHED;
        }
        if constexpr (ALIGN_EPI) { if (wr == 0) PG8_BAR; }
        if constexpr (FP8) asm volatile("s_nop 15\n\ts_nop 15" ::: "memory");
        E(acc, cur, wr, wc, fr, fq);
        if (!has_next) break;
#pragma unroll
        for (int a = 0; a < 2; ++a)
#pragma unroll
            for (int b = 0; b < 2; ++b)
#pragma unroll
                for (int m = 0; m < 4; ++m)
#pragma unroll
                    for (int n = 0; n < 2; ++n) acc[a][b][m][n] = (f32x4){0.f, 0.f, 0.f, 0.f};
        cur = nxt; cA = nA; cB = nB; ++ui;
        if constexpr (ALIGN_EPI) { if (wr == 1) PG8_BAR; }
    }
    PG8_WAIT_V(0);
    if constexpr (!ALIGN_EPI) { if (wr == 0) PG8_BAR; }
    PG8_BAR;
#undef PG8_SA
#undef PG8_SB
#undef PG8_STAGE
#undef PG8_LDA
#undef PG8_LDB
#undef PG8_MMA
#undef PG8_RD8
#undef PG8_WAIT_V
#undef PG8_WAIT_L
#undef PG8_BAR
#undef PG8_SCHED
}
}

constexpr int NWAVES = 8, NTHR = 512;
constexpr int S = 16384, D = 1024;
constexpr int E_IN = 1536, D_FF = 2816, O_IN = 2112, O_INP = 2304, NE = 8, DFE = 3584;
constexpr int MOE_ROWS = 34816;
constexpr float EPS = 1e-6f;
constexpr float MOE_WSCALE = 64.f;

constexpr size_t MiB = 1u << 20;
constexpr size_t WS_CTL = 0, CTL_ZERO_BYTES = 1 * MiB;
constexpr size_t WS_MODP = 1 * MiB, WS_MODF = 2 * MiB, WS_ROPE = 3 * MiB;
constexpr size_t WS_TOK = 7 * MiB;
constexpr size_t WS_WIN0 = 8 * MiB, WS_WOUT0 = 11 * MiB, WS_WGU0 = 13 * MiB, WS_WD0 = 24 * MiB, WS_WIN1 = 30 * MiB;
constexpr size_t WS_WUQ = 35 * MiB, WS_WUKV = WS_WUQ + MiB / 2, WS_WOUT1 = 36 * MiB, WS_WTRIL = 38 * MiB, WS_WGT = WS_WTRIL + 131072;
constexpr size_t WS_WGUM = 40 * MiB, WS_WDM = 152 * MiB;
constexpr size_t WS_ABUF = 208 * MiB, WS_MIX = 240 * MiB, WS_XR = 272 * MiB, WS_AMOE = 336 * MiB  , WS_BIG = 404 * MiB;
constexpr size_t WS_P0 = WS_BIG, WS_H = WS_BIG + 48 * MiB;
constexpr size_t WS_P1 = WS_BIG, WS_QR = WS_BIG + 72 * MiB, WS_KVR = WS_BIG + 104 * MiB, WS_QF = WS_BIG + 136 * MiB, WS_KIMG = WS_BIG + 160 * MiB, WS_VIMG = WS_BIG + 184 * MiB;
constexpr size_t WS_PART = WS_BIG + 200 * MiB, WS_PML = WS_BIG + 232 * MiB;
constexpr size_t WS_HM = WS_BIG;
constexpr size_t WS_END = 660 * MiB;
static_assert(WS_H + (size_t)S * D_FF * 2 <= WS_END && WS_VIMG + 16 * MiB <= WS_END && WS_HM + (size_t)MOE_ROWS * DFE * 2 <= WS_END, "big region");
static_assert(WS_AMOE + (size_t)MOE_ROWS * D * 2 <= WS_BIG && WS_WDM + (size_t)NE * D * DFE * 2 <= WS_ABUF && WS_WGUM + (size_t)NE * 2 * DFE * D * 2 <= WS_WDM, "map");
constexpr int CW_BAR = 4096;
constexpr int CW_CNT = 16384;

constexpr int RING_BYTES = 131072, LDSCTL_OFF = RING_BYTES, MISC_OFF = LDSCTL_OFF + 320, LDS_BYTES = 147456;

#define GAS __attribute__((address_space(1)))
#define LAS __attribute__((address_space(3)))
typedef unsigned short bf16;
typedef unsigned v4u __attribute__((ext_vector_type(4)));
typedef unsigned v2u __attribute__((ext_vector_type(2)));
typedef float f32x4 __attribute__((ext_vector_type(4)));
typedef float f32x16 __attribute__((ext_vector_type(16)));
typedef short bf16x8 __attribute__((ext_vector_type(8)));
typedef short s16x4 __attribute__((ext_vector_type(4)));
typedef GAS unsigned gu32;
#define RLX_AGENT __ATOMIC_RELAXED, __HIP_MEMORY_SCOPE_AGENT
#define LDS_WAIT() asm volatile("s_waitcnt lgkmcnt(0)" ::: "memory")
#define VM_WAIT() asm volatile("s_waitcnt vmcnt(0)" ::: "memory")
__device__ __forceinline__ unsigned f2bf(float f) { unsigned u = __builtin_bit_cast(unsigned, f); return (u + 0x7fffu + ((u >> 16) & 1u)) >> 16; }
__device__ __forceinline__ unsigned pk2(float lo, float hi) { return f2bf(lo) | (f2bf(hi) << 16); }
__device__ __forceinline__ float bflo(unsigned w) { return __builtin_bit_cast(float, w << 16); }
__device__ __forceinline__ float bfhi(unsigned w) { return __builtin_bit_cast(float, w & 0xffff0000u); }
__device__ __forceinline__ float wave_sum(float v) {
#pragma unroll
    for (int o = 1; o < 64; o <<= 1) v += __shfl_xor(v, o);
    return v;
}

#define XB_TMO      128
#define XB_XCNT(j)  (256  + 64 * (j))
#define XB_XSUB(j)  (1280 + 64 * (j))
#define XB_XGEN(j)  (2304 + 64 * (j))
#define XB_TOP      3328
#define XB_TOPGEN   3392
#define XCD_BAR_WORDS 3456
#define XB_SPIN_CAP (1u << 18)
__device__ __forceinline__ unsigned xb_ld(unsigned* p)              { return __hip_atomic_load(p, __ATOMIC_RELAXED, __HIP_MEMORY_SCOPE_AGENT); }
__device__ __forceinline__ unsigned xb_add(unsigned* p, unsigned v) { return __hip_atomic_fetch_add(p, v, __ATOMIC_RELAXED, __HIP_MEMORY_SCOPE_AGENT); }
__device__ __forceinline__ unsigned xb_xcc_id() { return (unsigned)__builtin_amdgcn_s_getreg((3 << 11) | 20) & 0xFu; }
#define XB_SPIN(cond, bar) do { unsigned _sp = 0; while (cond) { __builtin_amdgcn_s_sleep(1); \
    if ((++_sp & 255u) == 0u) { if (xb_ld(&(bar)[XB_TMO])) break; if (_sp > XB_SPIN_CAP) { atomicAdd(&(bar)[XB_TMO], 1u); break; } } } } while (0)
struct XcdBarrier { unsigned* bar; unsigned x; volatile LAS unsigned* st; };
__device__ __forceinline__ XcdBarrier xcd_barrier_post(unsigned* bar, volatile LAS unsigned* st) {
    XcdBarrier b; b.bar = bar; b.x = xb_xcc_id(); b.st = st;
    if (threadIdx.x == 0) (void)xb_add(&bar[XB_XCNT(b.x)], 1u);
    return b;
}
__device__ __forceinline__ void xcd_barrier_complete(unsigned* bar, unsigned x, unsigned& nloc, unsigned& nx) {
    const unsigned G = gridDim.x * gridDim.y * gridDim.z;
    unsigned sum, cnt, mine, sp = 0u;
    for (;;) {
        sum = 0u; cnt = 0u; mine = 0u;
#pragma unroll
        for (unsigned j = 0; j < 16; ++j) { const unsigned c = xb_ld(&bar[XB_XCNT(j)]); sum += c; cnt += (c > 0u) ? 1u : 0u; mine = (j == x) ? c : mine; }
        if (sum == G) break;
        __builtin_amdgcn_s_sleep(1);
        if ((++sp & 255u) == 0u) { if (xb_ld(&bar[XB_TMO])) break; if (sp > XB_SPIN_CAP) { atomicAdd(&bar[XB_TMO], 1u); break; } }
    }
    nloc = mine > 0u ? mine : 1u; nx = cnt > 0u ? cnt : 1u;
}
__device__ __forceinline__ void xcd_barrier(const XcdBarrier& b) {
    asm volatile("s_waitcnt vmcnt(0)" ::: "memory");
    __syncthreads();
    if (threadIdx.x == 0) {
        unsigned* bar = b.bar;
        __builtin_amdgcn_s_waitcnt(0);
        unsigned nloc = b.st[0], nx = b.st[1];
        if (nloc == 0u) { xcd_barrier_complete(bar, b.x, nloc, nx); b.st[0] = nloc; b.st[1] = nx; }
        const unsigned old = xb_add(&bar[XB_XSUB(b.x)], 1u);
        const unsigned gen = old / nloc;
        if (old + 1u == (gen + 1u) * nloc) {
            __builtin_amdgcn_fence(__ATOMIC_RELEASE, "agent");
            asm volatile("s_waitcnt vmcnt(0)" ::: "memory");
            const unsigned og = xb_add(&bar[XB_TOP], 1u);
            const unsigned tg = og / nx;
            if (og + 1u == (tg + 1u) * nx) xb_add(&bar[XB_TOPGEN], 1u);
            else XB_SPIN(xb_ld(&bar[XB_TOPGEN]) == tg, bar);
            __builtin_amdgcn_fence(__ATOMIC_ACQUIRE, "agent");
            xb_add(&bar[XB_XGEN(b.x)], 1u);
            asm volatile("s_waitcnt vmcnt(0)" ::: "memory");
        } else {
            XB_SPIN(xb_ld(&bar[XB_XGEN(b.x)]) == gen, bar);
            __builtin_amdgcn_fence(__ATOMIC_ACQUIRE, "agent");
            asm volatile("s_waitcnt vmcnt(0)" ::: "memory");
        }
    }
    __syncthreads();
}

struct Args { const void* in[29]; float* out; unsigned char* ws; int ph_lo, ph_hi; };
enum { I_X = 0, I_C, I_POS, I_NMW, I_NFW, I_ADAW, I_ADAB, I_EWIN, I_ALNW, I_ALNB, I_AWS, I_ABS, I_BWG, I_BSC, I_EWOUT, I_FGU, I_FDN,
       I_OWIN, I_CONV, I_QAN, I_WUQ, I_KVN, I_WUKV, I_QNW, I_KNW, I_OWOUT, I_RW, I_MGU, I_MDN };
constexpr int OFF_SHM = 0, OFF_SCM = 1024, OFF_GM = 2048, OFF_SHF = 3072, OFF_SCF = 4096, OFF_GF = 5120;

__device__ __forceinline__ void p0_mod(const float* c, const float* ada_w, float* modp, int vcu, int G, int tid) {
    for (int u = vcu; u < 384; u += G) {
        const int layer = u / 192, r = u % 192, ks = r / 12, cb = r % 12, col = cb * 512 + tid;
        const float* w = ada_w + ((size_t)layer * 1024 + ks * 64) * 6144 + col;
        float acc = 0.f;
#pragma unroll 8
        for (int k = 0; k < 64; ++k) { const float cv = c[ks * 64 + k]; const float sv = cv / (1.f + __expf(-cv)); acc += sv * w[(size_t)k * 6144]; }
        modp[(size_t)(layer * 16 + ks) * 6144 + col] = acc;
    }
}
__device__ __forceinline__ void conv_item(const float* src, int ldn, int k0, int n0, const float* kscale, bf16* dst, int ldk, int drow0, LAS float* scr, int lane) {
#pragma unroll
    for (int i = 0; i < 8; ++i) { const int kk = 8 * i + (lane >> 3); f32x4 v = *(const f32x4*)(src + (size_t)(k0 + kk) * ldn + n0 + (lane & 7) * 4);
        if (kscale) v = v * kscale[k0 + kk];
        LAS float* p = scr + kk * 33 + (lane & 7) * 4; p[0] = v.x; p[1] = v.y; p[2] = v.z; p[3] = v.w; }
    LDS_WAIT(); asm volatile("" ::: "memory");
    const int c = lane & 7;
#pragma unroll
    for (int j = 0; j < 4; ++j) { const int nn = (lane >> 3) + 8 * j; const LAS float* s = scr + (8 * c) * 33 + nn;
        v4u o; o.x = pk2(s[0 * 33], s[1 * 33]); o.y = pk2(s[2 * 33], s[3 * 33]); o.z = pk2(s[4 * 33], s[5 * 33]); o.w = pk2(s[6 * 33], s[7 * 33]);
        *(v4u*)(dst + (size_t)(drow0 + nn) * ldk + k0 + 8 * c) = o; }
    LDS_WAIT(); asm volatile("" ::: "memory");
}
__device__ __forceinline__ void conv_item8(const float* src, int ldn, int k0, int n0, float scale, unsigned char* dst, int ldkB, int drow0, LAS float* scr, int lane) {
#pragma unroll
    for (int i = 0; i < 8; ++i) { const int kk = 8 * i + (lane >> 3); const f32x4 v = *(const f32x4*)(src + (size_t)(k0 + kk) * ldn + n0 + (lane & 7) * 4) * scale;
        LAS float* p = scr + kk * 33 + (lane & 7) * 4; p[0] = v.x; p[1] = v.y; p[2] = v.z; p[3] = v.w; }
    LDS_WAIT(); asm volatile("" ::: "memory");
    const int c = lane & 7;
#pragma unroll
    for (int j = 0; j < 4; ++j) { const int nn = (lane >> 3) + 8 * j; const LAS float* s = scr + (8 * c) * 33 + nn;
        v2u o; o.x = pg8::pk4_fp8(s[0 * 33], s[1 * 33], s[2 * 33], s[3 * 33]); o.y = pg8::pk4_fp8(s[4 * 33], s[5 * 33], s[6 * 33], s[7 * 33]);
        *(v2u*)(dst + (size_t)(drow0 + nn) * ldkB + k0 + 8 * c) = o; }
    LDS_WAIT(); asm volatile("" ::: "memory");
}
__device__ __forceinline__ int gu_row(int n0, int half) { return n0 < half ? (n0 >> 7) * 256 + (n0 & 127) : ((n0 - half) >> 7) * 256 + 128 + ((n0 - half) & 127); }
__device__ __forceinline__ void p0_prologue(const Args& a, LAS unsigned char* lds, int vcu, int G, int tid) {
    unsigned char* ws = a.ws; const int lane = tid & 63, wave = __builtin_amdgcn_readfirstlane(tid >> 6);
    p0_mod((const float*)a.in[I_C], (const float*)a.in[I_ADAW], (float*)(ws + WS_MODP), vcu, G, tid);
    const int gt = vcu * NTHR + tid, NGT = G * NTHR;
    { const int* pos = (const int*)a.in[I_POS]; float* cosT = (float*)(ws + WS_ROPE); float* sinT = cosT + (size_t)S * 32;
      for (int i = gt; i < S * 32; i += NGT) { const int t = i >> 5, f = i & 31; const float inv = (float)exp(-(double)f * (9.210340371976184 / 32.0));
          const float ang = (float)pos[t] * inv; const double ad = (double)ang;
          const double k = __builtin_rint(ad * 0.15915494309189535); const double r = __builtin_fma(-k, 6.283185307179586, ad) - k * 2.4492935982947064e-16;
          cosT[i] = cosf((float)r); sinT[i] = sinf((float)r); } }
    { const float* aws = (const float*)a.in[I_AWS]; bf16* wt = (bf16*)(ws + WS_WTRIL);
      for (int i = gt; i < 4 * 128 * 128 / 2; i += NGT) { const int e = 2 * i, s = e & 127, t = (e >> 7) & 127; const float v0 = s <= t ? aws[e] : 0.f, v1 = (s + 1) <= t ? aws[e + 1] : 0.f; ((unsigned*)wt)[i] = pk2(v0, v1); } }
    { v4u z = {0u, 0u, 0u, 0u}; v4u* p1 = (v4u*)(ws + WS_WIN1 + (size_t)O_IN * 1024 * 2);
      for (int i = gt; i < (O_INP - O_IN) * 1024 * 2 / 16; i += NGT) p1[i] = z;
      for (int i = gt; i < 4 * 64 * 256 * 2 / 16; i += NGT) { const int h = i / (64 * 32), r = i % (64 * 32); ((v4u*)(ws + WS_WUQ + (size_t)(h * 256 + 192) * 256 * 2))[r] = z; } }
    LAS float* scr = (LAS float*)(lds + wave * 16384);
    const int gw = vcu * NWAVES + wave, NGW = G * NWAVES;
    constexpr int I0 = 16 * 48, I1 = 16 * 32, I2 = 16 * 176, I3 = 44 * 32, I4 = 16 * 66, I5 = 4 * 24, I6 = 4 * 32, I7 = 16 * 32, I8 = 4 * 8, I9 = 8 * 16 * 224, I10 = 8 * 56 * 32;
    constexpr int NITEMS = I0 + I1 + I2 + I3 + I4 + I5 + I6 + I7 + I8 + I9 + I10;
    for (int it = gw; it < NITEMS; it += NGW) {
        int r = it;
        if (r < I9) { const int e = r / (16 * 224), q = r % (16 * 224), kb = q / 224, nb = q % 224;
            conv_item8((const float*)a.in[I_MGU] + (size_t)e * 1024 * 7168, 7168, kb * 64, nb * 32, MOE_WSCALE, ws + WS_WGUM + (size_t)e * 7168 * 1024, 1024, gu_row(nb * 32, DFE), scr, lane); continue; } r -= I9;
        if (r < I10) { const int e = r / (56 * 32), q = r % (56 * 32), kb = q / 32, nb = q % 32;
            conv_item8((const float*)a.in[I_MDN] + (size_t)e * DFE * 1024, 1024, kb * 64, nb * 32, MOE_WSCALE, ws + WS_WDM + (size_t)e * 1024 * DFE, DFE, nb * 32, scr, lane); continue; } r -= I10;
        if (r < I0) { conv_item((const float*)a.in[I_EWIN], E_IN, (r / 48) * 64, (r % 48) * 32, nullptr, (bf16*)(ws + WS_WIN0), 1024, (r % 48) * 32, scr, lane); continue; } r -= I0;
        if (r < I1) { conv_item((const float*)a.in[I_EWOUT], 1024, (r / 32) * 64, (r % 32) * 32, nullptr, (bf16*)(ws + WS_WOUT0), 1024, (r % 32) * 32, scr, lane); continue; } r -= I1;
        if (r < I2) { conv_item((const float*)a.in[I_FGU], 2 * D_FF, (r / 176) * 64, (r % 176) * 32, nullptr, (bf16*)(ws + WS_WGU0), 1024, gu_row((r % 176) * 32, D_FF), scr, lane); continue; } r -= I2;
        if (r < I3) { conv_item((const float*)a.in[I_FDN], 1024, (r / 32) * 64, (r % 32) * 32, nullptr, (bf16*)(ws + WS_WD0), D_FF, (r % 32) * 32, scr, lane); continue; } r -= I3;
        if (r < I4) { conv_item((const float*)a.in[I_OWIN], O_IN, (r / 66) * 64, (r % 66) * 32, nullptr, (bf16*)(ws + WS_WIN1), 1024, (r % 66) * 32, scr, lane); continue; } r -= I4;
        if (r < I5) { const int n0 = (r % 24) * 32; conv_item((const float*)a.in[I_WUQ], 768, (r / 24) * 64, n0, (const float*)a.in[I_QAN], (bf16*)(ws + WS_WUQ), 256, (n0 / 192) * 256 + n0 % 192, scr, lane); continue; } r -= I5;
        if (r < I6) { conv_item((const float*)a.in[I_WUKV], 1024, (r / 32) * 64, (r % 32) * 32, (const float*)a.in[I_KVN], (bf16*)(ws + WS_WUKV), 256, (r % 32) * 32, scr, lane); continue; } r -= I6;
        if (r < I7) { conv_item((const float*)a.in[I_OWOUT], 1024, (r / 32) * 64, (r % 32) * 32, nullptr, (bf16*)(ws + WS_WOUT1), 1024, (r % 32) * 32, scr, lane); continue; } r -= I7;
        { const int g = r / 8, q = r % 8; conv_item((const float*)a.in[I_BWG] + (size_t)g * 16384, 128, (q / 4) * 64, (q % 4) * 32, nullptr, (bf16*)(ws + WS_WGT) + (size_t)g * 16384, 128, (q % 4) * 32, scr, lane); }
    }
}

__device__ __forceinline__ float modv_partial(const float* modp, const float* ada_b, int layer, int idx) {
    float s = ada_b[layer * 6144 + idx];
#pragma unroll
    for (int ks = 0; ks < 16; ++ks) s += modp[(size_t)(layer * 16 + ks) * 6144 + idx];
    return s;
}
template <bool PARTIAL>
__device__ __forceinline__ void norm_phase(const Args& a, const float* xin, bf16* out, const float* nw, int layer, int off_sh, int off_sc, int gw, int NGW, int lane) {
    const float* modp = (const float*)(a.ws + WS_MODP); const float* modF = (const float*)(a.ws + WS_MODF); const float* ada_b = (const float*)a.in[I_ADAB];
    f32x4 g[4], sh[4];
#pragma unroll
    for (int j = 0; j < 4; ++j)
#pragma unroll
        for (int e = 0; e < 4; ++e) { const int col = 4 * lane + e + 256 * j; float scv, shv;
            if (PARTIAL) { scv = modv_partial(modp, ada_b, layer, off_sc + col); shv = modv_partial(modp, ada_b, layer, off_sh + col); }
            else { scv = modF[layer * 6144 + off_sc + col]; shv = modF[layer * 6144 + off_sh + col]; }
            g[j][e] = nw[col] * (1.f + scv); sh[j][e] = shv; }
    for (int m = gw; m < S; m += NGW) {
        const f32x4* xr = (const f32x4*)(xin + (size_t)m * D) + lane;
        f32x4 v[4]; float s = 0.f;
#pragma unroll
        for (int j = 0; j < 4; ++j) { v[j] = xr[64 * j]; s += (v[j].x * v[j].x + v[j].y * v[j].y) + (v[j].z * v[j].z + v[j].w * v[j].w); }
        const float rstd = 1.f / sqrtf(wave_sum(s) * (1.f / D) + EPS);
        unsigned long long* o8 = (unsigned long long*)(out + (size_t)m * D) + lane;
#pragma unroll
        for (int j = 0; j < 4; ++j) { const f32x4 y = v[j] * rstd * g[j] + sh[j]; o8[64 * j] = (unsigned long long)pk2(y.x, y.y) | ((unsigned long long)pk2(y.z, y.w) << 32); }
    }
}

__device__ __forceinline__ void mixab_phase(const Args& a, LAS unsigned char* lds, int vcu, int G, int tid) {
    const bf16* P0 = (const bf16*)(a.ws + WS_P0); bf16* MIX = (bf16*)(a.ws + WS_MIX);
    const bf16* Wtril = (const bf16*)(a.ws + WS_WTRIL); const bf16* wgT = (const bf16*)(a.ws + WS_WGT);
    const float* ln_w = (const float*)a.in[I_ALNW]; const float* ln_b = (const float*)a.in[I_ALNB]; const float* b_s = (const float*)a.in[I_ABS]; const float* b_sc = (const float*)a.in[I_BSC];
    const int lane = tid & 63, wave = __builtin_amdgcn_readfirstlane(tid >> 6), fr = lane & 15, fq = lane >> 4;
    LAS bf16* vnT = (LAS bf16*)lds;
    LAS bf16* poolS = (LAS bf16*)(lds + 34816);
    LAS bf16* ppS = (LAS bf16*)(lds + 69632);
    LAS float* stat = (LAS float*)(lds + 69632 + 39168);
    for (int u = vcu; u < 512; u += G) {
        const int n = u >> 2, g = u & 3, t0 = n * 128;
        for (int rr = 0; rr < 16; ++rr) { const int row = wave * 16 + rr;
            const v4u raw = *(const v4u*)(P0 + (size_t)(t0 + row) * E_IN + 512 + lane * 8);
            float x[8] = {bflo(raw.x), bfhi(raw.x), bflo(raw.y), bfhi(raw.y), bflo(raw.z), bfhi(raw.z), bflo(raw.w), bfhi(raw.w)};
            float s = 0.f;
#pragma unroll
            for (int j = 0; j < 8; ++j) s += x[j];
            const float mu = wave_sum(s) * (1.f / 512.f); float q = 0.f;
#pragma unroll
            for (int j = 0; j < 8; ++j) { const float d = x[j] - mu; q += d * d; }
            const float rstd = 1.f / sqrtf(wave_sum(q) * (1.f / 512.f) + EPS);
            if (lane == 0) { stat[row * 2] = mu; stat[row * 2 + 1] = rstd; } }
        for (int i = tid; i < 144 * 16; i += NTHR) { const int r = i >> 4, c8 = i & 15, t = t0 - 16 + r; v4u v = {0u, 0u, 0u, 0u};
            if (t >= 0) v = *(const v4u*)(P0 + (size_t)t * E_IN + 1024 + g * 128 + c8 * 8);
            *(LAS v4u*)(ppS + r * 136 + c8 * 8) = v; }
        __syncthreads();
        { const int s = tid & 127, dq = tid >> 7; const float mu = stat[s * 2], rstd = stat[s * 2 + 1];
#pragma unroll
          for (int cc = 0; cc < 4; ++cc) { const int d0 = dq * 32 + cc * 8; const v4u raw = *(const v4u*)(P0 + (size_t)(t0 + s) * E_IN + 512 + g * 128 + d0);
              float x[8] = {bflo(raw.x), bfhi(raw.x), bflo(raw.y), bfhi(raw.y), bflo(raw.z), bfhi(raw.z), bflo(raw.w), bfhi(raw.w)};
#pragma unroll
              for (int j = 0; j < 8; ++j) { const int ch = g * 128 + d0 + j; vnT[(d0 + j) * 136 + s] = (bf16)f2bf((x[j] - mu) * rstd * ln_w[ch] + ln_b[ch]); } } }
        { const int t = tid & 127, q4 = tid >> 7, w = 2 << g, tg = t0 + t; const float inv = 1.f / (float)((tg + 1) < w ? (tg + 1) : w);
#pragma unroll
          for (int cc = 0; cc < 4; ++cc) { const int ch = q4 * 32 + cc * 8; float acc[8] = {0.f, 0.f, 0.f, 0.f, 0.f, 0.f, 0.f, 0.f};
              for (int j = 0; j < w; ++j) { const v4u r = *(const LAS v4u*)(ppS + (16 + t - j) * 136 + ch);
                  acc[0] += bflo(r.x); acc[1] += bfhi(r.x); acc[2] += bflo(r.y); acc[3] += bfhi(r.y); acc[4] += bflo(r.z); acc[5] += bfhi(r.z); acc[6] += bflo(r.w); acc[7] += bfhi(r.w); }
              const v4u c0 = *(const LAS v4u*)(ppS + (16 + t) * 136 + ch);
              v4u o; o.x = pk2(acc[0] * inv - bflo(c0.x), acc[1] * inv - bfhi(c0.x)); o.y = pk2(acc[2] * inv - bflo(c0.y), acc[3] * inv - bfhi(c0.y));
              o.z = pk2(acc[4] * inv - bflo(c0.z), acc[5] * inv - bfhi(c0.z)); o.w = pk2(acc[6] * inv - bflo(c0.w), acc[7] * inv - bfhi(c0.w));
              *(LAS v4u*)(poolS + t * 136 + ch) = o; } }
        __syncthreads();
        const int m0 = wave * 16, trow = t0 + m0 + fr;
        f32x4 acc[8];
#pragma unroll
        for (int nb = 0; nb < 8; ++nb) acc[nb] = (f32x4){0.f, 0.f, 0.f, 0.f};
#pragma unroll
        for (int kk = 0; kk < 4; ++kk) { const bf16x8 af = *(const bf16x8*)(Wtril + ((size_t)g * 128 + m0 + fr) * 128 + kk * 32 + fq * 8);
#pragma unroll
            for (int nb = 0; nb < 8; ++nb) { const bf16x8 bfr = *(const LAS bf16x8*)(vnT + (nb * 16 + fr) * 136 + kk * 32 + fq * 8); acc[nb] = __builtin_amdgcn_mfma_f32_16x16x32_bf16(bfr, af, acc[nb], 0, 0, 0); } }
        { const float bias = b_s[g * 128 + m0 + fr];
#pragma unroll
          for (int nb = 0; nb < 8; ++nb) { const int col = g * 128 + nb * 16 + 4 * fq; const v2u uv = *(const v2u*)(P0 + (size_t)trow * E_IN + col);
              v2u o; o.x = pk2(bflo(uv.x) * (acc[nb][0] + bias), bfhi(uv.x) * (acc[nb][1] + bias)); o.y = pk2(bflo(uv.y) * (acc[nb][2] + bias), bfhi(uv.y) * (acc[nb][3] + bias));
              *(v2u*)(MIX + (size_t)trow * D + col) = o; } }
#pragma unroll
        for (int nb = 0; nb < 8; ++nb) acc[nb] = (f32x4){0.f, 0.f, 0.f, 0.f};
#pragma unroll
        for (int kk = 0; kk < 4; ++kk) { const bf16x8 af = *(const LAS bf16x8*)(poolS + (m0 + fr) * 136 + kk * 32 + fq * 8);
#pragma unroll
            for (int nb = 0; nb < 8; ++nb) { const bf16x8 bfr = *(const bf16x8*)(wgT + ((size_t)g * 128 + nb * 16 + fr) * 128 + kk * 32 + fq * 8); acc[nb] = __builtin_amdgcn_mfma_f32_16x16x32_bf16(bfr, af, acc[nb], 0, 0, 0); } }
#pragma unroll
        for (int nb = 0; nb < 8; ++nb) { const int e = g * 128 + nb * 16 + 4 * fq; const f32x4 sc = *(const f32x4*)(b_sc + e);
            v2u o; o.x = pk2(acc[nb][0] * sc.x, acc[nb][1] * sc.y); o.y = pk2(acc[nb][2] * sc.z, acc[nb][3] * sc.w);
            *(v2u*)(MIX + (size_t)trow * D + 512 + e) = o; }
        __syncthreads();
    }
}

namespace att {
constexpr int KSLOT = 24576, VSLOT = 16384, LDS_K = 0, LDS_V = 2 * KSLOT, LDS_WS = LDS_V + 2 * VSLOT;
constexpr float SCALE = 0.07216878364870323f;
constexpr float THR = 8.f;
__device__ __forceinline__ int k_nope_off(int row, int colB) { return row * 256 + (colB ^ ((row & 7) << 4)); }
__device__ __forceinline__ int k_rope_off(int row, int cB) { return 16384 + row * 128 + (cB ^ (((row >> 1) & 7) << 4)); }
__device__ __forceinline__ int v_st(int k, int c) { const int kk = (k & ~0xC) | ((k & 4) << 1) | ((k & 8) >> 1); return ((kk >> 3) * 4 + (c >> 5)) * 512 + ((kk & 7) * 32 + (c & 31)) * 2; }
__device__ __forceinline__ int v_rd_base(int lane) { return ((lane & 3) << 3) | (((lane >> 2) & 3) << 6) | (((lane >> 4) & 1) << 5) | (((lane >> 5) & 1) << 8); }
constexpr int v_rd_off(int d0, int ks, int half) { return d0 * 512 + ks * 4096 + half * 2048; }
__device__ __forceinline__ int crow(int r, int hi) { return (r & 3) + 8 * (r >> 2) + 4 * hi; }
__device__ __forceinline__ unsigned cvtpk(float lo, float hi) { unsigned r; asm volatile("v_cvt_pk_bf16_f32 %0, %1, %2" : "=v"(r) : "v"(lo), "v"(hi)); return r; }
#define SBAR() __builtin_amdgcn_sched_barrier(0)
__device__ __forceinline__ void mask_tile(f32x16& p0, f32x16& p1, int dq) {
    const float NEG = -__builtin_inff();
#pragma unroll
    for (int r = 0; r < 16; ++r) { const int c = (r & 3) + 8 * (r >> 2); if (dq - c < 0) p0[r] = NEG; if (dq - c - 32 < 0) p1[r] = NEG; }
}
__device__ __forceinline__ void partialSM(f32x16& p0, f32x16& p1, float& m_reg, float& mn, float& alpha) {
    float pmax = p0[0];
#pragma unroll
    for (int r = 1; r < 16; ++r) pmax = fmaxf(pmax, p0[r]);
#pragma unroll
    for (int r = 0; r < 16; ++r) pmax = fmaxf(pmax, p1[r]);
    { auto rr = __builtin_amdgcn_permlane32_swap(__float_as_uint(pmax), __float_as_uint(pmax), false, false); pmax = fmaxf(__uint_as_float(rr[0]), __uint_as_float(rr[1])); }
    constexpr float C2 = 1.4426950408889634f * SCALE;
    if (__builtin_expect(__all((pmax - m_reg) * SCALE <= THR), 1)) { mn = m_reg; alpha = 1.f; }
    else { mn = fmaxf(m_reg, pmax); alpha = __builtin_amdgcn_exp2f((m_reg - mn) * C2); m_reg = mn; }
    const float mnL = -mn * C2;
#pragma unroll
    for (int r = 0; r < 16; ++r) p0[r] = fmaf(p0[r], C2, mnL);
#pragma unroll
    for (int r = 0; r < 16; ++r) p1[r] = fmaf(p1[r], C2, mnL);
#pragma unroll
    for (int r = 0; r < 16; ++r) p0[r] = __builtin_amdgcn_exp2f(p0[r]);
}
__device__ __forceinline__ void finishSM(f32x16& p0, f32x16& p1, float alpha, float& l_reg, bf16x8& pa0, bf16x8& pa1, bf16x8& pa2, bf16x8& pa3) {
#pragma unroll
    for (int r = 0; r < 16; ++r) p1[r] = __builtin_amdgcn_exp2f(p1[r]);
    float ps = 0;
#pragma unroll
    for (int r = 0; r < 16; ++r) ps += p0[r];
#pragma unroll
    for (int r = 0; r < 16; ++r) ps += p1[r];
    { auto rr = __builtin_amdgcn_permlane32_swap(__float_as_uint(ps), __float_as_uint(ps), false, false); ps = __uint_as_float(rr[0]) + __uint_as_float(rr[1]); }
    l_reg = l_reg * alpha + ps;
#define PK4(P, B_, OUT) do { unsigned a0 = cvtpk(P[B_+0], P[B_+1]), a1 = cvtpk(P[B_+2], P[B_+3]);                          \
        unsigned b0 = cvtpk(P[B_+4], P[B_+5]), b1 = cvtpk(P[B_+6], P[B_+7]);                                             \
        auto r0 = __builtin_amdgcn_permlane32_swap(a0, b0, false, false); auto r1 = __builtin_amdgcn_permlane32_swap(a1, b1, false, false); \
        v4u w = {r0[0], r1[0], r0[1], r1[1]}; OUT = __builtin_bit_cast(bf16x8, w); } while (0)
    PK4(p0, 0, pa0); PK4(p0, 8, pa1); PK4(p1, 0, pa2); PK4(p1, 8, pa3);
#undef PK4
}
template <int KB>
__device__ __forceinline__ void qkt(f32x16& p0, f32x16& p1, const LAS char* Kl, int r32, int hi, const bf16x8* qr) {
    p0 = f32x16{}; p1 = f32x16{};
    const LAS char* kb[4];
#pragma unroll
    for (int dd = 0; dd < 4; ++dd) kb[dd] = Kl + KB * KSLOT + k_nope_off(r32, (dd * 16 + hi * 8) * 2);
#pragma unroll
    for (int d0 = 0; d0 < 8; ++d0) { const LAS char* ap = kb[d0 & 3] + (d0 >> 2) * 128;
        const bf16x8 b0 = *(const LAS bf16x8*)ap; const bf16x8 b1 = *(const LAS bf16x8*)(ap + 32 * 256);
        p0 = __builtin_amdgcn_mfma_f32_32x32x16_bf16(b0, qr[d0], p0, 0, 0, 0);
        p1 = __builtin_amdgcn_mfma_f32_32x32x16_bf16(b1, qr[d0], p1, 0, 0, 0); }
#pragma unroll
    for (int dr = 0; dr < 4; ++dr) { const LAS char* ap = Kl + KB * KSLOT + k_rope_off(r32, dr * 32 + hi * 16);
        const bf16x8 b0 = *(const LAS bf16x8*)ap; const bf16x8 b1 = *(const LAS bf16x8*)(ap + 32 * 128);
        p0 = __builtin_amdgcn_mfma_f32_32x32x16_bf16(b0, qr[8 + dr], p0, 0, 0, 0);
        p1 = __builtin_amdgcn_mfma_f32_32x32x16_bf16(b1, qr[8 + dr], p1, 0, 0, 0); }
}
template <int VB>
__device__ __forceinline__ void pv_tile(f32x16* o, int vb0, bf16x8 pa0, bf16x8 pa1, bf16x8 pa2, bf16x8 pa3) {
#define TRRD(dst, off) asm volatile("ds_read_b64_tr_b16 %0, %1 offset:%2" : "=&v"(dst) : "v"(vb0), "i"(off) : "memory")
#define PV_D0(d0) do { s16x4 l0, l1, l2, l3, h0, h1, h2, h3; constexpr int b_ = VB * VSLOT + v_rd_off(d0, 0, 0); \
        TRRD(l0, b_); TRRD(h0, b_ + 2048); TRRD(l1, b_ + 4096); TRRD(h1, b_ + 6144); TRRD(l2, b_ + 8192); TRRD(h2, b_ + 10240); TRRD(l3, b_ + 12288); TRRD(h3, b_ + 14336); \
        asm volatile("s_waitcnt lgkmcnt(0)" ::: "memory"); SBAR(); \
        o[d0] = __builtin_amdgcn_mfma_f32_32x32x16_bf16(pa0, (bf16x8){l0[0], l0[1], l0[2], l0[3], h0[0], h0[1], h0[2], h0[3]}, o[d0], 0, 0, 0);   \
        o[d0] = __builtin_amdgcn_mfma_f32_32x32x16_bf16(pa1, (bf16x8){l1[0], l1[1], l1[2], l1[3], h1[0], h1[1], h1[2], h1[3]}, o[d0], 0, 0, 0);   \
        o[d0] = __builtin_amdgcn_mfma_f32_32x32x16_bf16(pa2, (bf16x8){l2[0], l2[1], l2[2], l2[3], h2[0], h2[1], h2[2], h2[3]}, o[d0], 0, 0, 0);   \
        o[d0] = __builtin_amdgcn_mfma_f32_32x32x16_bf16(pa3, (bf16x8){l3[0], l3[1], l3[2], l3[3], h3[0], h3[1], h3[2], h3[3]}, o[d0], 0, 0, 0); } while (0)
    PV_D0(0); PV_D0(1); PV_D0(2); PV_D0(3);
#undef PV_D0
#undef TRRD
}
__device__ __forceinline__ void glds16(const void* gsrc, unsigned lds_dst) { unsigned keep;
    asm volatile("s_mov_b32 %0, m0\n\ts_mov_b32 m0, %2\n\ts_nop 0\n\tglobal_load_lds_dwordx4 %1, off\n\ts_mov_b32 m0, %0" : "=&s"(keep) : "v"(gsrc), "s"(lds_dst) : "memory"); }
#define WAITBAR0() asm volatile("s_waitcnt vmcnt(0) lgkmcnt(0)\n\ts_barrier" ::: "memory")

__device__ __forceinline__ void attn_block(int h, int qb, int j_lo, int j_hi, int part, const bf16* QF, const unsigned char* KIMG, const unsigned char* VIMG, bf16* MIX, float* PART, float* PML, char* lds) {
    const int tid = threadIdx.x, wid = __builtin_amdgcn_readfirstlane(tid >> 6), lane = tid & 63, r32 = lane & 31, hi = lane >> 5;
    const int NT = j_hi - j_lo, q0 = qb * 256, qlo = q0 + wid * 32, qm = qlo + r32 - 4 * hi;
    const unsigned lds0 = (unsigned)(uintptr_t)lds;
    const LAS char* Kl = (const LAS char*)lds + LDS_K;
    LAS float* wsf = (LAS float*)((LAS char*)lds + LDS_WS) + wid * 64; LAS float* li_l = wsf; LAS float* al_l = wsf + 32;
    const int vb0 = (int)(lds0 + LDS_V) + v_rd_base(lane);
    const unsigned char* kimg = KIMG + ((size_t)h * 256 + j_lo) * KSLOT + (size_t)(3 * wid) * 1024 + lane * 16;
    const unsigned char* vimg = VIMG + ((size_t)h * 256 + j_lo) * VSLOT + (size_t)(2 * wid) * 1024 + lane * 16;
    const unsigned kdst = lds0 + LDS_K + (3 * wid) * 1024, vdst = lds0 + LDS_V + (2 * wid) * 1024;
#define DMA_K(t, slot) do { const unsigned char* s_ = kimg + (size_t)(t) * KSLOT; const unsigned d_ = (unsigned)__builtin_amdgcn_readfirstlane(kdst + (slot) * KSLOT); \
        glds16(s_, d_); glds16(s_ + 1024, d_ + 1024); glds16(s_ + 2048, d_ + 2048); } while (0)
#define DMA_V(t, slot) do { const unsigned char* s_ = vimg + (size_t)(t) * VSLOT; const unsigned d_ = (unsigned)__builtin_amdgcn_readfirstlane(vdst + (slot) * VSLOT); \
        glds16(s_, d_); glds16(s_ + 1024, d_ + 1024); } while (0)
    DMA_K(0, 0);
    bf16x8 qr[12];
    { const bf16* qp = QF + ((size_t)h * S + q0 + wid * 32 + r32) * 192 + hi * 8;
#pragma unroll
      for (int d0 = 0; d0 < 12; ++d0) qr[d0] = *(const bf16x8*)(qp + d0 * 16); }
    float m_reg = -1e30f, l_reg = 0.f; f32x16 o[4]; o[0] = f32x16{}; o[1] = f32x16{}; o[2] = f32x16{}; o[3] = f32x16{};
    f32x16 pA0, pA1, pB0, pB1; float mnA, mnB, alA = 1.f, alB = 1.f; bf16x8 pa0, pa1, pa2, pa3;
#define RESC(a_) do { if (__any((a_) < 1.f)) { if (hi == 0) al_l[r32] = (a_); asm volatile("s_waitcnt lgkmcnt(0)" ::: "memory"); \
        _Pragma("unroll") for (int d_ = 0; d_ < 4; ++d_) _Pragma("unroll") for (int r = 0; r < 16; ++r) o[d_][r] *= al_l[crow(r, hi)]; } } while (0)
#define MASKT(P0_, P1_, t) do { const int kb_ = (j_lo + (t)) * 64; if (kb_ + 63 > qlo) mask_tile(P0_, P1_, qm - kb_); } while (0)
    WAITBAR0();
    DMA_K(1, 1); DMA_V(0, 0);
    SBAR(); qkt<0>(pA0, pA1, Kl, r32, hi, qr); MASKT(pA0, pA1, 0); partialSM(pA0, pA1, m_reg, mnA, alA);
#define STEP(PX0, PX1, mnX, alX, PY0, PY1, alY, t, KB, VB) do { \
        WAITBAR0(); \
        if ((t) + 1 < NT) DMA_K((t) + 1, (KB) ^ 1); DMA_V((t), (VB) ^ 1); \
        SBAR(); qkt<KB>(PX0, PX1, Kl, r32, hi, qr); \
        finishSM(PY0, PY1, alY, l_reg, pa0, pa1, pa2, pa3); SBAR(); \
        pv_tile<VB>(o, vb0, pa0, pa1, pa2, pa3); MASKT(PX0, PX1, (t)); partialSM(PX0, PX1, m_reg, mnX, alX); \
        RESC(alX); } while (0)
    int t = 1;
    for (; t + 1 < NT; t += 2) {
        STEP(pB0, pB1, mnB, alB, pA0, pA1, alA, t, 1, 0);
        STEP(pA0, pA1, mnA, alA, pB0, pB1, alB, t + 1, 0, 1);
    }
    STEP(pB0, pB1, mnB, alB, pA0, pA1, alA, NT - 1, 1, 0);
    WAITBAR0();
    finishSM(pB0, pB1, alB, l_reg, pa0, pa1, pa2, pa3); SBAR();
    pv_tile<1>(o, vb0, pa0, pa1, pa2, pa3);
    if (part < 0) {
    if (hi == 0) li_l[r32] = l_reg; asm volatile("s_waitcnt lgkmcnt(0)" ::: "memory");
    float rli[16];
#pragma unroll
    for (int r = 0; r < 16; ++r) rli[r] = __builtin_amdgcn_rcpf(li_l[crow(r, hi)]);
    bf16* Ow = MIX + (size_t)(q0 + wid * 32) * D + 512 + h * 128;
#pragma unroll
    for (int r = 0; r < 16; ++r) { const int orow = crow(r, hi);
#pragma unroll
        for (int d0 = 0; d0 < 4; ++d0) { const float v = o[d0][r] * rli[r]; const float vn = __shfl_xor(v, 1);
            if ((r32 & 1) == 0) *(unsigned*)(Ow + (size_t)orow * D + d0 * 32 + r32) = cvtpk(v, vn); } }
    } else {
    float* Pw = PART + ((size_t)part * 256 + wid * 32) * 128;
#pragma unroll
    for (int r = 0; r < 16; ++r) { const int orow = crow(r, hi);
#pragma unroll
        for (int d0 = 0; d0 < 4; ++d0) Pw[(size_t)orow * 128 + d0 * 32 + r32] = o[d0][r]; }
    if (hi == 0) { float* ml = PML + ((size_t)part * 256 + wid * 32 + r32) * 2; ml[0] = m_reg; ml[1] = l_reg; }
    }
    asm volatile("s_waitcnt lgkmcnt(0)\n\ts_barrier" ::: "memory");
#undef DMA_K
#undef DMA_V
#undef RESC
#undef MASKT
#undef STEP
}
}

__device__ __forceinline__ void fin_phase(const Args& a, int gw, int NGW, int lane) {
    unsigned char* ws = a.ws;
    const bf16* P1 = (const bf16*)(ws + WS_P1); const bf16* QR = (const bf16*)(ws + WS_QR); const bf16* KVR = (const bf16*)(ws + WS_KVR);
    bf16* QF = (bf16*)(ws + WS_QF); unsigned char* KIMG = ws + WS_KIMG; unsigned char* VIMG = ws + WS_VIMG; bf16* MIX = (bf16*)(ws + WS_MIX);
    const float* cosT = (const float*)(ws + WS_ROPE); const float* sinT = cosT + (size_t)S * 32;
    const float* qnw = (const float*)a.in[I_QNW]; const float* knw = (const float*)a.in[I_KNW]; const float* cw = (const float*)a.in[I_CONV];
    const int hl = lane & 15, h = lane >> 4, c4 = lane & 3;
    float wq[16], wk[16], wkr[16];
#pragma unroll
    for (int e = 0; e < 16; ++e) { wq[e] = hl < 12 ? qnw[hl * 16 + e] : 0.f; wk[e] = hl < 8 ? knw[hl * 16 + e] : 0.f; wkr[e] = knw[128 + c4 * 16 + e]; }
    float cw0[8], cw1[8], cw2[8];
#pragma unroll
    for (int e = 0; e < 8; ++e) { cw0[e] = cw[lane * 8 + e]; cw1[e] = cw[512 + lane * 8 + e]; cw2[e] = cw[1024 + lane * 8 + e]; }
    for (int t = gw; t < S; t += NGW) {
        const bf16* prow = P1 + (size_t)t * O_INP;
        float s_q, s_kv;
        { const v2u r = *(const v2u*)(prow + 1536 + lane * 4); const float x0 = bflo(r.x), x1 = bfhi(r.x), x2 = bflo(r.y), x3 = bfhi(r.y);
          s_q = 1.f / sqrtf(wave_sum((x0 * x0 + x1 * x1) + (x2 * x2 + x3 * x3)) * (1.f / 256.f) + EPS); }
        { const v2u r = *(const v2u*)(prow + 1792 + lane * 4); const float x0 = bflo(r.x), x1 = bfhi(r.x), x2 = bflo(r.y), x3 = bfhi(r.y);
          s_kv = 1.f / sqrtf(wave_sum((x0 * x0 + x1 * x1) + (x2 * x2 + x3 * x3)) * (1.f / 256.f) + EPS); }
        const int fi = (hl & 1) * 16;
        float cs[16], sn[16];
        { const f32x4* cp = (const f32x4*)(cosT + (size_t)t * 32 + fi); const f32x4* sp = (const f32x4*)(sinT + (size_t)t * 32 + fi);
#pragma unroll
          for (int q = 0; q < 4; ++q) { const f32x4 c_ = cp[q], s_ = sp[q]; cs[4 * q] = c_.x; cs[4 * q + 1] = c_.y; cs[4 * q + 2] = c_.z; cs[4 * q + 3] = c_.w; sn[4 * q] = s_.x; sn[4 * q + 1] = s_.y; sn[4 * q + 2] = s_.z; sn[4 * q + 3] = s_.w; } }
        { const v4u r0 = *(const v4u*)(QR + (size_t)t * 1024 + lane * 16), r1 = *(const v4u*)(QR + (size_t)t * 1024 + lane * 16 + 8);
          float x[16] = {bflo(r0.x), bfhi(r0.x), bflo(r0.y), bfhi(r0.y), bflo(r0.z), bfhi(r0.z), bflo(r0.w), bfhi(r0.w), bflo(r1.x), bfhi(r1.x), bflo(r1.y), bfhi(r1.y), bflo(r1.z), bfhi(r1.z), bflo(r1.w), bfhi(r1.w)};
          float ss = 0.f;
#pragma unroll
          for (int e = 0; e < 16; ++e) { x[e] *= s_q; ss += x[e] * x[e]; }
          ss += __shfl_xor(ss, 1); ss += __shfl_xor(ss, 2); ss += __shfl_xor(ss, 4); ss += __shfl_xor(ss, 8);
          const float rq = 1.f / sqrtf(ss * (1.f / 192.f) + EPS);
          float y[16];
#pragma unroll
          for (int e = 0; e < 16; ++e) { const float v = x[e] * rq * wq[e]; const float pr = __shfl_xor(v, 2);
              y[e] = hl < 8 ? v : (hl < 10 ? v * cs[e] - pr * sn[e] : v * cs[e] + pr * sn[e]); }
          if (hl < 12) { v4u o0, o1; o0.x = pk2(y[0], y[1]); o0.y = pk2(y[2], y[3]); o0.z = pk2(y[4], y[5]); o0.w = pk2(y[6], y[7]); o1.x = pk2(y[8], y[9]); o1.y = pk2(y[10], y[11]); o1.z = pk2(y[12], y[13]); o1.w = pk2(y[14], y[15]);
              bf16* qd = QF + ((size_t)h * S + t) * 192 + hl * 16; *(v4u*)qd = o0; *(v4u*)(qd + 8) = o1; } }
        { const v4u r0 = *(const v4u*)(KVR + (size_t)t * 1024 + lane * 16), r1 = *(const v4u*)(KVR + (size_t)t * 1024 + lane * 16 + 8);
          float x[16] = {bflo(r0.x), bfhi(r0.x), bflo(r0.y), bfhi(r0.y), bflo(r0.z), bfhi(r0.z), bflo(r0.w), bfhi(r0.w), bflo(r1.x), bfhi(r1.x), bflo(r1.y), bfhi(r1.y), bflo(r1.z), bfhi(r1.z), bflo(r1.w), bfhi(r1.w)};
          const v4u p0 = *(const v4u*)(prow + 2048 + c4 * 16), p1 = *(const v4u*)(prow + 2048 + c4 * 16 + 8);
          float kp[16] = {bflo(p0.x), bfhi(p0.x), bflo(p0.y), bfhi(p0.y), bflo(p0.z), bfhi(p0.z), bflo(p0.w), bfhi(p0.w), bflo(p1.x), bfhi(p1.x), bflo(p1.y), bfhi(p1.y), bflo(p1.z), bfhi(p1.z), bflo(p1.w), bfhi(p1.w)};
          float ssk = 0.f, ssp = 0.f;
#pragma unroll
          for (int e = 0; e < 16; ++e) { x[e] *= s_kv; ssk += x[e] * x[e]; ssp += kp[e] * kp[e]; }
          if (hl >= 8) ssk = 0.f;
          ssk += __shfl_xor(ssk, 1); ssk += __shfl_xor(ssk, 2); ssk += __shfl_xor(ssk, 4); ssk += __shfl_xor(ssk, 8);
          ssp += __shfl_xor(ssp, 1); ssp += __shfl_xor(ssp, 2);
          const float rk = 1.f / sqrtf((ssk + ssp) * (1.f / 192.f) + EPS);
          const int krow = t & 63, tile = t >> 6;
          unsigned char* kt = KIMG + ((size_t)h * 256 + tile) * att::KSLOT; unsigned char* vt = VIMG + ((size_t)h * 256 + tile) * att::VSLOT;
          float y[16];
#pragma unroll
          for (int e = 0; e < 16; ++e) y[e] = hl < 8 ? x[e] * rk * wk[e] : x[e];
          { v4u o0, o1; o0.x = pk2(y[0], y[1]); o0.y = pk2(y[2], y[3]); o0.z = pk2(y[4], y[5]); o0.w = pk2(y[6], y[7]); o1.x = pk2(y[8], y[9]); o1.y = pk2(y[10], y[11]); o1.z = pk2(y[12], y[13]); o1.w = pk2(y[14], y[15]);
            if (hl < 8) { *(v4u*)(kt + att::k_nope_off(krow, hl * 32)) = o0; *(v4u*)(kt + att::k_nope_off(krow, hl * 32 + 16)) = o1; }
            else { *(v4u*)(vt + att::v_st(krow, (hl - 8) * 16)) = o0; *(v4u*)(vt + att::v_st(krow, (hl - 8) * 16 + 8)) = o1; } }
          float z[16];
#pragma unroll
          for (int e = 0; e < 16; ++e) { const float v = kp[e] * rk * wkr[e]; const float pr = __shfl_xor(v, 2); z[e] = c4 < 2 ? v * cs[e] - pr * sn[e] : v * cs[e] + pr * sn[e]; }
          if (hl < 4) { v4u o0, o1; o0.x = pk2(z[0], z[1]); o0.y = pk2(z[2], z[3]); o0.z = pk2(z[4], z[5]); o0.w = pk2(z[6], z[7]); o1.x = pk2(z[8], z[9]); o1.y = pk2(z[10], z[11]); o1.z = pk2(z[12], z[13]); o1.w = pk2(z[14], z[15]);
              *(v4u*)(kt + att::k_rope_off(krow, c4 * 32)) = o0; *(v4u*)(kt + att::k_rope_off(krow, c4 * 32 + 16)) = o1; } }
        { const int ch = lane * 8; float conv[8] = {0.f, 0.f, 0.f, 0.f, 0.f, 0.f, 0.f, 0.f};
#pragma unroll
          for (int k = 0; k < 3; ++k) { const int tt = t - 2 + k; if (tt >= 0) { const bf16* pr = P1 + (size_t)tt * O_INP; const v4u cg = *(const v4u*)(pr + 512 + ch), hh = *(const v4u*)(pr + 1024 + ch);
              const float* wv = k == 0 ? cw0 : (k == 1 ? cw1 : cw2);
              conv[0] += wv[0] * bflo(cg.x) * bflo(hh.x); conv[1] += wv[1] * bfhi(cg.x) * bfhi(hh.x); conv[2] += wv[2] * bflo(cg.y) * bflo(hh.y); conv[3] += wv[3] * bfhi(cg.y) * bfhi(hh.y);
              conv[4] += wv[4] * bflo(cg.z) * bflo(hh.z); conv[5] += wv[5] * bfhi(cg.z) * bfhi(hh.z); conv[6] += wv[6] * bflo(cg.w) * bflo(hh.w); conv[7] += wv[7] * bfhi(cg.w) * bfhi(hh.w); } }
          const v4u bg = *(const v4u*)(prow + ch);
          v4u o; o.x = pk2(bflo(bg.x) * conv[0], bfhi(bg.x) * conv[1]); o.y = pk2(bflo(bg.y) * conv[2], bfhi(bg.y) * conv[3]); o.z = pk2(bflo(bg.z) * conv[4], bfhi(bg.z) * conv[5]); o.w = pk2(bflo(bg.w) * conv[6], bfhi(bg.w) * conv[7]);
          *(v4u*)(MIX + (size_t)t * D + ch) = o; }
    }
}

__device__ __forceinline__ void route1_phase(const Args& a, LAS unsigned char* lds, int vcu, int G, int tid) {
    unsigned char* ws = a.ws; const float* XR = (const float*)(ws + WS_XR); const float* modF = (const float*)(ws + WS_MODF) + 6144;
    const float* nw = (const float*)a.in[I_NFW] + 1024; const float* rw = (const float*)a.in[I_RW];
    unsigned* tok = (unsigned*)(ws + WS_TOK); unsigned* cnt = (unsigned*)(ws + WS_CTL) + CW_CNT;
    const int lane = tid & 63, wave = __builtin_amdgcn_readfirstlane(tid >> 6);
    LAS int* tokE = (LAS int*)lds;
    LAS int* tokL = (LAS int*)(lds + 512);
    LAS int* offS = (LAS int*)(lds + 1024);
    f32x4 g[4], sh[4];
#pragma unroll
    for (int j = 0; j < 4; ++j)
#pragma unroll
        for (int e = 0; e < 4; ++e) { const int col = 4 * lane + e + 256 * j; g[j][e] = nw[col] * (1.f + modF[OFF_SCF + col]); sh[j][e] = modF[OFF_SHF + col]; }
    for (int chunk = vcu; chunk < S / 64; chunk += G) {
        for (int i = 0; i < 8; ++i) { const int ti = wave * 8 + i, t = chunk * 64 + ti;
            const f32x4* xr = (const f32x4*)(XR + (size_t)t * D) + lane; f32x4 v[4]; float s = 0.f;
#pragma unroll
            for (int j = 0; j < 4; ++j) { v[j] = xr[64 * j]; s += (v[j].x * v[j].x + v[j].y * v[j].y) + (v[j].z * v[j].z + v[j].w * v[j].w); }
            const float rstd = 1.f / sqrtf(wave_sum(s) * (1.f / D) + EPS);
            float lg[8] = {0.f, 0.f, 0.f, 0.f, 0.f, 0.f, 0.f, 0.f};
#pragma unroll
            for (int j = 0; j < 4; ++j) { const f32x4 hv = v[j] * rstd * g[j] + sh[j];
#pragma unroll
                for (int e = 0; e < 4; ++e) { const int col = 4 * lane + e + 256 * j; const f32x4 w0 = *(const f32x4*)(rw + col * 8), w1 = *(const f32x4*)(rw + col * 8 + 4); const float hx = hv[e];
                    lg[0] += hx * w0.x; lg[1] += hx * w0.y; lg[2] += hx * w0.z; lg[3] += hx * w0.w; lg[4] += hx * w1.x; lg[5] += hx * w1.y; lg[6] += hx * w1.z; lg[7] += hx * w1.w; } }
#pragma unroll
            for (int e = 0; e < 8; ++e) lg[e] = wave_sum(lg[e]);
            int e1 = 0; float l1 = lg[0];
#pragma unroll
            for (int e = 1; e < 8; ++e) if (lg[e] > l1) { l1 = lg[e]; e1 = e; }
            int e2 = -1; float l2 = -__builtin_inff();
#pragma unroll
            for (int e = 0; e < 8; ++e) if (e != e1 && lg[e] > l2) { l2 = lg[e]; e2 = e; }
            const float g1 = 1.f / (1.f + __expf(l2 - l1)), g2 = 1.f - g1;
            if (lane == 0) { unsigned* rec = tok + (size_t)t * 8; rec[0] = (unsigned)e1; rec[1] = (unsigned)e2; rec[4] = __float_as_uint(g1); rec[5] = __float_as_uint(g2); rec[6] = __float_as_uint(rstd);
                tokE[2 * ti] = e1; tokE[2 * ti + 1] = e2; } }
        __syncthreads();
        if (tid < 8) { int c = 0; for (int i = 0; i < 128; ++i) if (tokE[i] == tid) { tokL[i] = c; ++c; }
            offS[tid] = (int)__hip_atomic_fetch_add(cnt + 64 * tid, (unsigned)c, RLX_AGENT); }
        __syncthreads();
        if (tid < 128) { const int t = chunk * 64 + (tid >> 1); tok[(size_t)t * 8 + 2 + (tid & 1)] = (unsigned)(offS[tokE[tid]] + tokL[tid]); }
        __syncthreads();
    }
}
__device__ __forceinline__ void route2_phase(const Args& a, int gw, int NGW, int lane) {
    unsigned char* ws = a.ws; const float* XR = (const float*)(ws + WS_XR); const float* modF = (const float*)(ws + WS_MODF) + 6144;
    const float* nw = (const float*)a.in[I_NFW] + 1024; unsigned* tok = (unsigned*)(ws + WS_TOK); const unsigned* cnt = (const unsigned*)(ws + WS_CTL) + CW_CNT;
    unsigned char* AM = ws + WS_AMOE;
    f32x4 g[4], sh[4];
#pragma unroll
    for (int j = 0; j < 4; ++j)
#pragma unroll
        for (int e = 0; e < 4; ++e) { const int col = 4 * lane + e + 256 * j; g[j][e] = nw[col] * (1.f + modF[OFF_SCF + col]); sh[j][e] = modF[OFF_SHF + col]; }
    int base[8]; { int b = 0;
#pragma unroll
      for (int e = 0; e < 8; ++e) { base[e] = b; b += (int)((cnt[64 * e] + 255u) >> 8) * 256; } }
    for (int t = gw; t < S; t += NGW) {
        unsigned* rec = tok + (size_t)t * 8; const int e1 = (int)rec[0], e2 = (int)rec[1]; const float rstd = __uint_as_float(rec[6]);
        int b1 = 0, b2 = 0;
#pragma unroll
        for (int e = 0; e < 8; ++e) { b1 = e1 == e ? base[e] : b1; b2 = e2 == e ? base[e] : b2; }
        const int s1 = b1 + (int)rec[2], s2 = b2 + (int)rec[3];
        const f32x4* xr = (const f32x4*)(XR + (size_t)t * D) + lane;
        unsigned* o1 = (unsigned*)(AM + (size_t)s1 * D) + lane; unsigned* o2 = (unsigned*)(AM + (size_t)s2 * D) + lane;
#pragma unroll
        for (int j = 0; j < 4; ++j) { const f32x4 y = xr[64 * j] * rstd * g[j] + sh[j]; const unsigned w = pg8::pk4_fp8(y.x, y.y, y.z, y.w); o1[64 * j] = w; o2[64 * j] = w; }
        if (lane == 0) { rec[2] = (unsigned)s1; rec[3] = (unsigned)s2; }
    }
}
__device__ __forceinline__ void combine_phase(const Args& a, int gw, int NGW, int lane) {
    unsigned char* ws = a.ws; const float* XR = (const float*)(ws + WS_XR); const float* gf = (const float*)(ws + WS_MODF) + 6144 + OFF_GF;
    const unsigned* tok = (const unsigned*)(ws + WS_TOK); const bf16* Y = (const bf16*)(ws + WS_AMOE);
    f32x4 gg[4];
#pragma unroll
    for (int j = 0; j < 4; ++j) gg[j] = *(const f32x4*)(gf + 4 * lane + 256 * j);
    for (int t = gw; t < S; t += NGW) {
        const unsigned* rec = tok + (size_t)t * 8; const int s1 = (int)rec[2], s2 = (int)rec[3]; const float g1 = __uint_as_float(rec[4]), g2 = __uint_as_float(rec[5]);
        const f32x4* xr = (const f32x4*)(XR + (size_t)t * D) + lane; f32x4* orow = (f32x4*)(a.out + (size_t)t * D) + lane;
        const v2u* y1 = (const v2u*)(Y + (size_t)s1 * D) + lane; const v2u* y2 = (const v2u*)(Y + (size_t)s2 * D) + lane;
#pragma unroll
        for (int j = 0; j < 4; ++j) { const v2u a1 = y1[64 * j], a2 = y2[64 * j];
            f32x4 m; m.x = g1 * bflo(a1.x) + g2 * bflo(a2.x); m.y = g1 * bfhi(a1.x) + g2 * bfhi(a2.x); m.z = g1 * bflo(a1.y) + g2 * bflo(a2.y); m.w = g1 * bfhi(a1.y) + g2 * bfhi(a2.y);
            orow[64 * j] = xr[64 * j] + gg[j] * m; }
    }
}

constexpr int N_PHASES = 19;
__global__ void __launch_bounds__(NTHR, 2) fwd_kernel(Args args) {
    extern __shared__ __attribute__((aligned(16))) unsigned char lds[];
    LAS unsigned char* L = (LAS unsigned char*)lds;
    const int tid = threadIdx.x, lane = tid & 63, wave = __builtin_amdgcn_readfirstlane(tid >> 6);
    const int G = gridDim.x; const int bx = blockIdx.x; const int vcu = (G % 8 == 0) ? (bx % 8) * (G / 8) + bx / 8 : bx;
    const int gw = vcu * NWAVES + wave, NGW = G * NWAVES;
    unsigned char* ws = args.ws;
    for (int u = tid; u < (LDS_BYTES - LDSCTL_OFF) / 4; u += NTHR) ((LAS unsigned*)(L + LDSCTL_OFF))[u] = 0u;
    __syncthreads();
    XcdBarrier bar; bar.bar = (unsigned*)(ws + WS_CTL) + CW_BAR; bar.x = 0; bar.st = nullptr;
#if !MK_MULTI
    bar = xcd_barrier_post((unsigned*)(ws + WS_CTL) + CW_BAR, (volatile LAS unsigned*)(L + MISC_OFF) + 8);
#define GRID_BAR() xcd_barrier(bar)
#else
#define GRID_BAR() do {} while (0)
#endif
    const int lo = args.ph_lo, hi = args.ph_hi;
#define IN(k) (lo <= (k) && (k) < hi)
#define BOTH(k) (IN(k) && IN((k) + 1))
    const float* modF = (const float*)(ws + WS_MODF);
    bf16* ABUF = (bf16*)(ws + WS_ABUF); bf16* MIX = (bf16*)(ws + WS_MIX); float* XR = (float*)(ws + WS_XR);

    if (IN(0)) { p0_prologue(args, L, vcu, G, tid); if (DBG_REP == 0) { GRID_BAR(); p0_prologue(args, L, vcu, G, tid); } if (BOTH(0)) GRID_BAR(); }
    if (IN(1)) {
        { float* mf = (float*)(ws + WS_MODF); for (int i = vcu * NTHR + tid; i < 2 * 6144; i += G * NTHR) mf[i] = modv_partial((const float*)(ws + WS_MODP), (const float*)args.in[I_ADAB], i / 6144, i % 6144); }
        norm_phase<true>(args, (const float*)args.in[I_X], ABUF, (const float*)args.in[I_NMW], 0, OFF_SHM, OFF_SCM, gw, NGW, lane);
        if (BOTH(1)) GRID_BAR(); }
    if (IN(2)) { pg8::Gemm g{ABUF, ws + WS_WIN0, 2048, 2048}; pg8::StaticOrder So; So.init(S, E_IN, G, bx);
        pg8::EpiBf16G E{(bf16*)(ws + WS_P0), E_IN, 4, 1.f}; pg8::gemm_phase(L, g, So, E); if (BOTH(2)) GRID_BAR(); }
    if (IN(3)) { mixab_phase(args, L, vcu, G, tid); if (BOTH(3)) GRID_BAR(); }
    if (IN(4)) { pg8::Gemm g{MIX, ws + WS_WOUT0, 2048, 2048}; pg8::StaticOrder So; So.init(S, 1024, G, bx);
        pg8::EpiRes E{(const float*)args.in[I_X], XR, modF + OFF_GM}; pg8::gemm_phase(L, g, So, E); if (BOTH(4)) GRID_BAR(); }
    if (IN(5)) { norm_phase<false>(args, XR, ABUF, (const float*)args.in[I_NFW], 0, OFF_SHF, OFF_SCF, gw, NGW, lane); if (BOTH(5)) GRID_BAR(); }
    if (IN(6)) { pg8::Gemm g{ABUF, ws + WS_WGU0, 2048, 2048}; pg8::StaticOrder So; So.init(S, 2 * D_FF, G, bx);
        pg8::EpiSwiGLU E{(bf16*)(ws + WS_H), D_FF}; pg8::gemm_phase(L, g, So, E); if (BOTH(6)) GRID_BAR(); }
    if (IN(7)) { pg8::Gemm g{ws + WS_H, ws + WS_WD0, D_FF * 2, D_FF * 2}; pg8::StaticOrder So; So.init(S, 1024, G, bx);
        pg8::EpiRes E{XR, XR, modF + OFF_GF}; pg8::gemm_phase(L, g, So, E); if (BOTH(7)) GRID_BAR(); }
    if (IN(8)) { norm_phase<false>(args, XR, ABUF, (const float*)args.in[I_NMW] + 1024, 1, OFF_SHM, OFF_SCM, gw, NGW, lane); if (BOTH(8)) GRID_BAR(); }
    if (IN(9)) { pg8::Gemm g{ABUF, ws + WS_WIN1, 2048, 2048}; pg8::StaticOrder So; So.init(S, O_INP, G, bx);
        pg8::EpiBf16G E{(bf16*)(ws + WS_P1), O_INP, 0, 1.f}; pg8::gemm_phase(L, g, So, E); if (BOTH(9)) GRID_BAR(); }
    if (IN(10)) {
        { pg8::Gemm g{(const bf16*)(ws + WS_P1) + 1536, ws + WS_WUQ, O_INP * 2, 512}; pg8::StaticOrder So; So.init(S, 1024, G, bx);
          pg8::EpiBf16G E{(bf16*)(ws + WS_QR), 1024, 0, 1.f}; pg8::gemm_phase(L, g, So, E); }
        { pg8::Gemm g{(const bf16*)(ws + WS_P1) + 1792, ws + WS_WUKV, O_INP * 2, 512}; pg8::StaticOrder So; So.init(S, 1024, G, bx);
          pg8::EpiBf16G E{(bf16*)(ws + WS_KVR), 1024, 0, 1.f}; pg8::gemm_phase(L, g, So, E); }
        if (BOTH(10)) GRID_BAR(); }
    if (IN(11)) { fin_phase(args, gw, NGW, lane); if (BOTH(11)) GRID_BAR(); }
    if (IN(12)) {
        for (int rep = 0; rep < (DBG_REP == 12 ? 2 : 1); ++rep) { if (rep) GRID_BAR();
        for (int u = bx; u < 256; u += G) { const int h = u & 3, v = u >> 2, sb = v >> 1, role = v & 1, nA = 126 - 4 * sb, pi = (h * 32 + sb) * 2;
            const bf16* QF = (const bf16*)(ws + WS_QF); float* PART = (float*)(ws + WS_PART); float* PML = (float*)(ws + WS_PML);
            if (role == 0) { att::attn_block(h, sb, 0, 4 * (sb + 1), -1, QF, ws + WS_KIMG, ws + WS_VIMG, MIX, PART, PML, (char*)lds);
                             att::attn_block(h, 63 - sb, 0, nA, pi, QF, ws + WS_KIMG, ws + WS_VIMG, MIX, PART, PML, (char*)lds); }
            else att::attn_block(h, 63 - sb, nA, 4 * (64 - sb), pi + 1, QF, ws + WS_KIMG, ws + WS_VIMG, MIX, PART, PML, (char*)lds); } }
        GRID_BAR();
        { const float* PART = (const float*)(ws + WS_PART); const float* PML = (const float*)(ws + WS_PML); constexpr float C2 = 1.4426950408889634f * att::SCALE;
          for (int rw = gw; rw < 128 * 256; rw += NGW) { const int blk = rw >> 8, row = rw & 255, h = blk >> 5, sb = blk & 31, pi = blk * 2;
              const float mA = PML[((size_t)pi * 256 + row) * 2], lA = PML[((size_t)pi * 256 + row) * 2 + 1], mB = PML[((size_t)(pi + 1) * 256 + row) * 2], lB = PML[((size_t)(pi + 1) * 256 + row) * 2 + 1];
              const float m = fmaxf(mA, mB), wA = __builtin_amdgcn_exp2f((mA - m) * C2), wB = __builtin_amdgcn_exp2f((mB - m) * C2), inv = 1.f / (lA * wA + lB * wB);
              const float* oa = PART + ((size_t)pi * 256 + row) * 128 + lane * 2; const float* ob = PART + ((size_t)(pi + 1) * 256 + row) * 128 + lane * 2;
              const float v0 = (oa[0] * wA + ob[0] * wB) * inv, v1 = (oa[1] * wA + ob[1] * wB) * inv;
              *(unsigned*)(MIX + (size_t)((63 - sb) * 256 + row) * D + 512 + h * 128 + lane * 2) = pk2(v0, v1); } }
        if (BOTH(12)) GRID_BAR(); }
    if (IN(13)) { pg8::Gemm g{MIX, ws + WS_WOUT1, 2048, 2048}; pg8::StaticOrder So; So.init(S, 1024, G, bx);
        pg8::EpiRes E{XR, XR, modF + 6144 + OFF_GM}; pg8::gemm_phase(L, g, So, E); if (BOTH(13)) GRID_BAR(); }
    if (IN(14)) { route1_phase(args, L, vcu, G, tid); if (BOTH(14)) GRID_BAR(); }
    if (IN(15)) { route2_phase(args, gw, NGW, lane); if (BOTH(15)) GRID_BAR(); }
    if (IN(16)) { pg8::Gemm g{ws + WS_AMOE, ws + WS_WGUM, 1024, 1024}; pg8::MoeOrder Mo; Mo.init((const unsigned*)(ws + WS_CTL) + CW_CNT, 28, G, vcu);
        pg8::EpiSwiGLU8 E{ws + WS_HM, DFE, 1.f / MOE_WSCALE}; pg8::gemm_phase<pg8::EpiSwiGLU8, pg8::MoeOrder, true>(L, g, Mo, E); if (BOTH(16)) GRID_BAR(); }
    if (IN(17)) { pg8::Gemm g{ws + WS_HM, ws + WS_WDM, DFE, DFE}; pg8::MoeOrder Mo; Mo.init((const unsigned*)(ws + WS_CTL) + CW_CNT, 4, G, vcu);
        pg8::EpiBf16G E{(bf16*)(ws + WS_AMOE), 1024, 0, 1.f / MOE_WSCALE}; pg8::gemm_phase<pg8::EpiBf16G, pg8::MoeOrder, true>(L, g, Mo, E); if (BOTH(17)) GRID_BAR(); }
    if (IN(18)) { combine_phase(args, gw, NGW, lane); }
    if (IN(19)) { const f32x4* src = (const f32x4*)(DBG_STOP < 4 ? (const float*)args.in[I_X] : (const float*)XR); f32x4* dst = (f32x4*)args.out;
        for (size_t i = (size_t)vcu * NTHR + tid; i < (size_t)S * D / 4; i += (size_t)G * NTHR) dst[i] = src[i]; }
#undef IN
#undef BOTH
}

extern "C" void kernel_launch(void* const* d_in, const int* in_sizes, int n_in, void* d_out, int out_size, void* d_ws, size_t ws_size, hipStream_t stream) {
    static int grid = 0;
    if (grid == 0) {
        if (n_in != 29 || out_size != S * D || ws_size < WS_END) { fprintf(stderr, "kernel_launch: unexpected shapes (n_in %d out %d ws %zu)\n", n_in, out_size, ws_size); grid = -1; return; }
        int dev = 0, cus = 0;
        if (hipGetDevice(&dev) != hipSuccess || hipDeviceGetAttribute(&cus, hipDeviceAttributeMultiprocessorCount, dev) != hipSuccess) { grid = -1; return; }
        if (hipFuncSetAttribute((const void*)fwd_kernel, hipFuncAttributeMaxDynamicSharedMemorySize, LDS_BYTES) != hipSuccess) { grid = -1; return; }
        int per_cu = 0;
        if (hipOccupancyMaxActiveBlocksPerMultiprocessor(&per_cu, (const void*)fwd_kernel, NTHR, LDS_BYTES) != hipSuccess || per_cu < 1) fprintf(stderr, "kernel_launch: occupancy query says %d\n", per_cu);
        (void)hipGetLastError();
        grid = cus;
    }
    if (grid < 0) return;
    (void)hipMemsetAsync((char*)d_ws + WS_CTL, 0, CTL_ZERO_BYTES, stream);
    Args a{};
    for (int i = 0; i < 29; ++i) a.in[i] = d_in[i];
    a.out = (float*)d_out; a.ws = (unsigned char*)d_ws;
#if MK_MULTI
    { const int last = DBG_STOP < 0 ? N_PHASES - 1 : DBG_STOP;
      for (int p = 0; p <= last; ++p) { a.ph_lo = p; a.ph_hi = p + 1; hipLaunchKernelGGL(fwd_kernel, dim3(grid), dim3(NTHR), LDS_BYTES, stream, a); }
      if (DBG_STOP >= 0) { a.ph_lo = 19; a.ph_hi = 20; hipLaunchKernelGGL(fwd_kernel, dim3(grid), dim3(NTHR), LDS_BYTES, stream, a); } }
#else
    a.ph_lo = 0; a.ph_hi = N_PHASES;
    hipLaunchKernelGGL(fwd_kernel, dim3(grid), dim3(NTHR), LDS_BYTES, stream, a);
#endif
}
```

```cpp
#include <hip/hip_runtime.h>
#include <cstdio>
#include <cstdint>

#ifndef MK_MULTI
#define MK_MULTI 0
#endif
#ifndef FFN_FP8
#define FFN_FP8 0
#endif
#ifndef DBG_EPI2
#define DBG_EPI2 0
#endif
#ifndef DBG_DUMMY
#define DBG_DUMMY 0
#endif
#ifndef XCC_ORDER
#define XCC_ORDER 1
#endif
#ifndef DBG_QK2
#define DBG_QK2 0
#endif
#ifndef DBG_REP
#define DBG_REP -1
#endif
#ifndef DBG_STOP
#define DBG_STOP -1
#endif

namespace pg8 {
#define PG8_LAS __attribute__((address_space(3)))
typedef unsigned short bf16_t;
typedef short bf16x8 __attribute__((ext_vector_type(8)));
typedef float f32x4 __attribute__((ext_vector_type(4)));
typedef float f32x2 __attribute__((ext_vector_type(2)));
typedef unsigned u32x4 __attribute__((ext_vector_type(4)));
typedef unsigned u32x2 __attribute__((ext_vector_type(2)));
typedef int i32x4 __attribute__((ext_vector_type(4)));
typedef int i32x8 __attribute__((ext_vector_type(8)));
constexpr int BM = 256, BK = 64, HALF = 128, HTB = HALF * BK * 2, STAGE_BYTES = 8 * HTB, NXCD = 8, WGM = 8;

__host__ __device__ __forceinline__ int lds_byte(int r, int c) { const int st = (r >> 4) * 2 + (c >> 5), rr = r & 15, cc = c & 31, ob = rr * 64 + cc * 2; return st * 1024 + (ob ^ (((ob >> 9) & 1) << 5)); }
__host__ __device__ __forceinline__ void stage_rc(int b, int& R, int& C) { const int st = b / 1024, sb = b % 1024, swz = sb ^ (((sb >> 9) & 1) << 5); R = (st >> 1) * 16 + swz / 64; C = (st & 1) * 32 + (swz % 64) / 2; }
__host__ __device__ __forceinline__ int perm32(int rho) { const int n = rho >> 4, i = rho & 15; return 8 * (i >> 2) + 4 * n + (i & 3); }

struct Unit { int pm, pn, po; };
struct Gemm { const void* A; const void* Bt; int ldaB, KB; };

struct StaticOrder {
    int nM, nN, nwg, G, c;
    __device__ void init(int M, int N, int G_, int c_) { nM = M / BM; nN = N / BM; nwg = nM * nN; G = G_; c = c_; }
    __device__ bool next(int i, Unit& u) const {
        const long L = (long)i * G + c; if (L >= nwg) return false;
        int wgid = (int)L; { const int q = nwg / NXCD, r = nwg % NXCD, xcd = wgid % NXCD, off = wgid / NXCD; wgid = (xcd < r ? xcd * (q + 1) : r * (q + 1) + (xcd - r) * q) + off; }
        const int nig = WGM * nN, gid = wgid / nig, fm = gid * WGM, gsz = (nM - fm) < WGM ? (nM - fm) : WGM;
        u.pm = fm + ((wgid % nig) % gsz); u.pn = (wgid % nig) / gsz; u.po = u.pn; return true;
    }
};
struct MoeOrder {
    unsigned p0, p1; int nct, G, c;
    __device__ void init(const unsigned* cnt, int nct_, int G_, int c_) {
        p0 = 0u; p1 = 0u;
#pragma unroll
        for (int q = 0; q < 4; ++q) { p0 |= ((__hip_atomic_load(cnt + 64 * q, __ATOMIC_RELAXED, __HIP_MEMORY_SCOPE_AGENT) + 255u) >> 8) << (8 * q); p1 |= ((__hip_atomic_load(cnt + 64 * (q + 4), __ATOMIC_RELAXED, __HIP_MEMORY_SCOPE_AGENT) + 255u) >> 8) << (8 * q); }
        nct = nct_; G = G_; c = c_;
    }
    __device__ bool next(int i, Unit& u) const {
        const int L = i * G + c; int cum = 0, tb = 0; bool found = false;
#pragma unroll
        for (int q = 0; q < 8; ++q) { const int rte = (int)(((q < 4 ? p0 : p1) >> (8 * (q & 3))) & 255u); const int n_ = rte * nct;
            if (!found && L < cum + n_) { const int r_ = L - cum, nig = WGM * nct, gid = r_ / nig, fm = gid * WGM, gsz = (rte - fm) < WGM ? (rte - fm) : WGM, rem = r_ - gid * nig;
                u.pm = tb + fm + rem % gsz; u.po = rem / gsz; u.pn = q * nct + u.po; found = true; } cum += n_; tb += rte; }
        return found;
    }
};

__device__ __forceinline__ unsigned cvt_pk_bf16(float lo, float hi) { unsigned r; asm volatile("v_cvt_pk_bf16_f32 %0, %1, %2" : "=v"(r) : "v"(lo), "v"(hi)); return r; }
__device__ __forceinline__ float gelu_tanh(float x) {
    const float u2 = x * (1.5957691216057308f + 0.07135481282599649f * x * x);
    return x * __builtin_amdgcn_rcpf(1.0f + __builtin_amdgcn_exp2f(-1.4426950408889634f * u2));
}
__device__ __forceinline__ float silu_f(float x) { return x * __builtin_amdgcn_rcpf(1.0f + __builtin_amdgcn_exp2f(-1.4426950408889634f * x)); }

struct EpiBf16G {
    static constexpr bool PERM = true;
    bf16_t* O; int ldc; int gelu_tiles; float scale;
    __device__ __forceinline__ void operator()(const f32x4 (&acc)[2][2][4][2], const Unit& u, int wr, int wc, int fr, int fq) const {
        const int row0 = u.pm * BM + wr * 64 + fr, col0 = u.po * BM + wc * 32 + 8 * fq; const bool g = u.po < gelu_tiles;
#pragma unroll
        for (int ai = 0; ai < 2; ++ai)
#pragma unroll
            for (int m = 0; m < 4; ++m) { bf16_t* rowp = O + (size_t)(row0 + ai * HALF + m * 16) * ldc + col0;
#pragma unroll
                for (int bj = 0; bj < 2; ++bj) { f32x4 v0 = acc[ai][bj][m][0] * scale, v1 = acc[ai][bj][m][1] * scale;
                    if (g) { v0 = (f32x4){gelu_tanh(v0[0]), gelu_tanh(v0[1]), gelu_tanh(v0[2]), gelu_tanh(v0[3])}; v1 = (f32x4){gelu_tanh(v1[0]), gelu_tanh(v1[1]), gelu_tanh(v1[2]), gelu_tanh(v1[3])}; }
                    u32x4 w; w.x = cvt_pk_bf16(v0[0], v0[1]); w.y = cvt_pk_bf16(v0[2], v0[3]); w.z = cvt_pk_bf16(v1[0], v1[1]); w.w = cvt_pk_bf16(v1[2], v1[3]);
                    *(u32x4*)(rowp + bj * HALF) = w; } }
    }
};
struct EpiSwiGLU {
    static constexpr bool PERM = true;
    bf16_t* O; int ldc;
    __device__ __forceinline__ void operator()(const f32x4 (&acc)[2][2][4][2], const Unit& u, int wr, int wc, int fr, int fq) const {
        const int row0 = u.pm * BM + wr * 64 + fr, col0 = u.po * HALF + wc * 32 + 8 * fq;
#pragma unroll
        for (int ai = 0; ai < 2; ++ai)
#pragma unroll
            for (int m = 0; m < 4; ++m) { const f32x4 g0 = acc[ai][0][m][0], g1 = acc[ai][0][m][1], u0 = acc[ai][1][m][0], u1 = acc[ai][1][m][1];
                u32x4 w; w.x = cvt_pk_bf16(silu_f(g0[0]) * u0[0], silu_f(g0[1]) * u0[1]); w.y = cvt_pk_bf16(silu_f(g0[2]) * u0[2], silu_f(g0[3]) * u0[3]);
                w.z = cvt_pk_bf16(silu_f(g1[0]) * u1[0], silu_f(g1[1]) * u1[1]); w.w = cvt_pk_bf16(silu_f(g1[2]) * u1[2], silu_f(g1[3]) * u1[3]);
                *(u32x4*)(O + (size_t)(row0 + ai * HALF + m * 16) * ldc + col0) = w; }
    }
};
__device__ __forceinline__ unsigned pk4_fp8(float a, float b, float c, float d) { int w = 0; w = __builtin_amdgcn_cvt_pk_fp8_f32(a, b, w, false); w = __builtin_amdgcn_cvt_pk_fp8_f32(c, d, w, true); return (unsigned)w; }
struct EpiSwiGLU8 {
    static constexpr bool PERM = true;
    unsigned char* O; int ldc; float scale;
    __device__ __forceinline__ void operator()(const f32x4 (&acc)[2][2][4][2], const Unit& u, int wr, int wc, int fr, int fq) const {
        const int row0 = u.pm * BM + wr * 64 + fr, col0 = u.po * HALF + wc * 32 + 8 * fq;
#pragma unroll
        for (int ai = 0; ai < 2; ++ai)
#pragma unroll
            for (int m = 0; m < 4; ++m) { const f32x4 g0 = acc[ai][0][m][0] * scale, g1 = acc[ai][0][m][1] * scale, u0 = acc[ai][1][m][0] * scale, u1 = acc[ai][1][m][1] * scale;
                u32x2 w; w.x = pk4_fp8(silu_f(g0[0]) * u0[0], silu_f(g0[1]) * u0[1], silu_f(g0[2]) * u0[2], silu_f(g0[3]) * u0[3]);
                w.y = pk4_fp8(silu_f(g1[0]) * u1[0], silu_f(g1[1]) * u1[1], silu_f(g1[2]) * u1[2], silu_f(g1[3]) * u1[3]);
                *(u32x2*)(O + (size_t)(row0 + ai * HALF + m * 16) * ldc + col0) = w; }
    }
};
struct EpiNone { static constexpr bool PERM = true;
    __device__ __forceinline__ void operator()(const f32x4 (&acc)[2][2][4][2], const Unit&, int, int, int, int) const {
#pragma unroll
        for (int ai = 0; ai < 2; ++ai)
#pragma unroll
            for (int bj = 0; bj < 2; ++bj)
#pragma unroll
                for (int m = 0; m < 4; ++m)
#pragma unroll
                    for (int n = 0; n < 2; ++n) asm volatile("" :: "v"(acc[ai][bj][m][n])); }
};
struct EpiRes {
    static constexpr bool PERM = false;
    const float* base; float* out; const float* gate; float scale;
    __device__ __forceinline__ void operator()(const f32x4 (&acc)[2][2][4][2], const Unit& u, int wr, int wc, int fr, int fq) const {
        const int col0 = u.po * BM + wc * 32 + 4 * fq;
        f32x4 gv[2][2];
#pragma unroll
        for (int bj = 0; bj < 2; ++bj)
#pragma unroll
            for (int n = 0; n < 2; ++n) gv[bj][n] = *(const f32x4*)(gate + col0 + bj * HALF + n * 16) * scale;
#pragma unroll
        for (int ai = 0; ai < 2; ++ai)
#pragma unroll
            for (int m = 0; m < 4; ++m) { const size_t off = (size_t)(u.pm * BM + ai * HALF + wr * 64 + m * 16 + fr) * 1024 + col0;
#pragma unroll
                for (int bj = 0; bj < 2; ++bj)
#pragma unroll
                    for (int n = 0; n < 2; ++n) { const f32x4 bs = *(const f32x4*)(base + off + bj * HALF + n * 16); *(f32x4*)(out + off + bj * HALF + n * 16) = bs + gv[bj][n] * acc[ai][bj][m][n]; } }
    }
};

template <class Epi, class Sched, bool FP8 = false, bool ALIGN_EPI = true>
__device__ __forceinline__ void gemm_phase(PG8_LAS unsigned char* lds, const Gemm g, const Sched& S, const Epi& E) {
    const int tid = threadIdx.x, wid = __builtin_amdgcn_readfirstlane(tid >> 6), lane = tid & 63, wr = wid >> 2, wc = wid & 3, fr = lane & 15, fq = lane >> 4;
    const int KB = g.KB, nt = KB / (BK * 2), ldaB = g.ldaB;
    unsigned voffA[2], voffB[2];
#pragma unroll
    for (int i = 0; i < 2; ++i) { int R, C; stage_rc(tid * 16 + i * 8192, R, C); const int Rb = Epi::PERM ? ((R & ~31) + perm32(R & 31)) : R;
        voffA[i] = (unsigned)(R * ldaB + C * 2); voffB[i] = (unsigned)(Rb * KB + C * 2); }
    const size_t kstep = (size_t)(BK * 2);
    const size_t hstepA = (size_t)HALF * ldaB, hstepB = (size_t)HALF * KB;
    const size_t tstepA = 2 * hstepA, tstepB = 2 * hstepB;
    const unsigned ldsw = (unsigned)wid * 1024u;
    const int aoff = lds_byte(wr * 64 + fr, fq * 8), boff = lds_byte(wc * 32 + fr, fq * 8);
#define PG8_SA(b, h) (((b) * 2 + (h)) * HTB)
#define PG8_SB(b, h) ((4 + (b) * 2 + (h)) * HTB)
#define PG8_STAGE(bufoff, gbase, voff) do { _Pragma("unroll") for (int _i = 0; _i < 2; ++_i) \
        __builtin_amdgcn_global_load_lds((const unsigned*)((const char*)(gbase) + (voff)[_i]), (PG8_LAS unsigned*)(lds + (bufoff) + ldsw + _i * 8192), 16, 0, 0); } while (0)
#define PG8_RD8(p_) __builtin_shufflevector(*(const PG8_LAS i32x4*)(p_), *(const PG8_LAS i32x4*)((p_) + 1024), 0, 1, 2, 3, 4, 5, 6, 7)
#define PG8_LDA(dst, b, h) do { if constexpr (FP8) { _Pragma("unroll") for (int m = 0; m < 4; ++m) dst##8[m] = PG8_RD8(lds + PG8_SA(b, h) + aoff + m * 2048); } \
        else { _Pragma("unroll") for (int m = 0; m < 4; ++m) _Pragma("unroll") for (int k = 0; k < 2; ++k) dst[m][k] = *(const PG8_LAS bf16x8*)(lds + PG8_SA(b, h) + aoff + m * 2048 + k * 1024); } } while (0)
#define PG8_LDB(dst, b, h) do { if constexpr (FP8) { _Pragma("unroll") for (int n = 0; n < 2; ++n) dst##8[n] = PG8_RD8(lds + PG8_SB(b, h) + boff + n * 2048); } \
        else { _Pragma("unroll") for (int n = 0; n < 2; ++n) _Pragma("unroll") for (int k = 0; k < 2; ++k) dst[n][k] = *(const PG8_LAS bf16x8*)(lds + PG8_SB(b, h) + boff + n * 2048 + k * 1024); } } while (0)
#define PG8_MMA(ai, bj, At, Bt) do { __builtin_amdgcn_s_setprio(1); \
        if constexpr (FP8) { _Pragma("unroll") for (int m = 0; m < 4; ++m) _Pragma("unroll") for (int n = 0; n < 2; ++n) \
            asm volatile("v_mfma_scale_f32_16x16x128_f8f6f4 %0, %1, %2, %0, %3, %3 op_sel_hi:[0,0,0]" : "+v"(acc[ai][bj][m][n]) : "v"(Bt##8[n]), "v"(At##8[m]), "v"(sc7f)); } \
        else { _Pragma("unroll") for (int m = 0; m < 4; ++m) _Pragma("unroll") for (int n = 0; n < 2; ++n) _Pragma("unroll") for (int k = 0; k < 2; ++k) \
            acc[ai][bj][m][n] = __builtin_amdgcn_mfma_f32_16x16x32_bf16(Bt[n][k], At[m][k], acc[ai][bj][m][n], 0, 0, 0); } \
        __builtin_amdgcn_s_setprio(0); } while (0)
#define PG8_WAIT_V(n) asm volatile("s_waitcnt vmcnt(" #n ")" ::: "memory")
#define PG8_WAIT_L(n) asm volatile("s_waitcnt lgkmcnt(" #n ")" ::: "memory")
#define PG8_BAR __builtin_amdgcn_s_barrier()
#define PG8_SCHED __builtin_amdgcn_sched_barrier(0)
    Unit cur, nxt; int ui = 0;
    if (!S.next(0, cur)) return;
    f32x4 acc[2][2][4][2];
#pragma unroll
    for (int a = 0; a < 2; ++a)
#pragma unroll
        for (int b = 0; b < 2; ++b)
#pragma unroll
            for (int m = 0; m < 4; ++m)
#pragma unroll
                for (int n = 0; n < 2; ++n) acc[a][b][m][n] = (f32x4){0.f, 0.f, 0.f, 0.f};
    const int sc7f = 0x7f7f7f7f;
    bf16x8 At[4][2], B0[2][2], B1[2][2]; i32x8 At8[4], B08[2], B18[2];
    const char* cA = (const char*)g.A + (size_t)cur.pm * tstepA; const char* cB = (const char*)g.Bt + (size_t)cur.pn * tstepB;
    PG8_STAGE(PG8_SB(0, 0), cB, voffB); PG8_STAGE(PG8_SB(0, 1), cB + hstepB, voffB); PG8_STAGE(PG8_SA(0, 0), cA, voffA); PG8_STAGE(PG8_SA(0, 1), cA + hstepA, voffA);
    if (wr == 1) PG8_BAR;
    PG8_WAIT_V(2); PG8_BAR;
    PG8_STAGE(PG8_SB(1, 0), cB + kstep, voffB); PG8_STAGE(PG8_SA(1, 0), cA + kstep, voffA); PG8_STAGE(PG8_SB(1, 1), cB + hstepB + kstep, voffB);
    PG8_WAIT_V(6); PG8_BAR;
    for (;;) {
        const bool has_next = S.next(ui + 1, nxt);
        const char* nA = has_next ? (const char*)g.A + (size_t)nxt.pm * tstepA : cA; const char* nB = has_next ? (const char*)g.Bt + (size_t)nxt.pn * tstepB : cB;
#pragma nounroll
        for (int t = 0; t < nt; t += 2) {
            const bool last = (t == nt - 2);
            const char* a1 = cA + (size_t)(t + 1) * kstep;
            const char* a2 = last ? nA : cA + (size_t)(t + 2) * kstep; const char* b2 = last ? nB : cB + (size_t)(t + 2) * kstep;
            const char* a3 = a2 + kstep; const char* b3 = b2 + kstep;
            PG8_LDB(B0, 0, 0); PG8_LDB(B1, 0, 1); PG8_SCHED; PG8_LDA(At, 0, 0); PG8_STAGE(PG8_SA(1, 1), a1 + hstepA, voffA);
            PG8_WAIT_V(8); PG8_WAIT_L(0); PG8_BAR; PG8_MMA(0, 0, At, B0); PG8_MMA(0, 1, At, B1); PG8_BAR; PG8_SCHED;
            PG8_LDA(At, 0, 1); PG8_STAGE(PG8_SB(0, 0), b2, voffB); PG8_STAGE(PG8_SB(0, 1), b2 + hstepB, voffB); PG8_STAGE(PG8_SA(0, 0), a2, voffA);
            PG8_WAIT_V(8); PG8_WAIT_L(0); PG8_BAR; PG8_MMA(1, 0, At, B0); PG8_MMA(1, 1, At, B1); PG8_BAR; PG8_SCHED;
            PG8_LDB(B0, 1, 0); PG8_LDB(B1, 1, 1); PG8_SCHED; PG8_LDA(At, 1, 0); PG8_STAGE(PG8_SA(0, 1), a2 + hstepA, voffA);
            PG8_WAIT_V(8); PG8_WAIT_L(0); PG8_BAR; PG8_MMA(0, 0, At, B0); PG8_MMA(0, 1, At, B1); PG8_BAR; PG8_SCHED;
            PG8_LDA(At, 1, 1); PG8_STAGE(PG8_SB(1, 0), b3, voffB); PG8_STAGE(PG8_SB(1, 1), b3 + hstepB, voffB); PG8_STAGE(PG8_SA(1, 0), a3, voffA);
            PG8_WAIT_V(8); PG8_WAIT_L(0); PG8_BAR; PG8_MMA(1, 0, At, B0); PG8_MMA(1, 1, At, B1); PG8_BAR; PG8_SCHED;
        }
        if constexpr (ALIGN_EPI) { if (wr == 0) PG8_BAR; }
        if constexpr (FP8) asm volatile("s_nop 15\n\ts_nop 15" ::: "memory");
        E(acc, cur, wr, wc, fr, fq);
        if constexpr (FP8 && DBG_EPI2) { asm volatile("" ::: "memory"); E(acc, cur, wr, wc, fr, fq); }
        if (!has_next) break;
#pragma unroll
        for (int a = 0; a < 2; ++a)
#pragma unroll
            for (int b = 0; b < 2; ++b)
#pragma unroll
                for (int m = 0; m < 4; ++m)
#pragma unroll
                    for (int n = 0; n < 2; ++n) acc[a][b][m][n] = (f32x4){0.f, 0.f, 0.f, 0.f};
        cur = nxt; cA = nA; cB = nB; ++ui;
        if constexpr (ALIGN_EPI) { if (wr == 1) PG8_BAR; }
    }
    PG8_WAIT_V(0);
    if constexpr (!ALIGN_EPI) { if (wr == 0) PG8_BAR; }
    PG8_BAR;
#undef PG8_SA
#undef PG8_SB
#undef PG8_STAGE
#undef PG8_LDA
#undef PG8_LDB
#undef PG8_MMA
#undef PG8_RD8
#undef PG8_WAIT_V
#undef PG8_WAIT_L
#undef PG8_BAR
#undef PG8_SCHED
}
}

constexpr int NWAVES = 8, NTHR = 512;
constexpr int S = 16384, D = 1024;
constexpr int E_IN = 1536, D_FF = 2816, O_IN = 2112, O_INP = 2304, NE = 8, DFE = 3584;
constexpr int MOE_ROWS = 34816;
constexpr float EPS = 1e-6f;
constexpr float MOE_WSCALE = 64.f;

constexpr size_t MiB = 1u << 20;
constexpr size_t WS_CTL = 0, CTL_ZERO_BYTES = 1 * MiB;
constexpr size_t WS_MODP = 1 * MiB, WS_MODF = 2 * MiB, WS_ROPE = 3 * MiB;
constexpr size_t WS_TOK = 7 * MiB;
constexpr size_t WS_WIN0 = 8 * MiB, WS_WOUT0 = 11 * MiB, WS_WGU0 = 13 * MiB, WS_WD0 = 24 * MiB, WS_WIN1 = 30 * MiB;
constexpr size_t WS_WUQ = 35 * MiB, WS_WUKV = WS_WUQ + MiB / 2, WS_WOUT1 = 36 * MiB, WS_WTRIL = 38 * MiB, WS_WGT = WS_WTRIL + 131072;
constexpr size_t WS_WGUM = 40 * MiB, WS_WDM = 152 * MiB;
constexpr size_t WS_ABUF = 208 * MiB, WS_MIX = 240 * MiB, WS_XR = 272 * MiB, WS_AMOE = 336 * MiB  , WS_BIG = 404 * MiB;
constexpr size_t WS_P0 = WS_BIG, WS_H = WS_BIG + 48 * MiB;
constexpr size_t WS_P1 = WS_BIG, WS_QR = WS_BIG + 72 * MiB, WS_KVR = WS_BIG + 104 * MiB, WS_QF = WS_BIG + 136 * MiB, WS_KIMG = WS_BIG + 160 * MiB, WS_VIMG = WS_BIG + 184 * MiB;
constexpr size_t WS_PART = WS_BIG + 200 * MiB, WS_PML = WS_BIG + 232 * MiB;
constexpr size_t WS_HM = WS_BIG;
constexpr size_t WS_END = 660 * MiB;
static_assert(WS_H + (size_t)S * D_FF * 2 <= WS_END && WS_VIMG + 16 * MiB <= WS_END && WS_HM + (size_t)MOE_ROWS * DFE * 2 <= WS_END, "big region");
static_assert(WS_AMOE + (size_t)MOE_ROWS * D * 2 <= WS_BIG && WS_WDM + (size_t)NE * D * DFE * 2 <= WS_ABUF && WS_WGUM + (size_t)NE * 2 * DFE * D * 2 <= WS_WDM, "map");
constexpr int CW_BAR = 4096;
constexpr int CW_CNT = 16384;
constexpr int CW_Q = 17408;
constexpr int CW_XRANK = 20480;
constexpr int CW_GD = 17472;

constexpr int RING_BYTES = 131072, LDSCTL_OFF = RING_BYTES, MISC_OFF = LDSCTL_OFF + 320, LDS_BYTES = 147456;

#define GAS __attribute__((address_space(1)))
#define LAS __attribute__((address_space(3)))
typedef unsigned short bf16;
typedef unsigned v4u __attribute__((ext_vector_type(4)));
typedef unsigned v2u __attribute__((ext_vector_type(2)));
typedef float f32x4 __attribute__((ext_vector_type(4)));
typedef float f32x16 __attribute__((ext_vector_type(16)));
typedef short bf16x8 __attribute__((ext_vector_type(8)));
typedef short s16x4 __attribute__((ext_vector_type(4)));
typedef GAS unsigned gu32;
#define RLX_AGENT __ATOMIC_RELAXED, __HIP_MEMORY_SCOPE_AGENT
#define LDS_WAIT() asm volatile("s_waitcnt lgkmcnt(0)" ::: "memory")
#define VM_WAIT() asm volatile("s_waitcnt vmcnt(0)" ::: "memory")
__device__ __forceinline__ unsigned f2bf(float f) { unsigned u = __builtin_bit_cast(unsigned, f); return (u + 0x7fffu + ((u >> 16) & 1u)) >> 16; }
__device__ __forceinline__ unsigned pk2(float lo, float hi) { return f2bf(lo) | (f2bf(hi) << 16); }
__device__ __forceinline__ float bflo(unsigned w) { return __builtin_bit_cast(float, w << 16); }
__device__ __forceinline__ float bfhi(unsigned w) { return __builtin_bit_cast(float, w & 0xffff0000u); }
__device__ __forceinline__ float wave_sum(float v) {
#pragma unroll
    for (int o = 1; o < 64; o <<= 1) v += __shfl_xor(v, o);
    return v;
}

#define XB_TMO      128
#define XB_XCNT(j)  (256  + 64 * (j))
#define XB_XSUB(j)  (1280 + 64 * (j))
#define XB_XGEN(j)  (2304 + 64 * (j))
#define XB_TOP      3328
#define XB_TOPGEN   3392
#define XCD_BAR_WORDS 3456
#define XB_SPIN_CAP (1u << 18)
__device__ __forceinline__ unsigned xb_ld(unsigned* p)              { return __hip_atomic_load(p, __ATOMIC_RELAXED, __HIP_MEMORY_SCOPE_AGENT); }
__device__ __forceinline__ unsigned xb_add(unsigned* p, unsigned v) { return __hip_atomic_fetch_add(p, v, __ATOMIC_RELAXED, __HIP_MEMORY_SCOPE_AGENT); }
__device__ __forceinline__ unsigned xb_xcc_id() { return (unsigned)__builtin_amdgcn_s_getreg((3 << 11) | 20) & 0xFu; }
#define XB_SPIN(cond, bar) do { unsigned _sp = 0; while (cond) { __builtin_amdgcn_s_sleep(1); \
    if ((++_sp & 255u) == 0u) { if (xb_ld(&(bar)[XB_TMO])) break; if (_sp > XB_SPIN_CAP) { atomicAdd(&(bar)[XB_TMO], 1u); break; } } } } while (0)
struct XcdBarrier { unsigned* bar; unsigned x; volatile LAS unsigned* st; };
__device__ __forceinline__ XcdBarrier xcd_barrier_post(unsigned* bar, volatile LAS unsigned* st) {
    XcdBarrier b; b.bar = bar; b.x = xb_xcc_id(); b.st = st;
    if (threadIdx.x == 0) (void)xb_add(&bar[XB_XCNT(b.x)], 1u);
    return b;
}
__device__ __forceinline__ void xcd_barrier_complete(unsigned* bar, unsigned x, unsigned& nloc, unsigned& nx) {
    const unsigned G = gridDim.x * gridDim.y * gridDim.z;
    unsigned sum, cnt, mine, sp = 0u;
    for (;;) {
        sum = 0u; cnt = 0u; mine = 0u;
#pragma unroll
        for (unsigned j = 0; j < 16; ++j) { const unsigned c = xb_ld(&bar[XB_XCNT(j)]); sum += c; cnt += (c > 0u) ? 1u : 0u; mine = (j == x) ? c : mine; }
        if (sum == G) break;
        __builtin_amdgcn_s_sleep(1);
        if ((++sp & 255u) == 0u) { if (xb_ld(&bar[XB_TMO])) break; if (sp > XB_SPIN_CAP) { atomicAdd(&bar[XB_TMO], 1u); break; } }
    }
    nloc = mine > 0u ? mine : 1u; nx = cnt > 0u ? cnt : 1u;
}
__device__ __forceinline__ void xcd_barrier(const XcdBarrier& b) {
    asm volatile("s_waitcnt vmcnt(0)" ::: "memory");
    __syncthreads();
    if (threadIdx.x == 0) {
        unsigned* bar = b.bar;
        __builtin_amdgcn_s_waitcnt(0);
        unsigned nloc = b.st[0], nx = b.st[1];
        if (nloc == 0u) { xcd_barrier_complete(bar, b.x, nloc, nx); b.st[0] = nloc; b.st[1] = nx; }
        const unsigned old = xb_add(&bar[XB_XSUB(b.x)], 1u);
        const unsigned gen = old / nloc;
        if (old + 1u == (gen + 1u) * nloc) {
            __builtin_amdgcn_fence(__ATOMIC_RELEASE, "agent");
            asm volatile("s_waitcnt vmcnt(0)" ::: "memory");
            const unsigned og = xb_add(&bar[XB_TOP], 1u);
            const unsigned tg = og / nx;
            if (og + 1u == (tg + 1u) * nx) xb_add(&bar[XB_TOPGEN], 1u);
            else XB_SPIN(xb_ld(&bar[XB_TOPGEN]) == tg, bar);
            __builtin_amdgcn_fence(__ATOMIC_ACQUIRE, "agent");
            xb_add(&bar[XB_XGEN(b.x)], 1u);
            asm volatile("s_waitcnt vmcnt(0)" ::: "memory");
        } else {
            XB_SPIN(xb_ld(&bar[XB_XGEN(b.x)]) == gen, bar);
            __builtin_amdgcn_fence(__ATOMIC_ACQUIRE, "agent");
            asm volatile("s_waitcnt vmcnt(0)" ::: "memory");
        }
    }
    __syncthreads();
}

struct Args { const void* in[29]; float* out; unsigned char* ws; int ph_lo, ph_hi; };
enum { I_X = 0, I_C, I_POS, I_NMW, I_NFW, I_ADAW, I_ADAB, I_EWIN, I_ALNW, I_ALNB, I_AWS, I_ABS, I_BWG, I_BSC, I_EWOUT, I_FGU, I_FDN,
       I_OWIN, I_CONV, I_QAN, I_WUQ, I_KVN, I_WUKV, I_QNW, I_KNW, I_OWOUT, I_RW, I_MGU, I_MDN };
constexpr int OFF_SHM = 0, OFF_SCM = 1024, OFF_GM = 2048, OFF_SHF = 3072, OFF_SCF = 4096, OFF_GF = 5120;

__device__ __forceinline__ void p0_mod(const float* c, const float* ada_w, float* modp, int vcu, int G, int tid) {
    for (int u = vcu; u < 384; u += G) {
        const int layer = u / 192, r = u % 192, ks = r / 12, cb = r % 12, col = cb * 512 + tid;
        const float* w = ada_w + ((size_t)layer * 1024 + ks * 64) * 6144 + col;
        float acc = 0.f;
#pragma unroll 8
        for (int k = 0; k < 64; ++k) { const float cv = c[ks * 64 + k]; const float sv = cv / (1.f + __expf(-cv)); acc += sv * w[(size_t)k * 6144]; }
        modp[(size_t)(layer * 16 + ks) * 6144 + col] = acc;
    }
}
__device__ __forceinline__ void conv_item(const float* src, int ldn, int k0, int n0, const float* kscale, bf16* dst, int ldk, int drow0, LAS float* scr, int lane) {
#pragma unroll
    for (int i = 0; i < 8; ++i) { const int kk = 8 * i + (lane >> 3); f32x4 v = *(const f32x4*)(src + (size_t)(k0 + kk) * ldn + n0 + (lane & 7) * 4);
        if (kscale) v = v * kscale[k0 + kk];
        LAS float* p = scr + kk * 33 + (lane & 7) * 4; p[0] = v.x; p[1] = v.y; p[2] = v.z; p[3] = v.w; }
    LDS_WAIT(); asm volatile("" ::: "memory");
    const int c = lane & 7;
#pragma unroll
    for (int j = 0; j < 4; ++j) { const int nn = (lane >> 3) + 8 * j; const LAS float* s = scr + (8 * c) * 33 + nn;
        v4u o; o.x = pk2(s[0 * 33], s[1 * 33]); o.y = pk2(s[2 * 33], s[3 * 33]); o.z = pk2(s[4 * 33], s[5 * 33]); o.w = pk2(s[6 * 33], s[7 * 33]);
        *(v4u*)(dst + (size_t)(drow0 + nn) * ldk + k0 + 8 * c) = o; }
    LDS_WAIT(); asm volatile("" ::: "memory");
}
__device__ __forceinline__ void conv_item8(const float* src, int ldn, int k0, int n0, float scale, unsigned char* dst, int ldkB, int drow0, LAS float* scr, int lane) {
#pragma unroll
    for (int i = 0; i < 8; ++i) { const int kk = 8 * i + (lane >> 3); const f32x4 v = *(const f32x4*)(src + (size_t)(k0 + kk) * ldn + n0 + (lane & 7) * 4) * scale;
        LAS float* p = scr + kk * 33 + (lane & 7) * 4; p[0] = v.x; p[1] = v.y; p[2] = v.z; p[3] = v.w; }
    LDS_WAIT(); asm volatile("" ::: "memory");
    const int c = lane & 7;
#pragma unroll
    for (int j = 0; j < 4; ++j) { const int nn = (lane >> 3) + 8 * j; const LAS float* s = scr + (8 * c) * 33 + nn;
        v2u o; o.x = pg8::pk4_fp8(s[0 * 33], s[1 * 33], s[2 * 33], s[3 * 33]); o.y = pg8::pk4_fp8(s[4 * 33], s[5 * 33], s[6 * 33], s[7 * 33]);
        *(v2u*)(dst + (size_t)(drow0 + nn) * ldkB + k0 + 8 * c) = o; }
    LDS_WAIT(); asm volatile("" ::: "memory");
}
__device__ __forceinline__ int gu_row(int n0, int half) { return n0 < half ? (n0 >> 7) * 256 + (n0 & 127) : ((n0 - half) >> 7) * 256 + 128 + ((n0 - half) & 127); }
constexpr int LATE_GU = 8 * 16 * 224, LATE_DN = 8 * 56 * 32, N_LATE = LATE_GU + LATE_DN, LATE_CHUNK = 16;
__device__ __forceinline__ void conv_late_item(const Args& a, int r, LAS float* scr, int lane) {
    unsigned char* ws = a.ws;
    if (r < LATE_GU) { const int e = r / (16 * 224), q = r % (16 * 224), kb = q / 224, nb = q % 224;
        conv_item8((const float*)a.in[I_MGU] + (size_t)e * 1024 * 7168, 7168, kb * 64, nb * 32, MOE_WSCALE, ws + WS_WGUM + (size_t)e * 7168 * 1024, 1024, gu_row(nb * 32, DFE), scr, lane); }
    else { r -= LATE_GU; const int e = r / (56 * 32), q = r % (56 * 32), kb = q / 32, nb = q % 32;
        conv_item8((const float*)a.in[I_MDN] + (size_t)e * DFE * 1024, 1024, kb * 64, nb * 32, MOE_WSCALE, ws + WS_WDM + (size_t)e * 1024 * DFE, DFE, nb * 32, scr, lane); }
}
__device__ __forceinline__ void conv_fill(const Args& a, LAS unsigned char* lds, unsigned* gdone, int G, int tid) {
    unsigned* qhead = (unsigned*)(a.ws + WS_CTL) + CW_Q; const int lane = tid & 63, wave = __builtin_amdgcn_readfirstlane(tid >> 6);
    LAS float* scr = (LAS float*)(lds + wave * 16384); volatile LAS int* qb = (volatile LAS int*)(lds + 131056);
    __syncthreads();
    if (gdone && tid == 0) (void)__hip_atomic_fetch_add(gdone, 1u, RLX_AGENT);
    for (;;) {
        if (tid == 0) { int v = -1;
            if (!gdone || __hip_atomic_load(gdone, RLX_AGENT) < (unsigned)G) { v = (int)__hip_atomic_fetch_add(qhead, (unsigned)LATE_CHUNK, RLX_AGENT); if (v >= N_LATE) v = -1; }
            *qb = v; }
        __syncthreads();
        const int base = *qb;
        __syncthreads();
        if (base < 0) break;
        for (int it = base + wave; it < base + LATE_CHUNK && it < N_LATE; it += NWAVES) conv_late_item(a, it, scr, lane);
    }
}
__device__ __forceinline__ void p0_prologue(const Args& a, LAS unsigned char* lds, int vcu, int G, int tid) {
    unsigned char* ws = a.ws; const int lane = tid & 63, wave = __builtin_amdgcn_readfirstlane(tid >> 6);
    p0_mod((const float*)a.in[I_C], (const float*)a.in[I_ADAW], (float*)(ws + WS_MODP), vcu, G, tid);
    const int gt = vcu * NTHR + tid, NGT = G * NTHR;
    { const int* pos = (const int*)a.in[I_POS]; float* cosT = (float*)(ws + WS_ROPE); float* sinT = cosT + (size_t)S * 32;
      for (int i = gt; i < S * 32; i += NGT) { const int t = i >> 5, f = i & 31; const float inv = (float)exp(-(double)f * (9.210340371976184 / 32.0));
          const float ang = (float)pos[t] * inv; const double ad = (double)ang;
          const double k = __builtin_rint(ad * 0.15915494309189535); const double r = __builtin_fma(-k, 6.283185307179586, ad) - k * 2.4492935982947064e-16;
          cosT[i] = cosf((float)r); sinT[i] = sinf((float)r); } }
    { const float* aws = (const float*)a.in[I_AWS]; bf16* wt = (bf16*)(ws + WS_WTRIL);
      for (int i = gt; i < 4 * 128 * 128 / 2; i += NGT) { const int e = 2 * i, s = e & 127, t = (e >> 7) & 127; const float v0 = s <= t ? aws[e] : 0.f, v1 = (s + 1) <= t ? aws[e + 1] : 0.f; ((unsigned*)wt)[i] = pk2(v0, v1); } }
    { v4u z = {0u, 0u, 0u, 0u}; v4u* p1 = (v4u*)(ws + WS_WIN1 + (size_t)O_IN * 1024 * 2);
      for (int i = gt; i < (O_INP - O_IN) * 1024 * 2 / 16; i += NGT) p1[i] = z;
      for (int i = gt; i < 4 * 64 * 256 * 2 / 16; i += NGT) { const int h = i / (64 * 32), r = i % (64 * 32); ((v4u*)(ws + WS_WUQ + (size_t)(h * 256 + 192) * 256 * 2))[r] = z; } }
    LAS float* scr = (LAS float*)(lds + wave * 16384);
    const int gw = vcu * NWAVES + wave, NGW = G * NWAVES;
    constexpr int I0 = 16 * 48, I1 = 16 * 32, I2 = 16 * 176, I3 = 44 * 32, I4 = 16 * 66, I5 = 4 * 24, I6 = 4 * 32, I7 = 16 * 32, I8 = 4 * 8;
    constexpr int NITEMS = I0 + I1 + I2 + I3 + I4 + I5 + I6 + I7 + I8;
    for (int it = gw; it < NITEMS; it += NGW) {
        int r = it;
        if (r < I0) { conv_item((const float*)a.in[I_EWIN], E_IN, (r / 48) * 64, (r % 48) * 32, nullptr, (bf16*)(ws + WS_WIN0), 1024, (r % 48) * 32, scr, lane); continue; } r -= I0;
        if (r < I1) { conv_item((const float*)a.in[I_EWOUT], 1024, (r / 32) * 64, (r % 32) * 32, nullptr, (bf16*)(ws + WS_WOUT0), 1024, (r % 32) * 32, scr, lane); continue; } r -= I1;
#if FFN_FP8
        if (r < I2) { conv_item8((const float*)a.in[I_FGU], 2 * D_FF, (r / 176) * 64, (r % 176) * 32, MOE_WSCALE, ws + WS_WGU0, 1024, gu_row((r % 176) * 32, D_FF), scr, lane); continue; } r -= I2;
        if (r < I3) { conv_item8((const float*)a.in[I_FDN], 1024, (r / 32) * 64, (r % 32) * 32, MOE_WSCALE, ws + WS_WD0, D_FF, (r % 32) * 32, scr, lane); continue; } r -= I3;
#else
        if (r < I2) { conv_item((const float*)a.in[I_FGU], 2 * D_FF, (r / 176) * 64, (r % 176) * 32, nullptr, (bf16*)(ws + WS_WGU0), 1024, gu_row((r % 176) * 32, D_FF), scr, lane); continue; } r -= I2;
        if (r < I3) { conv_item((const float*)a.in[I_FDN], 1024, (r / 32) * 64, (r % 32) * 32, nullptr, (bf16*)(ws + WS_WD0), D_FF, (r % 32) * 32, scr, lane); continue; } r -= I3;
#endif
        if (r < I4) { conv_item((const float*)a.in[I_OWIN], O_IN, (r / 66) * 64, (r % 66) * 32, nullptr, (bf16*)(ws + WS_WIN1), 1024, (r % 66) * 32, scr, lane); continue; } r -= I4;
        if (r < I5) { const int n0 = (r % 24) * 32; conv_item((const float*)a.in[I_WUQ], 768, (r / 24) * 64, n0, (const float*)a.in[I_QAN], (bf16*)(ws + WS_WUQ), 256, (n0 / 192) * 256 + n0 % 192, scr, lane); continue; } r -= I5;
        if (r < I6) { conv_item((const float*)a.in[I_WUKV], 1024, (r / 32) * 64, (r % 32) * 32, (const float*)a.in[I_KVN], (bf16*)(ws + WS_WUKV), 256, (r % 32) * 32, scr, lane); continue; } r -= I6;
        if (r < I7) { conv_item((const float*)a.in[I_OWOUT], 1024, (r / 32) * 64, (r % 32) * 32, nullptr, (bf16*)(ws + WS_WOUT1), 1024, (r % 32) * 32, scr, lane); continue; } r -= I7;
        { const int g = r / 8, q = r % 8; conv_item((const float*)a.in[I_BWG] + (size_t)g * 16384, 128, (q / 4) * 64, (q % 4) * 32, nullptr, (bf16*)(ws + WS_WGT) + (size_t)g * 16384, 128, (q % 4) * 32, scr, lane); }
    }
}

__device__ __forceinline__ float modv_partial(const float* modp, const float* ada_b, int layer, int idx) {
    float s = ada_b[layer * 6144 + idx];
#pragma unroll
    for (int ks = 0; ks < 16; ++ks) s += modp[(size_t)(layer * 16 + ks) * 6144 + idx];
    return s;
}
template <bool PARTIAL, bool OUT8 = false>
__device__ __forceinline__ void norm_phase(const Args& a, const float* xin, bf16* out, const float* nw, int layer, int off_sh, int off_sc, int gw, int NGW, int lane, LAS float* lmod = nullptr) {
    const float* modp = (const float*)(a.ws + WS_MODP); const float* modF = (const float*)(a.ws + WS_MODF); const float* ada_b = (const float*)a.in[I_ADAB];
    if (PARTIAL) {
        for (int i = threadIdx.x; i < 2048; i += NTHR) lmod[i] = modv_partial(modp, ada_b, layer, (i < 1024 ? off_sc : off_sh - 1024) + i);
        __syncthreads();
    }
    f32x4 g[4], sh[4];
#pragma unroll
    for (int j = 0; j < 4; ++j)
#pragma unroll
        for (int e = 0; e < 4; ++e) { const int col = 4 * lane + e + 256 * j; float scv, shv;
            if (PARTIAL) { scv = lmod[col]; shv = lmod[1024 + col]; }
            else { scv = modF[layer * 6144 + off_sc + col]; shv = modF[layer * 6144 + off_sh + col]; }
            g[j][e] = nw[col] * (1.f + scv); sh[j][e] = shv; }
    for (int m = gw; m < S; m += NGW) {
        const f32x4* xr = (const f32x4*)(xin + (size_t)m * D) + lane;
        f32x4 v[4]; float s = 0.f;
#pragma unroll
        for (int j = 0; j < 4; ++j) { v[j] = xr[64 * j]; s += (v[j].x * v[j].x + v[j].y * v[j].y) + (v[j].z * v[j].z + v[j].w * v[j].w); }
        const float rstd = 1.f / sqrtf(wave_sum(s) * (1.f / D) + EPS);
        if constexpr (OUT8) { unsigned* o4 = (unsigned*)((unsigned char*)out + (size_t)m * D) + lane;
#pragma unroll
            for (int j = 0; j < 4; ++j) { const f32x4 y = v[j] * rstd * g[j] + sh[j]; o4[64 * j] = pg8::pk4_fp8(y.x, y.y, y.z, y.w); } }
        else { unsigned long long* o8 = (unsigned long long*)(out + (size_t)m * D) + lane;
#pragma unroll
            for (int j = 0; j < 4; ++j) { const f32x4 y = v[j] * rstd * g[j] + sh[j]; o8[64 * j] = (unsigned long long)pk2(y.x, y.y) | ((unsigned long long)pk2(y.z, y.w) << 32); } }
    }
}

__device__ __forceinline__ void mixab_phase(const Args& a, LAS unsigned char* lds, int vcu, int G, int tid) {
    const bf16* P0 = (const bf16*)(a.ws + WS_P0); bf16* MIX = (bf16*)(a.ws + WS_MIX);
    const bf16* Wtril = (const bf16*)(a.ws + WS_WTRIL); const bf16* wgT = (const bf16*)(a.ws + WS_WGT);
    const float* ln_w = (const float*)a.in[I_ALNW]; const float* ln_b = (const float*)a.in[I_ALNB]; const float* b_s = (const float*)a.in[I_ABS]; const float* b_sc = (const float*)a.in[I_BSC];
    const int lane = tid & 63, wave = __builtin_amdgcn_readfirstlane(tid >> 6), fr = lane & 15, fq = lane >> 4;
    LAS bf16* vnT = (LAS bf16*)lds;
    LAS bf16* poolS = (LAS bf16*)(lds + 34816);
    LAS bf16* ppS = (LAS bf16*)(lds + 69632);
    LAS float* stat = (LAS float*)(lds + 69632 + 39168);
    for (int u = vcu; u < 512; u += G) {
        const int n = u >> 2, g = u & 3, t0 = n * 128;
        for (int rr = 0; rr < 16; ++rr) { const int row = wave * 16 + rr;
            const v4u raw = *(const v4u*)(P0 + (size_t)(t0 + row) * E_IN + 512 + lane * 8);
            float x[8] = {bflo(raw.x), bfhi(raw.x), bflo(raw.y), bfhi(raw.y), bflo(raw.z), bfhi(raw.z), bflo(raw.w), bfhi(raw.w)};
            float s = 0.f;
#pragma unroll
            for (int j = 0; j < 8; ++j) s += x[j];
            const float mu = wave_sum(s) * (1.f / 512.f); float q = 0.f;
#pragma unroll
            for (int j = 0; j < 8; ++j) { const float d = x[j] - mu; q += d * d; }
            const float rstd = 1.f / sqrtf(wave_sum(q) * (1.f / 512.f) + EPS);
            if (lane == 0) { stat[row * 2] = mu; stat[row * 2 + 1] = rstd; } }
        for (int i = tid; i < 144 * 16; i += NTHR) { const int r = i >> 4, c8 = i & 15, t = t0 - 16 + r; v4u v = {0u, 0u, 0u, 0u};
            if (t >= 0) v = *(const v4u*)(P0 + (size_t)t * E_IN + 1024 + g * 128 + c8 * 8);
            *(LAS v4u*)(ppS + r * 136 + c8 * 8) = v; }
        __syncthreads();
        { const int s = tid & 127, dq = tid >> 7; const float mu = stat[s * 2], rstd = stat[s * 2 + 1];
#pragma unroll
          for (int cc = 0; cc < 4; ++cc) { const int d0 = dq * 32 + cc * 8; const v4u raw = *(const v4u*)(P0 + (size_t)(t0 + s) * E_IN + 512 + g * 128 + d0);
              float x[8] = {bflo(raw.x), bfhi(raw.x), bflo(raw.y), bfhi(raw.y), bflo(raw.z), bfhi(raw.z), bflo(raw.w), bfhi(raw.w)};
#pragma unroll
              for (int j = 0; j < 8; ++j) { const int ch = g * 128 + d0 + j; vnT[(d0 + j) * 136 + s] = (bf16)f2bf((x[j] - mu) * rstd * ln_w[ch] + ln_b[ch]); } } }
        { const int t = tid & 127, q4 = tid >> 7, w = 2 << g, tg = t0 + t; const float inv = 1.f / (float)((tg + 1) < w ? (tg + 1) : w);
#pragma unroll
          for (int cc = 0; cc < 4; ++cc) { const int ch = q4 * 32 + cc * 8; float acc[8] = {0.f, 0.f, 0.f, 0.f, 0.f, 0.f, 0.f, 0.f};
              for (int j = 0; j < w; ++j) { const v4u r = *(const LAS v4u*)(ppS + (16 + t - j) * 136 + ch);
                  acc[0] += bflo(r.x); acc[1] += bfhi(r.x); acc[2] += bflo(r.y); acc[3] += bfhi(r.y); acc[4] += bflo(r.z); acc[5] += bfhi(r.z); acc[6] += bflo(r.w); acc[7] += bfhi(r.w); }
              const v4u c0 = *(const LAS v4u*)(ppS + (16 + t) * 136 + ch);
              v4u o; o.x = pk2(acc[0] * inv - bflo(c0.x), acc[1] * inv - bfhi(c0.x)); o.y = pk2(acc[2] * inv - bflo(c0.y), acc[3] * inv - bfhi(c0.y));
              o.z = pk2(acc[4] * inv - bflo(c0.z), acc[5] * inv - bfhi(c0.z)); o.w = pk2(acc[6] * inv - bflo(c0.w), acc[7] * inv - bfhi(c0.w));
              *(LAS v4u*)(poolS + t * 136 + ch) = o; } }
        __syncthreads();
        const int m0 = wave * 16, trow = t0 + m0 + fr;
        f32x4 acc[8];
#pragma unroll
        for (int nb = 0; nb < 8; ++nb) acc[nb] = (f32x4){0.f, 0.f, 0.f, 0.f};
#pragma unroll
        for (int kk = 0; kk < 4; ++kk) { const bf16x8 af = *(const bf16x8*)(Wtril + ((size_t)g * 128 + m0 + fr) * 128 + kk * 32 + fq * 8);
#pragma unroll
            for (int nb = 0; nb < 8; ++nb) { const bf16x8 bfr = *(const LAS bf16x8*)(vnT + (nb * 16 + fr) * 136 + kk * 32 + fq * 8); acc[nb] = __builtin_amdgcn_mfma_f32_16x16x32_bf16(bfr, af, acc[nb], 0, 0, 0); } }
        { const float bias = b_s[g * 128 + m0 + fr];
#pragma unroll
          for (int nb = 0; nb < 8; ++nb) { const int col = g * 128 + nb * 16 + 4 * fq; const v2u uv = *(const v2u*)(P0 + (size_t)trow * E_IN + col);
              v2u o; o.x = pk2(bflo(uv.x) * (acc[nb][0] + bias), bfhi(uv.x) * (acc[nb][1] + bias)); o.y = pk2(bflo(uv.y) * (acc[nb][2] + bias), bfhi(uv.y) * (acc[nb][3] + bias));
              *(v2u*)(MIX + (size_t)trow * D + col) = o; } }
#pragma unroll
        for (int nb = 0; nb < 8; ++nb) acc[nb] = (f32x4){0.f, 0.f, 0.f, 0.f};
#pragma unroll
        for (int kk = 0; kk < 4; ++kk) { const bf16x8 af = *(const LAS bf16x8*)(poolS + (m0 + fr) * 136 + kk * 32 + fq * 8);
#pragma unroll
            for (int nb = 0; nb < 8; ++nb) { const bf16x8 bfr = *(const bf16x8*)(wgT + ((size_t)g * 128 + nb * 16 + fr) * 128 + kk * 32 + fq * 8); acc[nb] = __builtin_amdgcn_mfma_f32_16x16x32_bf16(bfr, af, acc[nb], 0, 0, 0); } }
#pragma unroll
        for (int nb = 0; nb < 8; ++nb) { const int e = g * 128 + nb * 16 + 4 * fq; const f32x4 sc = *(const f32x4*)(b_sc + e);
            v2u o; o.x = pk2(acc[nb][0] * sc.x, acc[nb][1] * sc.y); o.y = pk2(acc[nb][2] * sc.z, acc[nb][3] * sc.w);
            *(v2u*)(MIX + (size_t)trow * D + 512 + e) = o; }
        __syncthreads();
    }
}

namespace att {
constexpr int KSLOT = 24576, VSLOT = 16384, NSLOT = 3, LDS_K = 0, LDS_V = NSLOT * KSLOT, LDS_WS = LDS_V + NSLOT * VSLOT;
constexpr float SCALE = 0.07216878364870323f;
constexpr float THR = 8.f;
__device__ __forceinline__ int k_nope_off(int row, int colB) { return row * 256 + (colB ^ ((row & 7) << 4)); }
__device__ __forceinline__ int k_rope_off(int row, int cB) { return 16384 + row * 128 + (cB ^ (((row >> 1) & 7) << 4)); }
__device__ __forceinline__ int v_st(int k, int c) { const int kk = (k & ~0xC) | ((k & 4) << 1) | ((k & 8) >> 1); return ((kk >> 3) * 4 + (c >> 5)) * 512 + ((kk & 7) * 32 + (c & 31)) * 2; }
__device__ __forceinline__ int v_rd_base(int lane) { return ((lane & 3) << 3) | (((lane >> 2) & 3) << 6) | (((lane >> 4) & 1) << 5) | (((lane >> 5) & 1) << 8); }
constexpr int v_rd_off(int d0, int ks, int half) { return d0 * 512 + ks * 4096 + half * 2048; }
__device__ __forceinline__ int crow(int r, int hi) { return (r & 3) + 8 * (r >> 2) + 4 * hi; }
__device__ __forceinline__ unsigned cvtpk(float lo, float hi) { unsigned r; asm volatile("v_cvt_pk_bf16_f32 %0, %1, %2" : "=v"(r) : "v"(lo), "v"(hi)); return r; }
#define SBAR() __builtin_amdgcn_sched_barrier(0)
__device__ __forceinline__ void mask_tile(f32x16& p0, f32x16& p1, int dq) {
    const float NEG = -__builtin_inff();
#pragma unroll
    for (int r = 0; r < 16; ++r) { const int c = (r & 3) + 8 * (r >> 2); if (dq - c < 0) p0[r] = NEG; if (dq - c - 32 < 0) p1[r] = NEG; }
}
__device__ __forceinline__ void partialSM(f32x16& p0, f32x16& p1, float& m_reg, float& mn, float& alpha) {
    float pmax = p0[0];
#pragma unroll
    for (int r = 1; r < 16; ++r) pmax = fmaxf(pmax, p0[r]);
#pragma unroll
    for (int r = 0; r < 16; ++r) pmax = fmaxf(pmax, p1[r]);
    { auto rr = __builtin_amdgcn_permlane32_swap(__float_as_uint(pmax), __float_as_uint(pmax), false, false); pmax = fmaxf(__uint_as_float(rr[0]), __uint_as_float(rr[1])); }
    constexpr float C2 = 1.4426950408889634f * SCALE;
    if (__builtin_expect(__all((pmax - m_reg) * SCALE <= THR), 1)) { mn = m_reg; alpha = 1.f; }
    else { mn = fmaxf(m_reg, pmax); alpha = __builtin_amdgcn_exp2f((m_reg - mn) * C2); m_reg = mn; }
    const float mnL = -mn * C2;
#pragma unroll
    for (int r = 0; r < 16; ++r) p0[r] = fmaf(p0[r], C2, mnL);
#pragma unroll
    for (int r = 0; r < 16; ++r) p1[r] = fmaf(p1[r], C2, mnL);
#pragma unroll
    for (int r = 0; r < 16; ++r) p0[r] = __builtin_amdgcn_exp2f(p0[r]);
}
__device__ __forceinline__ void finishSM(f32x16& p0, f32x16& p1, float alpha, float& l_reg, bf16x8& pa0, bf16x8& pa1, bf16x8& pa2, bf16x8& pa3) {
#pragma unroll
    for (int r = 0; r < 16; ++r) p1[r] = __builtin_amdgcn_exp2f(p1[r]);
    float ps = 0;
#pragma unroll
    for (int r = 0; r < 16; ++r) ps += p0[r];
#pragma unroll
    for (int r = 0; r < 16; ++r) ps += p1[r];
    { auto rr = __builtin_amdgcn_permlane32_swap(__float_as_uint(ps), __float_as_uint(ps), false, false); ps = __uint_as_float(rr[0]) + __uint_as_float(rr[1]); }
    l_reg = l_reg * alpha + ps;
#define PK4(P, B_, OUT) do { unsigned a0 = cvtpk(P[B_+0], P[B_+1]), a1 = cvtpk(P[B_+2], P[B_+3]);                          \
        unsigned b0 = cvtpk(P[B_+4], P[B_+5]), b1 = cvtpk(P[B_+6], P[B_+7]);                                             \
        auto r0 = __builtin_amdgcn_permlane32_swap(a0, b0, false, false); auto r1 = __builtin_amdgcn_permlane32_swap(a1, b1, false, false); \
        v4u w = {r0[0], r1[0], r0[1], r1[1]}; OUT = __builtin_bit_cast(bf16x8, w); } while (0)
    PK4(p0, 0, pa0); PK4(p0, 8, pa1); PK4(p1, 0, pa2); PK4(p1, 8, pa3);
#undef PK4
}
__device__ __forceinline__ void qkt(f32x16& p0, f32x16& p1, const LAS char* Kl, int r32, int hi, const bf16x8* qr) {
    p0 = f32x16{}; p1 = f32x16{};
    const LAS char* kb[4];
#pragma unroll
    for (int dd = 0; dd < 4; ++dd) kb[dd] = Kl + k_nope_off(r32, (dd * 16 + hi * 8) * 2);
#pragma unroll
    for (int d0 = 0; d0 < 8; ++d0) { const LAS char* ap = kb[d0 & 3] + (d0 >> 2) * 128;
        const bf16x8 b0 = *(const LAS bf16x8*)ap; const bf16x8 b1 = *(const LAS bf16x8*)(ap + 32 * 256);
        p0 = __builtin_amdgcn_mfma_f32_32x32x16_bf16(b0, qr[d0], p0, 0, 0, 0);
        p1 = __builtin_amdgcn_mfma_f32_32x32x16_bf16(b1, qr[d0], p1, 0, 0, 0); }
#pragma unroll
    for (int dr = 0; dr < 4; ++dr) { const LAS char* ap = Kl + k_rope_off(r32, dr * 32 + hi * 16);
        const bf16x8 b0 = *(const LAS bf16x8*)ap; const bf16x8 b1 = *(const LAS bf16x8*)(ap + 32 * 128);
        p0 = __builtin_amdgcn_mfma_f32_32x32x16_bf16(b0, qr[8 + dr], p0, 0, 0, 0);
        p1 = __builtin_amdgcn_mfma_f32_32x32x16_bf16(b1, qr[8 + dr], p1, 0, 0, 0); }
}
__device__ __forceinline__ void pv_tile(f32x16* o, int vb0, bf16x8 pa0, bf16x8 pa1, bf16x8 pa2, bf16x8 pa3) {
#define TRRD(dst, off) asm volatile("ds_read_b64_tr_b16 %0, %1 offset:%2" : "=&v"(dst) : "v"(vb0), "i"(off) : "memory")
#define PV_LD(S_, d0, hf) do { constexpr int b_ = v_rd_off(d0, 2 * (hf), 0); TRRD(S_##l0, b_); TRRD(S_##h0, b_ + 2048); TRRD(S_##l1, b_ + 4096); TRRD(S_##h1, b_ + 6144); } while (0)
#define PV_MM(S_, d0, PA, PB) do { \
        o[d0] = __builtin_amdgcn_mfma_f32_32x32x16_bf16(PA, (bf16x8){S_##l0[0], S_##l0[1], S_##l0[2], S_##l0[3], S_##h0[0], S_##h0[1], S_##h0[2], S_##h0[3]}, o[d0], 0, 0, 0);   \
        o[d0] = __builtin_amdgcn_mfma_f32_32x32x16_bf16(PB, (bf16x8){S_##l1[0], S_##l1[1], S_##l1[2], S_##l1[3], S_##h1[0], S_##h1[1], S_##h1[2], S_##h1[3]}, o[d0], 0, 0, 0); } while (0)
#define PV_W4() do { asm volatile("s_waitcnt lgkmcnt(4)" ::: "memory"); SBAR(); } while (0)
    s16x4 Al0, Al1, Ah0, Ah1, Bl0, Bl1, Bh0, Bh1;
    PV_LD(A, 0, 0); PV_LD(B, 0, 1);
    PV_W4(); PV_MM(A, 0, pa0, pa1); SBAR(); PV_LD(A, 1, 0);
    PV_W4(); PV_MM(B, 0, pa2, pa3); SBAR(); PV_LD(B, 1, 1);
    PV_W4(); PV_MM(A, 1, pa0, pa1); SBAR(); PV_LD(A, 2, 0);
    PV_W4(); PV_MM(B, 1, pa2, pa3); SBAR(); PV_LD(B, 2, 1);
    PV_W4(); PV_MM(A, 2, pa0, pa1); SBAR(); PV_LD(A, 3, 0);
    PV_W4(); PV_MM(B, 2, pa2, pa3); SBAR(); PV_LD(B, 3, 1);
    PV_W4(); PV_MM(A, 3, pa0, pa1); SBAR();
    asm volatile("s_waitcnt lgkmcnt(0)" ::: "memory"); SBAR(); PV_MM(B, 3, pa2, pa3);
#undef PV_LD
#undef PV_MM
#undef PV_W4
#undef TRRD
}
__device__ __forceinline__ void glds16(const void* gsrc, unsigned lds_dst) { unsigned keep;
    asm volatile("s_mov_b32 %0, m0\n\ts_mov_b32 m0, %2\n\ts_nop 0\n\tglobal_load_lds_dwordx4 %1, off\n\ts_mov_b32 m0, %0" : "=&s"(keep) : "v"(gsrc), "s"(lds_dst) : "memory"); }
#define WAITBAR0() asm volatile("s_waitcnt vmcnt(0) lgkmcnt(0)\n\ts_barrier" ::: "memory")

__device__ __forceinline__ void attn_block(int h, int qb, int j_lo, int j_hi, int part, const bf16* QF, const unsigned char* KIMG, const unsigned char* VIMG, bf16* MIX, float* PART, float* PML, char* lds) {
    const int tid = threadIdx.x, wid = __builtin_amdgcn_readfirstlane(tid >> 6), lane = tid & 63, r32 = lane & 31, hi = lane >> 5;
    const int NT = j_hi - j_lo, q0 = qb * 256, qlo = q0 + wid * 32, qm = qlo + r32 - 4 * hi;
    const unsigned lds0 = (unsigned)(uintptr_t)lds;
    const LAS char* Kl = (const LAS char*)lds + LDS_K;
    LAS float* wsf = (LAS float*)((LAS char*)lds + LDS_WS) + wid * 64; LAS float* li_l = wsf; LAS float* al_l = wsf + 32;
    const int vb0 = (int)(lds0 + LDS_V) + v_rd_base(lane);
    const unsigned char* kimg = KIMG + ((size_t)h * 256 + j_lo) * KSLOT + (size_t)(3 * wid) * 1024 + lane * 16;
    const unsigned char* vimg = VIMG + ((size_t)h * 256 + j_lo) * VSLOT + (size_t)(2 * wid) * 1024 + lane * 16;
    const unsigned kdst = lds0 + LDS_K + (3 * wid) * 1024, vdst = lds0 + LDS_V + (2 * wid) * 1024;
#define DMA_K(t, soff) do { const unsigned char* s_ = kimg + (size_t)(t) * KSLOT; const unsigned d_ = (unsigned)__builtin_amdgcn_readfirstlane(kdst + (soff)); \
        glds16(s_, d_); glds16(s_ + 1024, d_ + 1024); glds16(s_ + 2048, d_ + 2048); } while (0)
#define DMA_V(t, soff) do { const unsigned char* s_ = vimg + (size_t)(t) * VSLOT; const unsigned d_ = (unsigned)__builtin_amdgcn_readfirstlane(vdst + (soff)); \
        glds16(s_, d_); glds16(s_ + 1024, d_ + 1024); } while (0)
    bf16x8 qr[12];
    { const bf16* qp = QF + ((size_t)h * S + q0 + wid * 32 + r32) * 192 + hi * 8;
#pragma unroll
      for (int d0 = 0; d0 < 12; ++d0) qr[d0] = *(const bf16x8*)(qp + d0 * 16); }
    int k0 = 0, k1 = KSLOT, k2 = 2 * KSLOT, vp = 2 * VSLOT, vc = 0, vn = VSLOT;
    DMA_K(0, k0); DMA_K(1, k1); DMA_V(0, vc);
    float m_reg = -1e30f, l_reg = 0.f; f32x16 o[4]; o[0] = f32x16{}; o[1] = f32x16{}; o[2] = f32x16{}; o[3] = f32x16{};
    f32x16 pA0, pA1, pB0, pB1; float mnA, mnB, alA = 1.f, alB = 1.f; bf16x8 pa0, pa1, pa2, pa3;
#define RESC(a_) do { if (__any((a_) < 1.f)) { if (hi == 0) al_l[r32] = (a_); asm volatile("s_waitcnt lgkmcnt(0)" ::: "memory"); \
        _Pragma("unroll") for (int d_ = 0; d_ < 4; ++d_) _Pragma("unroll") for (int r = 0; r < 16; ++r) o[d_][r] *= al_l[crow(r, hi)]; } } while (0)
#define MASKT(P0_, P1_, t) do { const int kb_ = (j_lo + (t)) * 64; if (kb_ + 63 > qlo) mask_tile(P0_, P1_, qm - kb_); } while (0)
#define OPEN(t) do { if ((t) + 1 < NT) asm volatile("s_waitcnt vmcnt(5) lgkmcnt(0)\n\ts_barrier" ::: "memory"); \
        else if ((t) < NT) asm volatile("s_waitcnt vmcnt(2) lgkmcnt(0)\n\ts_barrier" ::: "memory"); else asm volatile("s_waitcnt vmcnt(0) lgkmcnt(0)\n\ts_barrier" ::: "memory"); \
        if ((t) + 2 < NT) DMA_K((t) + 2, k2); if ((t) + 1 < NT) DMA_V((t) + 1, vn); } while (0)
#define ROT() do { int t_ = k0; k0 = k1; k1 = k2; k2 = t_; t_ = vp; vp = vc; vc = vn; vn = t_; } while (0)
    if (wid < 4) {
    OPEN(0);
    SBAR(); qkt(pA0, pA1, Kl + k0, r32, hi, qr); MASKT(pA0, pA1, 0); partialSM(pA0, pA1, m_reg, mnA, alA); ROT();
#define STEP(PX0, PX1, mnX, alX, PY0, PY1, alY, t) do { \
        OPEN(t); \
        SBAR(); qkt(PX0, PX1, Kl + k0, r32, hi, qr); if (DBG_QK2) { asm volatile("" : "+v"(PX0), "+v"(PX1)); qkt(PX0, PX1, Kl + k0, r32, hi, qr); } \
        finishSM(PY0, PY1, alY, l_reg, pa0, pa1, pa2, pa3); SBAR(); \
        pv_tile(o, vb0 + vp, pa0, pa1, pa2, pa3); MASKT(PX0, PX1, (t)); partialSM(PX0, PX1, m_reg, mnX, alX); \
        RESC(alX); ROT(); } while (0)
    int t = 1;
    for (; t + 1 < NT; t += 2) {
        STEP(pB0, pB1, mnB, alB, pA0, pA1, alA, t);
        STEP(pA0, pA1, mnA, alA, pB0, pB1, alB, t + 1);
    }
    STEP(pB0, pB1, mnB, alB, pA0, pA1, alA, NT - 1);
    OPEN(NT);
    finishSM(pB0, pB1, alB, l_reg, pa0, pa1, pa2, pa3); SBAR();
    pv_tile(o, vb0 + vp, pa0, pa1, pa2, pa3);
#undef STEP
    } else {
    OPEN(0);
    SBAR(); qkt(pA0, pA1, Kl + k0, r32, hi, qr); ROT();
#define STEPB(PX0, PX1, PY0, PY1, mnY, alY, t) do { \
        OPEN(t); \
        MASKT(PY0, PY1, (t) - 1); partialSM(PY0, PY1, m_reg, mnY, alY); RESC(alY); \
        SBAR(); qkt(PX0, PX1, Kl + k0, r32, hi, qr); if (DBG_QK2) { asm volatile("" : "+v"(PX0), "+v"(PX1)); qkt(PX0, PX1, Kl + k0, r32, hi, qr); } \
        finishSM(PY0, PY1, alY, l_reg, pa0, pa1, pa2, pa3); SBAR(); \
        pv_tile(o, vb0 + vp, pa0, pa1, pa2, pa3); ROT(); } while (0)
    int t = 1;
    for (; t + 1 < NT; t += 2) {
        STEPB(pB0, pB1, pA0, pA1, mnA, alA, t);
        STEPB(pA0, pA1, pB0, pB1, mnB, alB, t + 1);
    }
    STEPB(pB0, pB1, pA0, pA1, mnA, alA, NT - 1);
    OPEN(NT);
    MASKT(pB0, pB1, NT - 1); partialSM(pB0, pB1, m_reg, mnB, alB); RESC(alB);
    finishSM(pB0, pB1, alB, l_reg, pa0, pa1, pa2, pa3); SBAR();
    pv_tile(o, vb0 + vp, pa0, pa1, pa2, pa3);
#undef STEPB
    }
    if (part < 0) {
    if (hi == 0) li_l[r32] = l_reg; asm volatile("s_waitcnt lgkmcnt(0)" ::: "memory");
    float rli[16];
#pragma unroll
    for (int r = 0; r < 16; ++r) rli[r] = __builtin_amdgcn_rcpf(li_l[crow(r, hi)]);
    bf16* Ow = MIX + (size_t)(q0 + wid * 32) * D + 512 + h * 128;
#pragma unroll
    for (int r = 0; r < 16; ++r) { const int orow = crow(r, hi);
#pragma unroll
        for (int d0 = 0; d0 < 4; ++d0) { const float v = o[d0][r] * rli[r]; const float vn = __shfl_xor(v, 1);
            if ((r32 & 1) == 0) *(unsigned*)(Ow + (size_t)orow * D + d0 * 32 + r32) = cvtpk(v, vn); } }
    } else {
    float* Pw = PART + ((size_t)part * 256 + wid * 32) * 128;
#pragma unroll
    for (int r = 0; r < 16; ++r) { const int orow = crow(r, hi);
#pragma unroll
        for (int d0 = 0; d0 < 4; ++d0) Pw[(size_t)orow * 128 + d0 * 32 + r32] = o[d0][r]; }
    if (hi == 0) { float* ml = PML + ((size_t)part * 256 + wid * 32 + r32) * 2; ml[0] = m_reg; ml[1] = l_reg; }
    }
    asm volatile("s_waitcnt lgkmcnt(0)\n\ts_barrier" ::: "memory");
#undef DMA_K
#undef DMA_V
#undef RESC
#undef MASKT
#undef OPEN
#undef ROT
}
}

__device__ __forceinline__ void fin_phase(const Args& a, int gw, int NGW, int lane) {
    unsigned char* ws = a.ws;
    const bf16* P1 = (const bf16*)(ws + WS_P1); const bf16* QR = (const bf16*)(ws + WS_QR); const bf16* KVR = (const bf16*)(ws + WS_KVR);
    bf16* QF = (bf16*)(ws + WS_QF); unsigned char* KIMG = ws + WS_KIMG; unsigned char* VIMG = ws + WS_VIMG; bf16* MIX = (bf16*)(ws + WS_MIX);
    const float* cosT = (const float*)(ws + WS_ROPE); const float* sinT = cosT + (size_t)S * 32;
    const float* qnw = (const float*)a.in[I_QNW]; const float* knw = (const float*)a.in[I_KNW]; const float* cw = (const float*)a.in[I_CONV];
    const int hl = lane & 15, h = lane >> 4, c4 = lane & 3;
    float wq[16], wk[16], wkr[16];
#pragma unroll
    for (int e = 0; e < 16; ++e) { wq[e] = hl < 12 ? qnw[hl * 16 + e] : 0.f; wk[e] = hl < 8 ? knw[hl * 16 + e] : 0.f; wkr[e] = knw[128 + c4 * 16 + e]; }
    float cw0[8], cw1[8], cw2[8];
#pragma unroll
    for (int e = 0; e < 8; ++e) { cw0[e] = cw[lane * 8 + e]; cw1[e] = cw[512 + lane * 8 + e]; cw2[e] = cw[1024 + lane * 8 + e]; }
    for (int t = gw; t < S; t += NGW) {
        const bf16* prow = P1 + (size_t)t * O_INP;
        float s_q, s_kv;
        { const v2u r = *(const v2u*)(prow + 1536 + lane * 4); const float x0 = bflo(r.x), x1 = bfhi(r.x), x2 = bflo(r.y), x3 = bfhi(r.y);
          s_q = 1.f / sqrtf(wave_sum((x0 * x0 + x1 * x1) + (x2 * x2 + x3 * x3)) * (1.f / 256.f) + EPS); }
        { const v2u r = *(const v2u*)(prow + 1792 + lane * 4); const float x0 = bflo(r.x), x1 = bfhi(r.x), x2 = bflo(r.y), x3 = bfhi(r.y);
          s_kv = 1.f / sqrtf(wave_sum((x0 * x0 + x1 * x1) + (x2 * x2 + x3 * x3)) * (1.f / 256.f) + EPS); }
        const int fi = (hl & 1) * 16;
        float cs[16], sn[16];
        { const f32x4* cp = (const f32x4*)(cosT + (size_t)t * 32 + fi); const f32x4* sp = (const f32x4*)(sinT + (size_t)t * 32 + fi);
#pragma unroll
          for (int q = 0; q < 4; ++q) { const f32x4 c_ = cp[q], s_ = sp[q]; cs[4 * q] = c_.x; cs[4 * q + 1] = c_.y; cs[4 * q + 2] = c_.z; cs[4 * q + 3] = c_.w; sn[4 * q] = s_.x; sn[4 * q + 1] = s_.y; sn[4 * q + 2] = s_.z; sn[4 * q + 3] = s_.w; } }
        { const v4u r0 = *(const v4u*)(QR + (size_t)t * 1024 + lane * 16), r1 = *(const v4u*)(QR + (size_t)t * 1024 + lane * 16 + 8);
          float x[16] = {bflo(r0.x), bfhi(r0.x), bflo(r0.y), bfhi(r0.y), bflo(r0.z), bfhi(r0.z), bflo(r0.w), bfhi(r0.w), bflo(r1.x), bfhi(r1.x), bflo(r1.y), bfhi(r1.y), bflo(r1.z), bfhi(r1.z), bflo(r1.w), bfhi(r1.w)};
          float ss = 0.f;
#pragma unroll
          for (int e = 0; e < 16; ++e) { x[e] *= s_q; ss += x[e] * x[e]; }
          ss += __shfl_xor(ss, 1); ss += __shfl_xor(ss, 2); ss += __shfl_xor(ss, 4); ss += __shfl_xor(ss, 8);
          const float rq = 1.f / sqrtf(ss * (1.f / 192.f) + EPS);
          float y[16];
#pragma unroll
          for (int e = 0; e < 16; ++e) { const float v = x[e] * rq * wq[e]; const float pr = __shfl_xor(v, 2);
              y[e] = hl < 8 ? v : (hl < 10 ? v * cs[e] - pr * sn[e] : v * cs[e] + pr * sn[e]); }
          if (hl < 12) { v4u o0, o1; o0.x = pk2(y[0], y[1]); o0.y = pk2(y[2], y[3]); o0.z = pk2(y[4], y[5]); o0.w = pk2(y[6], y[7]); o1.x = pk2(y[8], y[9]); o1.y = pk2(y[10], y[11]); o1.z = pk2(y[12], y[13]); o1.w = pk2(y[14], y[15]);
              bf16* qd = QF + ((size_t)h * S + t) * 192 + hl * 16; *(v4u*)qd = o0; *(v4u*)(qd + 8) = o1; } }
        { const v4u r0 = *(const v4u*)(KVR + (size_t)t * 1024 + lane * 16), r1 = *(const v4u*)(KVR + (size_t)t * 1024 + lane * 16 + 8);
          float x[16] = {bflo(r0.x), bfhi(r0.x), bflo(r0.y), bfhi(r0.y), bflo(r0.z), bfhi(r0.z), bflo(r0.w), bfhi(r0.w), bflo(r1.x), bfhi(r1.x), bflo(r1.y), bfhi(r1.y), bflo(r1.z), bfhi(r1.z), bflo(r1.w), bfhi(r1.w)};
          const v4u p0 = *(const v4u*)(prow + 2048 + c4 * 16), p1 = *(const v4u*)(prow + 2048 + c4 * 16 + 8);
          float kp[16] = {bflo(p0.x), bfhi(p0.x), bflo(p0.y), bfhi(p0.y), bflo(p0.z), bfhi(p0.z), bflo(p0.w), bfhi(p0.w), bflo(p1.x), bfhi(p1.x), bflo(p1.y), bfhi(p1.y), bflo(p1.z), bfhi(p1.z), bflo(p1.w), bfhi(p1.w)};
          float ssk = 0.f, ssp = 0.f;
#pragma unroll
          for (int e = 0; e < 16; ++e) { x[e] *= s_kv; ssk += x[e] * x[e]; ssp += kp[e] * kp[e]; }
          if (hl >= 8) ssk = 0.f;
          ssk += __shfl_xor(ssk, 1); ssk += __shfl_xor(ssk, 2); ssk += __shfl_xor(ssk, 4); ssk += __shfl_xor(ssk, 8);
          ssp += __shfl_xor(ssp, 1); ssp += __shfl_xor(ssp, 2);
          const float rk = 1.f / sqrtf((ssk + ssp) * (1.f / 192.f) + EPS);
          const int krow = t & 63, tile = t >> 6;
          unsigned char* kt = KIMG + ((size_t)h * 256 + tile) * att::KSLOT; unsigned char* vt = VIMG + ((size_t)h * 256 + tile) * att::VSLOT;
          float y[16];
#pragma unroll
          for (int e = 0; e < 16; ++e) y[e] = hl < 8 ? x[e] * rk * wk[e] : x[e];
          { v4u o0, o1; o0.x = pk2(y[0], y[1]); o0.y = pk2(y[2], y[3]); o0.z = pk2(y[4], y[5]); o0.w = pk2(y[6], y[7]); o1.x = pk2(y[8], y[9]); o1.y = pk2(y[10], y[11]); o1.z = pk2(y[12], y[13]); o1.w = pk2(y[14], y[15]);
            if (hl < 8) { *(v4u*)(kt + att::k_nope_off(krow, hl * 32)) = o0; *(v4u*)(kt + att::k_nope_off(krow, hl * 32 + 16)) = o1; }
            else { *(v4u*)(vt + att::v_st(krow, (hl - 8) * 16)) = o0; *(v4u*)(vt + att::v_st(krow, (hl - 8) * 16 + 8)) = o1; } }
          float z[16];
#pragma unroll
          for (int e = 0; e < 16; ++e) { const float v = kp[e] * rk * wkr[e]; const float pr = __shfl_xor(v, 2); z[e] = c4 < 2 ? v * cs[e] - pr * sn[e] : v * cs[e] + pr * sn[e]; }
          if (hl < 4) { v4u o0, o1; o0.x = pk2(z[0], z[1]); o0.y = pk2(z[2], z[3]); o0.z = pk2(z[4], z[5]); o0.w = pk2(z[6], z[7]); o1.x = pk2(z[8], z[9]); o1.y = pk2(z[10], z[11]); o1.z = pk2(z[12], z[13]); o1.w = pk2(z[14], z[15]);
              *(v4u*)(kt + att::k_rope_off(krow, c4 * 32)) = o0; *(v4u*)(kt + att::k_rope_off(krow, c4 * 32 + 16)) = o1; } }
        { const int ch = lane * 8; float conv[8] = {0.f, 0.f, 0.f, 0.f, 0.f, 0.f, 0.f, 0.f};
#pragma unroll
          for (int k = 0; k < 3; ++k) { const int tt = t - 2 + k; if (tt >= 0) { const bf16* pr = P1 + (size_t)tt * O_INP; const v4u cg = *(const v4u*)(pr + 512 + ch), hh = *(const v4u*)(pr + 1024 + ch);
              const float* wv = k == 0 ? cw0 : (k == 1 ? cw1 : cw2);
              conv[0] += wv[0] * bflo(cg.x) * bflo(hh.x); conv[1] += wv[1] * bfhi(cg.x) * bfhi(hh.x); conv[2] += wv[2] * bflo(cg.y) * bflo(hh.y); conv[3] += wv[3] * bfhi(cg.y) * bfhi(hh.y);
              conv[4] += wv[4] * bflo(cg.z) * bflo(hh.z); conv[5] += wv[5] * bfhi(cg.z) * bfhi(hh.z); conv[6] += wv[6] * bflo(cg.w) * bflo(hh.w); conv[7] += wv[7] * bfhi(cg.w) * bfhi(hh.w); } }
          const v4u bg = *(const v4u*)(prow + ch);
          v4u o; o.x = pk2(bflo(bg.x) * conv[0], bfhi(bg.x) * conv[1]); o.y = pk2(bflo(bg.y) * conv[2], bfhi(bg.y) * conv[3]); o.z = pk2(bflo(bg.z) * conv[4], bfhi(bg.z) * conv[5]); o.w = pk2(bflo(bg.w) * conv[6], bfhi(bg.w) * conv[7]);
          *(v4u*)(MIX + (size_t)t * D + ch) = o; }
    }
}

__device__ __forceinline__ void route1_phase(const Args& a, LAS unsigned char* lds, int vcu, int G, int tid) {
    unsigned char* ws = a.ws; const float* XR = (const float*)(ws + WS_XR); const float* modF = (const float*)(ws + WS_MODF) + 6144;
    const float* nw = (const float*)a.in[I_NFW] + 1024; const float* rw = (const float*)a.in[I_RW];
    unsigned* tok = (unsigned*)(ws + WS_TOK); unsigned* cnt = (unsigned*)(ws + WS_CTL) + CW_CNT;
    const int lane = tid & 63, wave = __builtin_amdgcn_readfirstlane(tid >> 6);
    LAS int* tokE = (LAS int*)lds;
    LAS int* tokL = (LAS int*)(lds + 512);
    LAS int* offS = (LAS int*)(lds + 1024);
    f32x4 g[4], sh[4];
#pragma unroll
    for (int j = 0; j < 4; ++j)
#pragma unroll
        for (int e = 0; e < 4; ++e) { const int col = 4 * lane + e + 256 * j; g[j][e] = nw[col] * (1.f + modF[OFF_SCF + col]); sh[j][e] = modF[OFF_SHF + col]; }
    for (int chunk = vcu; chunk < S / 64; chunk += G) {
        for (int i = 0; i < 8; ++i) { const int ti = wave * 8 + i, t = chunk * 64 + ti;
            const f32x4* xr = (const f32x4*)(XR + (size_t)t * D) + lane; f32x4 v[4]; float s = 0.f;
#pragma unroll
            for (int j = 0; j < 4; ++j) { v[j] = xr[64 * j]; s += (v[j].x * v[j].x + v[j].y * v[j].y) + (v[j].z * v[j].z + v[j].w * v[j].w); }
            const float rstd = 1.f / sqrtf(wave_sum(s) * (1.f / D) + EPS);
            float lg[8] = {0.f, 0.f, 0.f, 0.f, 0.f, 0.f, 0.f, 0.f};
#pragma unroll
            for (int j = 0; j < 4; ++j) { const f32x4 hv = v[j] * rstd * g[j] + sh[j];
#pragma unroll
                for (int e = 0; e < 4; ++e) { const int col = 4 * lane + e + 256 * j; const f32x4 w0 = *(const f32x4*)(rw + col * 8), w1 = *(const f32x4*)(rw + col * 8 + 4); const float hx = hv[e];
                    lg[0] += hx * w0.x; lg[1] += hx * w0.y; lg[2] += hx * w0.z; lg[3] += hx * w0.w; lg[4] += hx * w1.x; lg[5] += hx * w1.y; lg[6] += hx * w1.z; lg[7] += hx * w1.w; } }
#pragma unroll
            for (int e = 0; e < 8; ++e) lg[e] = wave_sum(lg[e]);
            int e1 = 0; float l1 = lg[0];
#pragma unroll
            for (int e = 1; e < 8; ++e) if (lg[e] > l1) { l1 = lg[e]; e1 = e; }
            int e2 = -1; float l2 = -__builtin_inff();
#pragma unroll
            for (int e = 0; e < 8; ++e) if (e != e1 && lg[e] > l2) { l2 = lg[e]; e2 = e; }
            const float g1 = 1.f / (1.f + __expf(l2 - l1)), g2 = 1.f - g1;
            if (lane == 0) { unsigned* rec = tok + (size_t)t * 8; rec[0] = (unsigned)e1; rec[1] = (unsigned)e2; rec[4] = __float_as_uint(g1); rec[5] = __float_as_uint(g2); rec[6] = __float_as_uint(rstd);
                tokE[2 * ti] = e1; tokE[2 * ti + 1] = e2; } }
        __syncthreads();
        if (tid < 8) { int c = 0; for (int i = 0; i < 128; ++i) if (tokE[i] == tid) { tokL[i] = c; ++c; }
            offS[tid] = (int)__hip_atomic_fetch_add(cnt + 64 * tid, (unsigned)c, RLX_AGENT); }
        __syncthreads();
        if (tid < 128) { const int t = chunk * 64 + (tid >> 1); tok[(size_t)t * 8 + 2 + (tid & 1)] = (unsigned)(offS[tokE[tid]] + tokL[tid]); }
        __syncthreads();
    }
}
__device__ __forceinline__ void route2_phase(const Args& a, int gw, int NGW, int lane) {
    unsigned char* ws = a.ws; const float* XR = (const float*)(ws + WS_XR); const float* modF = (const float*)(ws + WS_MODF) + 6144;
    const float* nw = (const float*)a.in[I_NFW] + 1024; unsigned* tok = (unsigned*)(ws + WS_TOK); const unsigned* cnt = (const unsigned*)(ws + WS_CTL) + CW_CNT;
    unsigned char* AM = ws + WS_AMOE;
    f32x4 g[4], sh[4];
#pragma unroll
    for (int j = 0; j < 4; ++j)
#pragma unroll
        for (int e = 0; e < 4; ++e) { const int col = 4 * lane + e + 256 * j; g[j][e] = nw[col] * (1.f + modF[OFF_SCF + col]); sh[j][e] = modF[OFF_SHF + col]; }
    int base[8]; { int b = 0;
#pragma unroll
      for (int e = 0; e < 8; ++e) { base[e] = b; b += (int)((__hip_atomic_load(cnt + 64 * e, RLX_AGENT) + 255u) >> 8) * 256; } }
    for (int t = gw; t < S; t += NGW) {
        unsigned* rec = tok + (size_t)t * 8; const int e1 = (int)rec[0], e2 = (int)rec[1]; const float rstd = __uint_as_float(rec[6]);
        int b1 = 0, b2 = 0;
#pragma unroll
        for (int e = 0; e < 8; ++e) { b1 = e1 == e ? base[e] : b1; b2 = e2 == e ? base[e] : b2; }
        const int s1 = b1 + (int)rec[2], s2 = b2 + (int)rec[3];
        const f32x4* xr = (const f32x4*)(XR + (size_t)t * D) + lane;
        unsigned* o1 = (unsigned*)(AM + (size_t)s1 * D) + lane; unsigned* o2 = (unsigned*)(AM + (size_t)s2 * D) + lane;
#pragma unroll
        for (int j = 0; j < 4; ++j) { const f32x4 y = xr[64 * j] * rstd * g[j] + sh[j]; const unsigned w = pg8::pk4_fp8(y.x, y.y, y.z, y.w); o1[64 * j] = w; o2[64 * j] = w; }
        if (lane == 0) { rec[2] = (unsigned)s1; rec[3] = (unsigned)s2; }
    }
}
__device__ __forceinline__ void combine_phase(const Args& a, int gw, int NGW, int lane) {
    unsigned char* ws = a.ws; const float* XR = (const float*)(ws + WS_XR); const float* gf = (const float*)(ws + WS_MODF) + 6144 + OFF_GF;
    const unsigned* tok = (const unsigned*)(ws + WS_TOK); const bf16* Y = (const bf16*)(ws + WS_AMOE);
    f32x4 gg[4];
#pragma unroll
    for (int j = 0; j < 4; ++j) gg[j] = *(const f32x4*)(gf + 4 * lane + 256 * j);
    for (int t = gw; t < S; t += NGW) {
        const unsigned* rec = tok + (size_t)t * 8; const int s1 = (int)rec[2], s2 = (int)rec[3]; const float g1 = __uint_as_float(rec[4]), g2 = __uint_as_float(rec[5]);
        const f32x4* xr = (const f32x4*)(XR + (size_t)t * D) + lane; f32x4* orow = (f32x4*)(a.out + (size_t)t * D) + lane;
        const v2u* y1 = (const v2u*)(Y + (size_t)s1 * D) + lane; const v2u* y2 = (const v2u*)(Y + (size_t)s2 * D) + lane;
#pragma unroll
        for (int j = 0; j < 4; ++j) { const v2u a1 = y1[64 * j], a2 = y2[64 * j];
            f32x4 m; m.x = g1 * bflo(a1.x) + g2 * bflo(a2.x); m.y = g1 * bfhi(a1.x) + g2 * bfhi(a2.x); m.z = g1 * bflo(a1.y) + g2 * bflo(a2.y); m.w = g1 * bfhi(a1.y) + g2 * bfhi(a2.y);
            orow[64 * j] = xr[64 * j] + gg[j] * m; }
    }
}

constexpr int N_PHASES = 19;
__global__ void __launch_bounds__(NTHR, 2) fwd_kernel(Args args) {
    extern __shared__ __attribute__((aligned(16))) unsigned char lds[];
    LAS unsigned char* L = (LAS unsigned char*)lds;
    const int tid = threadIdx.x, lane = tid & 63, wave = __builtin_amdgcn_readfirstlane(tid >> 6);
    const int G = gridDim.x; int bx = blockIdx.x; int vcu = (G % 8 == 0) ? (bx % 8) * (G / 8) + bx / 8 : bx;
    int gw = vcu * NWAVES + wave; const int NGW = G * NWAVES;
    unsigned char* ws = args.ws;
    for (int u = tid; u < (LDS_BYTES - LDSCTL_OFF) / 4; u += NTHR) ((LAS unsigned*)(L + LDSCTL_OFF))[u] = 0u;
    __syncthreads();
    XcdBarrier bar; bar.bar = (unsigned*)(ws + WS_CTL) + CW_BAR; bar.x = 0; bar.st = nullptr;
#if !MK_MULTI
    bar = xcd_barrier_post((unsigned*)(ws + WS_CTL) + CW_BAR, (volatile LAS unsigned*)(L + MISC_OFF) + 8);
    if (tid == 0) { volatile LAS unsigned* M = (volatile LAS unsigned*)(L + MISC_OFF); M[10] = bar.x; M[11] = xb_add((unsigned*)(ws + WS_CTL) + CW_XRANK + 64 * bar.x, 1u); }
#define GRID_BAR() xcd_barrier(bar)
#else
#define GRID_BAR() do {} while (0)
#endif
    const int lo = args.ph_lo, hi = args.ph_hi;
#define IN(k) (lo <= (k) && (k) < hi)
#define BOTH(k) (IN(k) && IN((k) + 1))
    const float* modF = (const float*)(ws + WS_MODF);
    bf16* ABUF = (bf16*)(ws + WS_ABUF); bf16* MIX = (bf16*)(ws + WS_MIX); float* XR = (float*)(ws + WS_XR);

    if (IN(0)) { p0_prologue(args, L, vcu, G, tid); if (DBG_REP == 0) { GRID_BAR(); p0_prologue(args, L, vcu, G, tid); } if (BOTH(0)) GRID_BAR(); }
#if !MK_MULTI && XCC_ORDER
    if (BOTH(0)) {
        volatile LAS unsigned* M = (volatile LAS unsigned*)(L + MISC_OFF);
        if (tid == 0) { unsigned* xb = (unsigned*)(ws + WS_CTL) + CW_BAR; bool ok = (G % 8) == 0;
            for (unsigned j = 0; j < 16; ++j) { const unsigned c_ = xb_ld(&xb[XB_XCNT(j)]); ok = ok && (c_ == (j < 8 ? (unsigned)(G / 8) : 0u)); }
            M[12] = ok ? (M[11] * 8u + M[10]) : (unsigned)blockIdx.x; }
        __syncthreads();
        bx = (int)M[12]; vcu = (G % 8 == 0) ? (bx % 8) * (G / 8) + bx / 8 : bx; gw = vcu * NWAVES + wave;
    }
#endif
    if (IN(1)) {
        { float* mf = (float*)(ws + WS_MODF); for (int i = vcu * NTHR + tid; i < 2 * 6144; i += G * NTHR) mf[i] = modv_partial((const float*)(ws + WS_MODP), (const float*)args.in[I_ADAB], i / 6144, i % 6144); }
        norm_phase<true>(args, (const float*)args.in[I_X], ABUF, (const float*)args.in[I_NMW], 0, OFF_SHM, OFF_SCM, gw, NGW, lane, (LAS float*)L);
        if (DBG_REP == 1) { GRID_BAR(); norm_phase<true>(args, (const float*)args.in[I_X], ABUF, (const float*)args.in[I_NMW], 0, OFF_SHM, OFF_SCM, gw, NGW, lane, (LAS float*)L); }
        if (BOTH(1)) GRID_BAR(); }
    if (IN(2)) { pg8::Gemm g{ABUF, ws + WS_WIN0, 2048, 2048}; pg8::StaticOrder So; So.init(S, E_IN, G, bx);
        pg8::EpiBf16G E{(bf16*)(ws + WS_P0), E_IN, 4, 1.f}; pg8::gemm_phase(L, g, So, E); if (DBG_REP == 2) { GRID_BAR(); pg8::gemm_phase(L, g, So, E); } conv_fill(args, L, (unsigned*)(ws + WS_CTL) + CW_GD, G, tid); if (BOTH(2)) GRID_BAR(); }
    if (IN(3)) { mixab_phase(args, L, vcu, G, tid); if (DBG_REP == 3) { GRID_BAR(); mixab_phase(args, L, vcu, G, tid); } if (BOTH(3)) GRID_BAR(); }
    if (IN(4)) { pg8::Gemm g{MIX, ws + WS_WOUT0, 2048, 2048}; pg8::StaticOrder So; So.init(S, 1024, G, bx);
        pg8::EpiRes E{(const float*)args.in[I_X], XR, modF + OFF_GM, 1.f}; pg8::gemm_phase(L, g, So, E); if (DBG_REP == 4) { GRID_BAR(); pg8::gemm_phase(L, g, So, E); } if (BOTH(4)) GRID_BAR(); }
    if (IN(5)) { norm_phase<false, FFN_FP8 != 0>(args, XR, ABUF, (const float*)args.in[I_NFW], 0, OFF_SHF, OFF_SCF, gw, NGW, lane); if (DBG_REP == 5) { GRID_BAR(); norm_phase<false, FFN_FP8 != 0>(args, XR, ABUF, (const float*)args.in[I_NFW], 0, OFF_SHF, OFF_SCF, gw, NGW, lane); } if (BOTH(5)) GRID_BAR(); }
#if FFN_FP8
    if (IN(6)) { pg8::Gemm g{ABUF, ws + WS_WGU0, 1024, 1024}; pg8::StaticOrder So; So.init(S, 2 * D_FF, G, bx);
        pg8::EpiSwiGLU8 E{ws + WS_H, D_FF, 1.f / MOE_WSCALE}; pg8::gemm_phase<pg8::EpiSwiGLU8, pg8::StaticOrder, true>(L, g, So, E); if (BOTH(6)) GRID_BAR(); }
#else
    if (IN(6)) { pg8::Gemm g{ABUF, ws + WS_WGU0, 2048, 2048}; pg8::StaticOrder So; So.init(S, 2 * D_FF, G, bx);
        pg8::EpiSwiGLU E{(bf16*)(ws + WS_H), D_FF}; pg8::gemm_phase(L, g, So, E); if (DBG_REP == 6) { GRID_BAR(); pg8::gemm_phase(L, g, So, E); } conv_fill(args, L, (unsigned*)(ws + WS_CTL) + CW_GD + 64, G, tid); if (BOTH(6)) GRID_BAR(); }
#endif
#if FFN_FP8
    if (IN(7)) { pg8::Gemm g{ws + WS_H, ws + WS_WD0, D_FF, D_FF}; pg8::StaticOrder So; So.init(S, 1024, G, bx);
        pg8::EpiRes E{XR, XR, modF + OFF_GF, 1.f / MOE_WSCALE}; pg8::gemm_phase<pg8::EpiRes, pg8::StaticOrder, true>(L, g, So, E); if (BOTH(7)) GRID_BAR(); }
#else
    if (IN(7)) { pg8::Gemm g{ws + WS_H, ws + WS_WD0, D_FF * 2, D_FF * 2}; pg8::StaticOrder So; So.init(S, 1024, G, bx);
        pg8::EpiRes E{XR, XR, modF + OFF_GF, 1.f}; pg8::gemm_phase(L, g, So, E); if (BOTH(7)) GRID_BAR(); }
#endif
    if (IN(8)) { norm_phase<false>(args, XR, ABUF, (const float*)args.in[I_NMW] + 1024, 1, OFF_SHM, OFF_SCM, gw, NGW, lane); if (BOTH(8)) GRID_BAR(); }
    if (IN(9)) { pg8::Gemm g{ABUF, ws + WS_WIN1, 2048, 2048}; pg8::StaticOrder So; So.init(S, O_INP, G, bx);
        pg8::EpiBf16G E{(bf16*)(ws + WS_P1), O_INP, 0, 1.f}; pg8::gemm_phase(L, g, So, E); if (DBG_REP == 9) { GRID_BAR(); pg8::gemm_phase(L, g, So, E); } conv_fill(args, L, (unsigned*)(ws + WS_CTL) + CW_GD + 128, G, tid); if (BOTH(9)) GRID_BAR(); }
    if (IN(10)) {
        for (int rep_ = 0; rep_ < (DBG_REP == 10 ? 2 : 1); ++rep_) { if (rep_) GRID_BAR();
        { pg8::Gemm g{(const bf16*)(ws + WS_P1) + 1536, ws + WS_WUQ, O_INP * 2, 512}; pg8::StaticOrder So; So.init(S, 1024, G, bx);
          pg8::EpiBf16G E{(bf16*)(ws + WS_QR), 1024, 0, 1.f}; pg8::gemm_phase(L, g, So, E); }
        { pg8::Gemm g{(const bf16*)(ws + WS_P1) + 1792, ws + WS_WUKV, O_INP * 2, 512}; pg8::StaticOrder So; So.init(S, 1024, G, bx);
          pg8::EpiBf16G E{(bf16*)(ws + WS_KVR), 1024, 0, 1.f}; pg8::gemm_phase(L, g, So, E); } }
        if (BOTH(10)) GRID_BAR(); }
    if (IN(11)) { fin_phase(args, gw, NGW, lane); if (DBG_REP == 11) { GRID_BAR(); fin_phase(args, gw, NGW, lane); } if (BOTH(11)) GRID_BAR(); }
    if (IN(12)) {
        for (int rep = 0; rep < (DBG_REP == 12 ? 2 : 1); ++rep) { if (rep) GRID_BAR();
        for (int u = bx; u < 256; u += G) { const int h = u & 3, v = u >> 2, sb = v >> 1, role = v & 1, nA = 126 - 4 * sb, pi = (h * 32 + sb) * 2;
            const bf16* QF = (const bf16*)(ws + WS_QF); float* PART = (float*)(ws + WS_PART); float* PML = (float*)(ws + WS_PML);
            if (role == 0) { att::attn_block(h, sb, 0, 4 * (sb + 1), -1, QF, ws + WS_KIMG, ws + WS_VIMG, MIX, PART, PML, (char*)lds);
                             att::attn_block(h, 63 - sb, 0, nA, pi, QF, ws + WS_KIMG, ws + WS_VIMG, MIX, PART, PML, (char*)lds); }
            else att::attn_block(h, 63 - sb, nA, 4 * (64 - sb), pi + 1, QF, ws + WS_KIMG, ws + WS_VIMG, MIX, PART, PML, (char*)lds); } }
        GRID_BAR();
        { const float* PART = (const float*)(ws + WS_PART); const float* PML = (const float*)(ws + WS_PML); constexpr float C2 = 1.4426950408889634f * att::SCALE;
          for (int it = vcu * NTHR + tid; it < 128 * 256 * 16; it += G * NTHR) { const int rw = it >> 4, c8 = (it & 15) * 8, blk = rw >> 8, row = rw & 255, h = blk >> 5, sb = blk & 31, pi = blk * 2;
              const size_t ra = (size_t)pi * 256 + row, rb = ra + 256;
              const float mA = PML[ra * 2], lA = PML[ra * 2 + 1], mB = PML[rb * 2], lB = PML[rb * 2 + 1];
              const f32x4 a0 = *(const f32x4*)(PART + ra * 128 + c8), a1 = *(const f32x4*)(PART + ra * 128 + c8 + 4), b0 = *(const f32x4*)(PART + rb * 128 + c8), b1 = *(const f32x4*)(PART + rb * 128 + c8 + 4);
              const float m = fmaxf(mA, mB), wA = __builtin_amdgcn_exp2f((mA - m) * C2), wB = __builtin_amdgcn_exp2f((mB - m) * C2), inv = 1.f / (lA * wA + lB * wB);
              const f32x4 v0 = (a0 * wA + b0 * wB) * inv, v1 = (a1 * wA + b1 * wB) * inv;
              v4u o; o.x = pk2(v0[0], v0[1]); o.y = pk2(v0[2], v0[3]); o.z = pk2(v1[0], v1[1]); o.w = pk2(v1[2], v1[3]);
              *(v4u*)(MIX + (size_t)((63 - sb) * 256 + row) * D + 512 + h * 128 + c8) = o; } }
        if (BOTH(12)) GRID_BAR(); }
    if (IN(13)) { pg8::Gemm g{MIX, ws + WS_WOUT1, 2048, 2048}; pg8::StaticOrder So; So.init(S, 1024, G, bx);
        pg8::EpiRes E{XR, XR, modF + 6144 + OFF_GM, 1.f}; pg8::gemm_phase(L, g, So, E); if (BOTH(13)) GRID_BAR(); }
    if (IN(14)) { conv_fill(args, L, nullptr, G, tid); route1_phase(args, L, vcu, G, tid); if (BOTH(14)) GRID_BAR(); }
    if (IN(15)) { route2_phase(args, gw, NGW, lane); if (BOTH(15)) GRID_BAR(); }
    if (IN(16)) { pg8::Gemm g{ws + WS_AMOE, ws + WS_WGUM, 1024, 1024}; pg8::MoeOrder Mo; Mo.init((const unsigned*)(ws + WS_CTL) + CW_CNT, 28, G, vcu);
        pg8::EpiSwiGLU8 E{ws + WS_HM, DFE, 1.f / MOE_WSCALE}; pg8::gemm_phase<pg8::EpiSwiGLU8, pg8::MoeOrder, true>(L, g, Mo, E); if (DBG_REP == 16) { GRID_BAR(); pg8::gemm_phase<pg8::EpiSwiGLU8, pg8::MoeOrder, true>(L, g, Mo, E); } if (BOTH(16)) GRID_BAR(); }
    if (IN(17)) { pg8::Gemm g{ws + WS_HM, ws + WS_WDM, DFE, DFE}; pg8::MoeOrder Mo; Mo.init((const unsigned*)(ws + WS_CTL) + CW_CNT, 4, G, vcu);
        pg8::EpiBf16G E{(bf16*)(ws + WS_AMOE), 1024, 0, 1.f / MOE_WSCALE}; pg8::gemm_phase<pg8::EpiBf16G, pg8::MoeOrder, true>(L, g, Mo, E); if (DBG_REP == 17) { GRID_BAR(); pg8::gemm_phase<pg8::EpiBf16G, pg8::MoeOrder, true>(L, g, Mo, E); } if (BOTH(17)) GRID_BAR(); }
    if (IN(18)) { combine_phase(args, gw, NGW, lane); if (DBG_REP == 18) { GRID_BAR(); combine_phase(args, gw, NGW, lane); } }
#if DBG_DUMMY
    if (IN(18)) { GRID_BAR();
#if DBG_DUMMY >= 6 && DBG_DUMMY <= 8
        constexpr int KBX = DBG_DUMMY == 6 ? 1024 : (DBG_DUMMY == 7 ? 2048 : 4096);
        pg8::Gemm g{XR, XR, 4096, KBX}; pg8::StaticOrder So; So.init(S, 8192 * 1024 / KBX, G, bx);
        pg8::EpiNone E{}; pg8::gemm_phase<pg8::EpiNone, pg8::StaticOrder, true>(L, g, So, E);
#elif DBG_DUMMY == 5
        pg8::Gemm g{ABUF, ws + WS_WGUM, 2048, 1024}; pg8::MoeOrder Mo; Mo.init((const unsigned*)(ws + WS_CTL) + CW_CNT, 28, G, vcu);
        pg8::EpiNone E{}; pg8::gemm_phase<pg8::EpiNone, pg8::MoeOrder, true>(L, g, Mo, E);
#elif DBG_DUMMY == 4
        pg8::Gemm g{ABUF, ws + WS_WGUM, 2048, 1024}; pg8::StaticOrder So; So.init(4096, 57344, G, bx);
        pg8::EpiNone E{}; pg8::gemm_phase<pg8::EpiNone, pg8::StaticOrder, true>(L, g, So, E);
#elif DBG_DUMMY == 3
        pg8::Gemm g{ABUF, ws + WS_WGU0, 2048, 2048}; pg8::StaticOrder So; So.init(S, 2048, G, bx);
        pg8::EpiNone E{}; pg8::gemm_phase<pg8::EpiNone, pg8::StaticOrder, true>(L, g, So, E);
#elif DBG_DUMMY == 2
        pg8::Gemm g{ABUF, ws + WS_WGUM, 2048, 1024}; pg8::StaticOrder So; So.init(S, 4096, G, bx);
        pg8::EpiSwiGLU8 E{ws + WS_HM, DFE, 1.f / MOE_WSCALE}; pg8::gemm_phase<pg8::EpiSwiGLU8, pg8::StaticOrder, true>(L, g, So, E);
#else
        pg8::Gemm g{ABUF, ws + WS_WGUM, 2048, 1024}; pg8::StaticOrder So; So.init(S, 4096, G, bx);
        pg8::EpiNone E{}; pg8::gemm_phase<pg8::EpiNone, pg8::StaticOrder, true>(L, g, So, E);
#endif
    }
#endif
    if (IN(19)) { const f32x4* src = (const f32x4*)(DBG_STOP < 4 ? (const float*)args.in[I_X] : (const float*)XR); f32x4* dst = (f32x4*)args.out;
        for (size_t i = (size_t)vcu * NTHR + tid; i < (size_t)S * D / 4; i += (size_t)G * NTHR) dst[i] = src[i]; }
#undef IN
#undef BOTH
}

extern "C" void kernel_launch(void* const* d_in, const int* in_sizes, int n_in, void* d_out, int out_size, void* d_ws, size_t ws_size, hipStream_t stream) {
    static int grid = 0;
    if (grid == 0) {
        if (n_in != 29 || out_size != S * D || ws_size < WS_END) { fprintf(stderr, "kernel_launch: unexpected shapes (n_in %d out %d ws %zu)\n", n_in, out_size, ws_size); grid = -1; return; }
        int dev = 0, cus = 0;
        if (hipGetDevice(&dev) != hipSuccess || hipDeviceGetAttribute(&cus, hipDeviceAttributeMultiprocessorCount, dev) != hipSuccess) { grid = -1; return; }
        if (hipFuncSetAttribute((const void*)fwd_kernel, hipFuncAttributeMaxDynamicSharedMemorySize, LDS_BYTES) != hipSuccess) { grid = -1; return; }
        int per_cu = 0;
        if (hipOccupancyMaxActiveBlocksPerMultiprocessor(&per_cu, (const void*)fwd_kernel, NTHR, LDS_BYTES) != hipSuccess || per_cu < 1) fprintf(stderr, "kernel_launch: occupancy query says %d\n", per_cu);
        (void)hipGetLastError();
        grid = cus;
    }
    if (grid < 0) return;
    (void)hipMemsetAsync((char*)d_ws + WS_CTL, 0, CTL_ZERO_BYTES, stream);
    Args a{};
    for (int i = 0; i < 29; ++i) a.in[i] = d_in[i];
    a.out = (float*)d_out; a.ws = (unsigned char*)d_ws;
#if MK_MULTI
    { const int last = DBG_STOP < 0 ? N_PHASES - 1 : DBG_STOP;
      for (int p = 0; p <= last; ++p) { a.ph_lo = p; a.ph_hi = p + 1; hipLaunchKernelGGL(fwd_kernel, dim3(grid), dim3(NTHR), LDS_BYTES, stream, a); }
      if (DBG_STOP >= 0) { a.ph_lo = 19; a.ph_hi = 20; hipLaunchKernelGGL(fwd_kernel, dim3(grid), dim3(NTHR), LDS_BYTES, stream, a); } }
#else
    a.ph_lo = 0; a.ph_hi = N_PHASES;
    hipLaunchKernelGGL(fwd_kernel, dim3(grid), dim3(NTHR), LDS_BYTES, stream, a);
#endif
}
```

```cpp
#include <hip/hip_runtime.h>
#include <cstdio>
#include <cstdint>

#ifndef MK_MULTI
#define MK_MULTI 0
#endif
#ifndef FFN_FP8
#define FFN_FP8 0
#endif
#ifndef DBG_EPI2
#define DBG_EPI2 0
#endif
#ifndef DBG_DUMMY
#define DBG_DUMMY 0
#endif
#ifndef XCC_ORDER
#define XCC_ORDER 1
#endif
#ifndef DBG_QK2
#define DBG_QK2 0
#endif
#ifndef SO_WGM
#define SO_WGM 8
#endif
#ifndef DBG_REP
#define DBG_REP -1
#endif
#ifndef DBG_STOP
#define DBG_STOP -1
#endif

namespace pg8 {
#define PG8_LAS __attribute__((address_space(3)))
typedef unsigned short bf16_t;
typedef short bf16x8 __attribute__((ext_vector_type(8)));
typedef float f32x4 __attribute__((ext_vector_type(4)));
typedef float f32x2 __attribute__((ext_vector_type(2)));
typedef unsigned u32x4 __attribute__((ext_vector_type(4)));
typedef unsigned u32x2 __attribute__((ext_vector_type(2)));
typedef int i32x4 __attribute__((ext_vector_type(4)));
typedef int i32x8 __attribute__((ext_vector_type(8)));
constexpr int BM = 256, BK = 64, HALF = 128, HTB = HALF * BK * 2, STAGE_BYTES = 8 * HTB, NXCD = 8, WGM = 8;

__host__ __device__ __forceinline__ int lds_byte(int r, int c) { const int st = (r >> 4) * 2 + (c >> 5), rr = r & 15, cc = c & 31, ob = rr * 64 + cc * 2; return st * 1024 + (ob ^ (((ob >> 9) & 1) << 5)); }
__host__ __device__ __forceinline__ void stage_rc(int b, int& R, int& C) { const int st = b / 1024, sb = b % 1024, swz = sb ^ (((sb >> 9) & 1) << 5); R = (st >> 1) * 16 + swz / 64; C = (st & 1) * 32 + (swz % 64) / 2; }
__host__ __device__ __forceinline__ int perm32(int rho) { const int n = rho >> 4, i = rho & 15; return 8 * (i >> 2) + 4 * n + (i & 3); }

struct Unit { int pm, pn, po; };
struct Gemm { const void* A; const void* Bt; int ldaB, KB; };

struct StaticOrder {
    int nM, nN, nwg, G, c;
    __device__ void init(int M, int N, int G_, int c_) { nM = M / BM; nN = N / BM; nwg = nM * nN; G = G_; c = c_; }
    __device__ bool next(int i, Unit& u) const {
        const long L = (long)i * G + c; if (L >= nwg) return false;
        int wgid = (int)L; { const int q = nwg / NXCD, r = nwg % NXCD, xcd = wgid % NXCD, off = wgid / NXCD; wgid = (xcd < r ? xcd * (q + 1) : r * (q + 1) + (xcd - r) * q) + off; }
        const int nig = SO_WGM * nN, gid = wgid / nig, fm = gid * SO_WGM, gsz = (nM - fm) < SO_WGM ? (nM - fm) : SO_WGM;
        u.pm = fm + ((wgid % nig) % gsz); u.pn = (wgid % nig) / gsz; u.po = u.pn; return true;
    }
};
struct MoeOrder {
    unsigned p0, p1; int nct, G, c, wgm;
    __device__ void init(const unsigned* cnt, int nct_, int G_, int c_, int wgm_) { wgm = wgm_;
        p0 = 0u; p1 = 0u;
#pragma unroll
        for (int q = 0; q < 4; ++q) { p0 |= ((__hip_atomic_load(cnt + 64 * q, __ATOMIC_RELAXED, __HIP_MEMORY_SCOPE_AGENT) + 255u) >> 8) << (8 * q); p1 |= ((__hip_atomic_load(cnt + 64 * (q + 4), __ATOMIC_RELAXED, __HIP_MEMORY_SCOPE_AGENT) + 255u) >> 8) << (8 * q); }
        nct = nct_; G = G_; c = c_;
    }
    __device__ bool next(int i, Unit& u) const {
        const int L = i * G + c; int cum = 0, tb = 0; bool found = false;
#pragma unroll
        for (int q = 0; q < 8; ++q) { const int rte = (int)(((q < 4 ? p0 : p1) >> (8 * (q & 3))) & 255u); const int n_ = rte * nct;
            if (!found && L < cum + n_) { const int r_ = L - cum, nig = wgm * nct, gid = r_ / nig, fm = gid * wgm, gsz = (rte - fm) < wgm ? (rte - fm) : wgm, rem = r_ - gid * nig;
                u.pm = tb + fm + rem % gsz; u.po = rem / gsz; u.pn = q * nct + u.po; found = true; } cum += n_; tb += rte; }
        return found;
    }
};

__device__ __forceinline__ unsigned cvt_pk_bf16(float lo, float hi) { unsigned r; asm volatile("v_cvt_pk_bf16_f32 %0, %1, %2" : "=v"(r) : "v"(lo), "v"(hi)); return r; }
__device__ __forceinline__ float gelu_tanh(float x) {
    const float u2 = x * (1.5957691216057308f + 0.07135481282599649f * x * x);
    return x * __builtin_amdgcn_rcpf(1.0f + __builtin_amdgcn_exp2f(-1.4426950408889634f * u2));
}
__device__ __forceinline__ float silu_f(float x) { return x * __builtin_amdgcn_rcpf(1.0f + __builtin_amdgcn_exp2f(-1.4426950408889634f * x)); }

struct EpiBf16G {
    static constexpr bool PERM = true;
    bf16_t* O; int ldc; int gelu_tiles; float scale;
    __device__ __forceinline__ void operator()(const f32x4 (&acc)[2][2][4][2], const Unit& u, int wr, int wc, int fr, int fq) const {
        const int row0 = u.pm * BM + wr * 64 + fr, col0 = u.po * BM + wc * 32 + 8 * fq; const bool g = u.po < gelu_tiles;
#pragma unroll
        for (int ai = 0; ai < 2; ++ai)
#pragma unroll
            for (int m = 0; m < 4; ++m) { bf16_t* rowp = O + (size_t)(row0 + ai * HALF + m * 16) * ldc + col0;
#pragma unroll
                for (int bj = 0; bj < 2; ++bj) { f32x4 v0 = acc[ai][bj][m][0] * scale, v1 = acc[ai][bj][m][1] * scale;
                    if (g) { v0 = (f32x4){gelu_tanh(v0[0]), gelu_tanh(v0[1]), gelu_tanh(v0[2]), gelu_tanh(v0[3])}; v1 = (f32x4){gelu_tanh(v1[0]), gelu_tanh(v1[1]), gelu_tanh(v1[2]), gelu_tanh(v1[3])}; }
                    u32x4 w; w.x = cvt_pk_bf16(v0[0], v0[1]); w.y = cvt_pk_bf16(v0[2], v0[3]); w.z = cvt_pk_bf16(v1[0], v1[1]); w.w = cvt_pk_bf16(v1[2], v1[3]);
                    *(u32x4*)(rowp + bj * HALF) = w; } }
    }
};
struct EpiSwiGLU {
    static constexpr bool PERM = true;
    bf16_t* O; int ldc;
    __device__ __forceinline__ void operator()(const f32x4 (&acc)[2][2][4][2], const Unit& u, int wr, int wc, int fr, int fq) const {
        const int row0 = u.pm * BM + wr * 64 + fr, col0 = u.po * HALF + wc * 32 + 8 * fq;
#pragma unroll
        for (int ai = 0; ai < 2; ++ai)
#pragma unroll
            for (int m = 0; m < 4; ++m) { const f32x4 g0 = acc[ai][0][m][0], g1 = acc[ai][0][m][1], u0 = acc[ai][1][m][0], u1 = acc[ai][1][m][1];
                u32x4 w; w.x = cvt_pk_bf16(silu_f(g0[0]) * u0[0], silu_f(g0[1]) * u0[1]); w.y = cvt_pk_bf16(silu_f(g0[2]) * u0[2], silu_f(g0[3]) * u0[3]);
                w.z = cvt_pk_bf16(silu_f(g1[0]) * u1[0], silu_f(g1[1]) * u1[1]); w.w = cvt_pk_bf16(silu_f(g1[2]) * u1[2], silu_f(g1[3]) * u1[3]);
                *(u32x4*)(O + (size_t)(row0 + ai * HALF + m * 16) * ldc + col0) = w; }
    }
};
__device__ __forceinline__ unsigned pk4_fp8(float a, float b, float c, float d) { int w = 0; w = __builtin_amdgcn_cvt_pk_fp8_f32(a, b, w, false); w = __builtin_amdgcn_cvt_pk_fp8_f32(c, d, w, true); return (unsigned)w; }
struct EpiSwiGLU8 {
    static constexpr bool PERM = true;
    unsigned char* O; int ldc; float scale;
    __device__ __forceinline__ void operator()(const f32x4 (&acc)[2][2][4][2], const Unit& u, int wr, int wc, int fr, int fq) const {
        const int row0 = u.pm * BM + wr * 64 + fr, col0 = u.po * HALF + wc * 32 + 8 * fq;
#pragma unroll
        for (int ai = 0; ai < 2; ++ai)
#pragma unroll
            for (int m = 0; m < 4; ++m) { const f32x4 g0 = acc[ai][0][m][0] * scale, g1 = acc[ai][0][m][1] * scale, u0 = acc[ai][1][m][0] * scale, u1 = acc[ai][1][m][1] * scale;
                u32x2 w; w.x = pk4_fp8(silu_f(g0[0]) * u0[0], silu_f(g0[1]) * u0[1], silu_f(g0[2]) * u0[2], silu_f(g0[3]) * u0[3]);
                w.y = pk4_fp8(silu_f(g1[0]) * u1[0], silu_f(g1[1]) * u1[1], silu_f(g1[2]) * u1[2], silu_f(g1[3]) * u1[3]);
                *(u32x2*)(O + (size_t)(row0 + ai * HALF + m * 16) * ldc + col0) = w; }
    }
};
struct EpiNone { static constexpr bool PERM = true;
    __device__ __forceinline__ void operator()(const f32x4 (&acc)[2][2][4][2], const Unit&, int, int, int, int) const {
#pragma unroll
        for (int ai = 0; ai < 2; ++ai)
#pragma unroll
            for (int bj = 0; bj < 2; ++bj)
#pragma unroll
                for (int m = 0; m < 4; ++m)
#pragma unroll
                    for (int n = 0; n < 2; ++n) asm volatile("" :: "v"(acc[ai][bj][m][n])); }
};
template <bool BASE16, bool OUT16>
struct EpiResT {
    static constexpr bool PERM = false;
    const void* base; void* out; const float* gate; float scale;
    __device__ __forceinline__ void operator()(const f32x4 (&acc)[2][2][4][2], const Unit& u, int wr, int wc, int fr, int fq) const {
        const int col0 = u.po * BM + wc * 32 + 4 * fq;
        f32x4 gv[2][2];
#pragma unroll
        for (int bj = 0; bj < 2; ++bj)
#pragma unroll
            for (int n = 0; n < 2; ++n) gv[bj][n] = *(const f32x4*)(gate + col0 + bj * HALF + n * 16) * scale;
#pragma unroll
        for (int ai = 0; ai < 2; ++ai)
#pragma unroll
            for (int m = 0; m < 4; ++m) { const size_t off = (size_t)(u.pm * BM + ai * HALF + wr * 64 + m * 16 + fr) * 1024 + col0;
#pragma unroll
                for (int bj = 0; bj < 2; ++bj)
#pragma unroll
                    for (int n = 0; n < 2; ++n) { const size_t o_ = off + bj * HALF + n * 16; f32x4 bs;
                        if constexpr (BASE16) { const u32x2 w = *(const u32x2*)((const bf16_t*)base + o_); bs = (f32x4){__builtin_bit_cast(float, w.x << 16), __builtin_bit_cast(float, w.x & 0xffff0000u), __builtin_bit_cast(float, w.y << 16), __builtin_bit_cast(float, w.y & 0xffff0000u)}; }
                        else bs = *(const f32x4*)((const float*)base + o_);
                        const f32x4 r = bs + gv[bj][n] * acc[ai][bj][m][n];
                        if constexpr (OUT16) { u32x2 w; w.x = cvt_pk_bf16(r[0], r[1]); w.y = cvt_pk_bf16(r[2], r[3]); *(u32x2*)((bf16_t*)out + o_) = w; }
                        else *(f32x4*)((float*)out + o_) = r; } }
    }
};

template <class Epi, class Sched, bool FP8 = false, bool ALIGN_EPI = true>
__device__ __forceinline__ void gemm_phase(PG8_LAS unsigned char* lds, const Gemm g, const Sched& S, const Epi& E) {
    const int tid = threadIdx.x, wid = __builtin_amdgcn_readfirstlane(tid >> 6), lane = tid & 63, wr = wid >> 2, wc = wid & 3, fr = lane & 15, fq = lane >> 4;
    const int KB = g.KB, nt = KB / (BK * 2), ldaB = g.ldaB;
    unsigned voffA[2], voffB[2];
#pragma unroll
    for (int i = 0; i < 2; ++i) { int R, C; stage_rc(tid * 16 + i * 8192, R, C); const int Rb = Epi::PERM ? ((R & ~31) + perm32(R & 31)) : R;
        voffA[i] = (unsigned)(R * ldaB + C * 2); voffB[i] = (unsigned)(Rb * KB + C * 2); }
    const size_t kstep = (size_t)(BK * 2);
    const size_t hstepA = (size_t)HALF * ldaB, hstepB = (size_t)HALF * KB;
    const size_t tstepA = 2 * hstepA, tstepB = 2 * hstepB;
    const unsigned ldsw = (unsigned)wid * 1024u;
    const int aoff = lds_byte(wr * 64 + fr, fq * 8), boff = lds_byte(wc * 32 + fr, fq * 8);
#define PG8_SA(b, h) (((b) * 2 + (h)) * HTB)
#define PG8_SB(b, h) ((4 + (b) * 2 + (h)) * HTB)
#define PG8_STAGE(bufoff, gbase, voff) do { _Pragma("unroll") for (int _i = 0; _i < 2; ++_i) \
        __builtin_amdgcn_global_load_lds((const unsigned*)((const char*)(gbase) + (voff)[_i]), (PG8_LAS unsigned*)(lds + (bufoff) + ldsw + _i * 8192), 16, 0, 0); } while (0)
#define PG8_RD8(p_) __builtin_shufflevector(*(const PG8_LAS i32x4*)(p_), *(const PG8_LAS i32x4*)((p_) + 1024), 0, 1, 2, 3, 4, 5, 6, 7)
#define PG8_LDA(dst, b, h) do { if constexpr (FP8) { _Pragma("unroll") for (int m = 0; m < 4; ++m) dst##8[m] = PG8_RD8(lds + PG8_SA(b, h) + aoff + m * 2048); } \
        else { _Pragma("unroll") for (int m = 0; m < 4; ++m) _Pragma("unroll") for (int k = 0; k < 2; ++k) dst[m][k] = *(const PG8_LAS bf16x8*)(lds + PG8_SA(b, h) + aoff + m * 2048 + k * 1024); } } while (0)
#define PG8_LDB(dst, b, h) do { if constexpr (FP8) { _Pragma("unroll") for (int n = 0; n < 2; ++n) dst##8[n] = PG8_RD8(lds + PG8_SB(b, h) + boff + n * 2048); } \
        else { _Pragma("unroll") for (int n = 0; n < 2; ++n) _Pragma("unroll") for (int k = 0; k < 2; ++k) dst[n][k] = *(const PG8_LAS bf16x8*)(lds + PG8_SB(b, h) + boff + n * 2048 + k * 1024); } } while (0)
#define PG8_MMA(ai, bj, At, Bt) do { __builtin_amdgcn_s_setprio(1); \
        if constexpr (FP8) { _Pragma("unroll") for (int m = 0; m < 4; ++m) _Pragma("unroll") for (int n = 0; n < 2; ++n) \
            asm volatile("v_mfma_scale_f32_16x16x128_f8f6f4 %0, %1, %2, %0, %3, %3 op_sel_hi:[0,0,0]" : "+v"(acc[ai][bj][m][n]) : "v"(Bt##8[n]), "v"(At##8[m]), "v"(sc7f)); } \
        else { _Pragma("unroll") for (int m = 0; m < 4; ++m) _Pragma("unroll") for (int n = 0; n < 2; ++n) _Pragma("unroll") for (int k = 0; k < 2; ++k) \
            acc[ai][bj][m][n] = __builtin_amdgcn_mfma_f32_16x16x32_bf16(Bt[n][k], At[m][k], acc[ai][bj][m][n], 0, 0, 0); } \
        __builtin_amdgcn_s_setprio(0); } while (0)
#define PG8_WAIT_V(n) asm volatile("s_waitcnt vmcnt(" #n ")" ::: "memory")
#define PG8_WAIT_L(n) asm volatile("s_waitcnt lgkmcnt(" #n ")" ::: "memory")
#define PG8_BAR __builtin_amdgcn_s_barrier()
#define PG8_SCHED __builtin_amdgcn_sched_barrier(0)
    Unit cur, nxt; int ui = 0;
    if (!S.next(0, cur)) return;
    f32x4 acc[2][2][4][2];
#pragma unroll
    for (int a = 0; a < 2; ++a)
#pragma unroll
        for (int b = 0; b < 2; ++b)
#pragma unroll
            for (int m = 0; m < 4; ++m)
#pragma unroll
                for (int n = 0; n < 2; ++n) acc[a][b][m][n] = (f32x4){0.f, 0.f, 0.f, 0.f};
    const int sc7f = 0x7f7f7f7f;
    bf16x8 At[4][2], B0[2][2], B1[2][2]; i32x8 At8[4], B08[2], B18[2];
    const char* cA = (const char*)g.A + (size_t)cur.pm * tstepA; const char* cB = (const char*)g.Bt + (size_t)cur.pn * tstepB;
    PG8_STAGE(PG8_SB(0, 0), cB, voffB); PG8_STAGE(PG8_SB(0, 1), cB + hstepB, voffB); PG8_STAGE(PG8_SA(0, 0), cA, voffA); PG8_STAGE(PG8_SA(0, 1), cA + hstepA, voffA);
    if (wr == 1) PG8_BAR;
    PG8_WAIT_V(2); PG8_BAR;
    PG8_STAGE(PG8_SB(1, 0), cB + kstep, voffB); PG8_STAGE(PG8_SA(1, 0), cA + kstep, voffA); PG8_STAGE(PG8_SB(1, 1), cB + hstepB + kstep, voffB);
    PG8_WAIT_V(6); PG8_BAR;
    for (;;) {
        const bool has_next = S.next(ui + 1, nxt);
        const char* nA = has_next ? (const char*)g.A + (size_t)nxt.pm * tstepA : cA; const char* nB = has_next ? (const char*)g.Bt + (size_t)nxt.pn * tstepB : cB;
#pragma nounroll
        for (int t = 0; t < nt; t += 2) {
            const bool last = (t == nt - 2);
            const char* a1 = cA + (size_t)(t + 1) * kstep;
            const char* a2 = last ? nA : cA + (size_t)(t + 2) * kstep; const char* b2 = last ? nB : cB + (size_t)(t + 2) * kstep;
            const char* a3 = a2 + kstep; const char* b3 = b2 + kstep;
            PG8_LDB(B0, 0, 0); PG8_LDB(B1, 0, 1); PG8_SCHED; PG8_LDA(At, 0, 0); PG8_STAGE(PG8_SA(1, 1), a1 + hstepA, voffA);
            PG8_WAIT_V(8); PG8_WAIT_L(0); PG8_BAR; PG8_MMA(0, 0, At, B0); PG8_MMA(0, 1, At, B1); PG8_BAR; PG8_SCHED;
            PG8_LDA(At, 0, 1); PG8_STAGE(PG8_SB(0, 0), b2, voffB); PG8_STAGE(PG8_SB(0, 1), b2 + hstepB, voffB); PG8_STAGE(PG8_SA(0, 0), a2, voffA);
            PG8_WAIT_V(8); PG8_WAIT_L(0); PG8_BAR; PG8_MMA(1, 0, At, B0); PG8_MMA(1, 1, At, B1); PG8_BAR; PG8_SCHED;
            PG8_LDB(B0, 1, 0); PG8_LDB(B1, 1, 1); PG8_SCHED; PG8_LDA(At, 1, 0); PG8_STAGE(PG8_SA(0, 1), a2 + hstepA, voffA);
            PG8_WAIT_V(8); PG8_WAIT_L(0); PG8_BAR; PG8_MMA(0, 0, At, B0); PG8_MMA(0, 1, At, B1); PG8_BAR; PG8_SCHED;
            PG8_LDA(At, 1, 1); PG8_STAGE(PG8_SB(1, 0), b3, voffB); PG8_STAGE(PG8_SB(1, 1), b3 + hstepB, voffB); PG8_STAGE(PG8_SA(1, 0), a3, voffA);
            PG8_WAIT_V(8); PG8_WAIT_L(0); PG8_BAR; PG8_MMA(1, 0, At, B0); PG8_MMA(1, 1, At, B1); PG8_BAR; PG8_SCHED;
        }
        if constexpr (ALIGN_EPI) { if (wr == 0) PG8_BAR; }
        if constexpr (FP8) asm volatile("s_nop 15\n\ts_nop 15" ::: "memory");
        E(acc, cur, wr, wc, fr, fq);
        if constexpr (FP8 && DBG_EPI2) { asm volatile("" ::: "memory"); E(acc, cur, wr, wc, fr, fq); }
        if (!has_next) break;
#pragma unroll
        for (int a = 0; a < 2; ++a)
#pragma unroll
            for (int b = 0; b < 2; ++b)
#pragma unroll
                for (int m = 0; m < 4; ++m)
#pragma unroll
                    for (int n = 0; n < 2; ++n) acc[a][b][m][n] = (f32x4){0.f, 0.f, 0.f, 0.f};
        cur = nxt; cA = nA; cB = nB; ++ui;
        if constexpr (ALIGN_EPI) { if (wr == 1) PG8_BAR; }
    }
    PG8_WAIT_V(0);
    if constexpr (!ALIGN_EPI) { if (wr == 0) PG8_BAR; }
    PG8_BAR;
#undef PG8_SA
#undef PG8_SB
#undef PG8_STAGE
#undef PG8_LDA
#undef PG8_LDB
#undef PG8_MMA
#undef PG8_RD8
#undef PG8_WAIT_V
#undef PG8_WAIT_L
#undef PG8_BAR
#undef PG8_SCHED
}
}

constexpr int NWAVES = 8, NTHR = 512;
constexpr int S = 16384, D = 1024;
constexpr int E_IN = 1536, D_FF = 2816, O_IN = 2112, O_INP = 2304, NE = 8, DFE = 3584;
constexpr int MOE_ROWS = 34816;
constexpr float EPS = 1e-6f;
constexpr float MOE_WSCALE = 64.f;

constexpr size_t MiB = 1u << 20;
constexpr size_t WS_CTL = 0, CTL_ZERO_BYTES = 1 * MiB;
constexpr size_t WS_MODP = 1 * MiB, WS_MODF = 2 * MiB, WS_ROPE = 3 * MiB;
constexpr size_t WS_TOK = 7 * MiB;
constexpr size_t WS_WIN0 = 8 * MiB, WS_WOUT0 = 11 * MiB, WS_WGU0 = 13 * MiB, WS_WD0 = 24 * MiB, WS_WIN1 = 30 * MiB;
constexpr size_t WS_WUQ = 35 * MiB, WS_WUKV = WS_WUQ + MiB / 2, WS_WOUT1 = 36 * MiB, WS_WTRIL = 38 * MiB, WS_WGT = WS_WTRIL + 131072;
constexpr size_t WS_WGUM = 40 * MiB, WS_WDM = 152 * MiB;
constexpr size_t WS_ABUF = 208 * MiB, WS_MIX = 240 * MiB, WS_XR = 272 * MiB, WS_AMOE = 336 * MiB  , WS_BIG = 404 * MiB;
constexpr size_t WS_P0 = WS_BIG, WS_H = WS_BIG + 48 * MiB;
constexpr size_t WS_P1 = WS_BIG, WS_QR = WS_BIG + 72 * MiB, WS_KVR = WS_BIG + 104 * MiB, WS_QF = WS_BIG + 136 * MiB, WS_KIMG = WS_BIG + 160 * MiB, WS_VIMG = WS_BIG + 184 * MiB;
constexpr size_t WS_PART = WS_BIG + 200 * MiB, WS_PML = WS_BIG + 232 * MiB;
constexpr size_t WS_HM = WS_BIG;
constexpr size_t WS_XRB = 660 * MiB;
constexpr size_t WS_END = 692 * MiB;
static_assert(WS_H + (size_t)S * D_FF * 2 <= WS_END && WS_VIMG + 16 * MiB <= WS_END && WS_HM + (size_t)MOE_ROWS * DFE * 2 <= WS_END, "big region");
static_assert(WS_AMOE + (size_t)MOE_ROWS * D * 2 <= WS_BIG && WS_WDM + (size_t)NE * D * DFE * 2 <= WS_ABUF && WS_WGUM + (size_t)NE * 2 * DFE * D * 2 <= WS_WDM, "map");
constexpr int CW_BAR = 4096;
constexpr int CW_CNT = 16384;
constexpr int CW_Q = 17408;
constexpr int CW_XRANK = 20480;
constexpr int CW_GD = 17472;

constexpr int RING_BYTES = 131072, LDSCTL_OFF = RING_BYTES, MISC_OFF = LDSCTL_OFF + 320, LDS_BYTES = 147456;

#define GAS __attribute__((address_space(1)))
#define LAS __attribute__((address_space(3)))
typedef unsigned short bf16;
typedef unsigned v4u __attribute__((ext_vector_type(4)));
typedef unsigned v2u __attribute__((ext_vector_type(2)));
typedef float f32x4 __attribute__((ext_vector_type(4)));
typedef float f32x16 __attribute__((ext_vector_type(16)));
typedef short bf16x8 __attribute__((ext_vector_type(8)));
typedef short s16x4 __attribute__((ext_vector_type(4)));
typedef GAS unsigned gu32;
#define RLX_AGENT __ATOMIC_RELAXED, __HIP_MEMORY_SCOPE_AGENT
#define LDS_WAIT() asm volatile("s_waitcnt lgkmcnt(0)" ::: "memory")
#define VM_WAIT() asm volatile("s_waitcnt vmcnt(0)" ::: "memory")
__device__ __forceinline__ unsigned f2bf(float f) { unsigned u = __builtin_bit_cast(unsigned, f); return (u + 0x7fffu + ((u >> 16) & 1u)) >> 16; }
__device__ __forceinline__ unsigned pk2(float lo, float hi) { return f2bf(lo) | (f2bf(hi) << 16); }
__device__ __forceinline__ float bflo(unsigned w) { return __builtin_bit_cast(float, w << 16); }
__device__ __forceinline__ float bfhi(unsigned w) { return __builtin_bit_cast(float, w & 0xffff0000u); }
__device__ __forceinline__ float wave_sum(float v) {
#pragma unroll
    for (int o = 1; o < 64; o <<= 1) v += __shfl_xor(v, o);
    return v;
}

#define XB_TMO      128
#define XB_XCNT(j)  (256  + 64 * (j))
#define XB_XSUB(j)  (1280 + 64 * (j))
#define XB_XGEN(j)  (2304 + 64 * (j))
#define XB_TOP      3328
#define XB_TOPGEN   3392
#define XCD_BAR_WORDS 3456
#define XB_SPIN_CAP (1u << 18)
__device__ __forceinline__ unsigned xb_ld(unsigned* p)              { return __hip_atomic_load(p, __ATOMIC_RELAXED, __HIP_MEMORY_SCOPE_AGENT); }
__device__ __forceinline__ unsigned xb_add(unsigned* p, unsigned v) { return __hip_atomic_fetch_add(p, v, __ATOMIC_RELAXED, __HIP_MEMORY_SCOPE_AGENT); }
__device__ __forceinline__ unsigned xb_xcc_id() { return (unsigned)__builtin_amdgcn_s_getreg((3 << 11) | 20) & 0xFu; }
#define XB_SPIN(cond, bar) do { unsigned _sp = 0; while (cond) { __builtin_amdgcn_s_sleep(1); \
    if ((++_sp & 255u) == 0u) { if (xb_ld(&(bar)[XB_TMO])) break; if (_sp > XB_SPIN_CAP) { atomicAdd(&(bar)[XB_TMO], 1u); break; } } } } while (0)
struct XcdBarrier { unsigned* bar; unsigned x; volatile LAS unsigned* st; };
__device__ __forceinline__ XcdBarrier xcd_barrier_post(unsigned* bar, volatile LAS unsigned* st) {
    XcdBarrier b; b.bar = bar; b.x = xb_xcc_id(); b.st = st;
    if (threadIdx.x == 0) (void)xb_add(&bar[XB_XCNT(b.x)], 1u);
    return b;
}
__device__ __forceinline__ void xcd_barrier_complete(unsigned* bar, unsigned x, unsigned& nloc, unsigned& nx) {
    const unsigned G = gridDim.x * gridDim.y * gridDim.z;
    unsigned sum, cnt, mine, sp = 0u;
    for (;;) {
        sum = 0u; cnt = 0u; mine = 0u;
#pragma unroll
        for (unsigned j = 0; j < 16; ++j) { const unsigned c = xb_ld(&bar[XB_XCNT(j)]); sum += c; cnt += (c > 0u) ? 1u : 0u; mine = (j == x) ? c : mine; }
        if (sum == G) break;
        __builtin_amdgcn_s_sleep(1);
        if ((++sp & 255u) == 0u) { if (xb_ld(&bar[XB_TMO])) break; if (sp > XB_SPIN_CAP) { atomicAdd(&bar[XB_TMO], 1u); break; } }
    }
    nloc = mine > 0u ? mine : 1u; nx = cnt > 0u ? cnt : 1u;
}
__device__ __forceinline__ void xcd_barrier(const XcdBarrier& b) {
    asm volatile("s_waitcnt vmcnt(0)" ::: "memory");
    __syncthreads();
    if (threadIdx.x == 0) {
        unsigned* bar = b.bar;
        __builtin_amdgcn_s_waitcnt(0);
        unsigned nloc = b.st[0], nx = b.st[1];
        if (nloc == 0u) { xcd_barrier_complete(bar, b.x, nloc, nx); b.st[0] = nloc; b.st[1] = nx; }
        const unsigned old = xb_add(&bar[XB_XSUB(b.x)], 1u);
        const unsigned gen = old / nloc;
        if (old + 1u == (gen + 1u) * nloc) {
            __builtin_amdgcn_fence(__ATOMIC_RELEASE, "agent");
            asm volatile("s_waitcnt vmcnt(0)" ::: "memory");
            const unsigned og = xb_add(&bar[XB_TOP], 1u);
            const unsigned tg = og / nx;
            if (og + 1u == (tg + 1u) * nx) xb_add(&bar[XB_TOPGEN], 1u);
            else XB_SPIN(xb_ld(&bar[XB_TOPGEN]) == tg, bar);
            __builtin_amdgcn_fence(__ATOMIC_ACQUIRE, "agent");
            xb_add(&bar[XB_XGEN(b.x)], 1u);
            asm volatile("s_waitcnt vmcnt(0)" ::: "memory");
        } else {
            XB_SPIN(xb_ld(&bar[XB_XGEN(b.x)]) == gen, bar);
            __builtin_amdgcn_fence(__ATOMIC_ACQUIRE, "agent");
            asm volatile("s_waitcnt vmcnt(0)" ::: "memory");
        }
    }
    __syncthreads();
}

struct Args { const void* in[29]; float* out; unsigned char* ws; int ph_lo, ph_hi; };
enum { I_X = 0, I_C, I_POS, I_NMW, I_NFW, I_ADAW, I_ADAB, I_EWIN, I_ALNW, I_ALNB, I_AWS, I_ABS, I_BWG, I_BSC, I_EWOUT, I_FGU, I_FDN,
       I_OWIN, I_CONV, I_QAN, I_WUQ, I_KVN, I_WUKV, I_QNW, I_KNW, I_OWOUT, I_RW, I_MGU, I_MDN };
constexpr int OFF_SHM = 0, OFF_SCM = 1024, OFF_GM = 2048, OFF_SHF = 3072, OFF_SCF = 4096, OFF_GF = 5120;

__device__ __forceinline__ void p0_mod(const float* c, const float* ada_w, float* modp, int vcu, int G, int tid) {
    for (int u = vcu; u < 384; u += G) {
        const int layer = u / 192, r = u % 192, ks = r / 12, cb = r % 12, col = cb * 512 + tid;
        const float* w = ada_w + ((size_t)layer * 1024 + ks * 64) * 6144 + col;
        float acc = 0.f;
#pragma unroll 8
        for (int k = 0; k < 64; ++k) { const float cv = c[ks * 64 + k]; const float sv = cv / (1.f + __expf(-cv)); acc += sv * w[(size_t)k * 6144]; }
        modp[(size_t)(layer * 16 + ks) * 6144 + col] = acc;
    }
}
__device__ __forceinline__ void conv_item(const float* src, int ldn, int k0, int n0, const float* kscale, bf16* dst, int ldk, int drow0, LAS float* scr, int lane) {
#pragma unroll
    for (int i = 0; i < 8; ++i) { const int kk = 8 * i + (lane >> 3); f32x4 v = *(const f32x4*)(src + (size_t)(k0 + kk) * ldn + n0 + (lane & 7) * 4);
        if (kscale) v = v * kscale[k0 + kk];
        LAS float* p = scr + kk * 33 + (lane & 7) * 4; p[0] = v.x; p[1] = v.y; p[2] = v.z; p[3] = v.w; }
    LDS_WAIT(); asm volatile("" ::: "memory");
    const int c = lane & 7;
#pragma unroll
    for (int j = 0; j < 4; ++j) { const int nn = (lane >> 3) + 8 * j; const LAS float* s = scr + (8 * c) * 33 + nn;
        v4u o; o.x = pk2(s[0 * 33], s[1 * 33]); o.y = pk2(s[2 * 33], s[3 * 33]); o.z = pk2(s[4 * 33], s[5 * 33]); o.w = pk2(s[6 * 33], s[7 * 33]);
        *(v4u*)(dst + (size_t)(drow0 + nn) * ldk + k0 + 8 * c) = o; }
    LDS_WAIT(); asm volatile("" ::: "memory");
}
__device__ __forceinline__ void conv_item8(const float* src, int ldn, int k0, int n0, float scale, unsigned char* dst, int ldkB, int drow0, LAS float* scr, int lane) {
#pragma unroll
    for (int i = 0; i < 8; ++i) { const int kk = 8 * i + (lane >> 3); const f32x4 v = *(const f32x4*)(src + (size_t)(k0 + kk) * ldn + n0 + (lane & 7) * 4) * scale;
        LAS float* p = scr + kk * 33 + (lane & 7) * 4; p[0] = v.x; p[1] = v.y; p[2] = v.z; p[3] = v.w; }
    LDS_WAIT(); asm volatile("" ::: "memory");
    const int c = lane & 7;
#pragma unroll
    for (int j = 0; j < 4; ++j) { const int nn = (lane >> 3) + 8 * j; const LAS float* s = scr + (8 * c) * 33 + nn;
        v2u o; o.x = pg8::pk4_fp8(s[0 * 33], s[1 * 33], s[2 * 33], s[3 * 33]); o.y = pg8::pk4_fp8(s[4 * 33], s[5 * 33], s[6 * 33], s[7 * 33]);
        *(v2u*)(dst + (size_t)(drow0 + nn) * ldkB + k0 + 8 * c) = o; }
    LDS_WAIT(); asm volatile("" ::: "memory");
}
__device__ __forceinline__ int gu_row(int n0, int half) { return n0 < half ? (n0 >> 7) * 256 + (n0 & 127) : ((n0 - half) >> 7) * 256 + 128 + ((n0 - half) & 127); }
constexpr int LATE_GU = 8 * 16 * 224, LATE_DN = 8 * 56 * 32, N_LATE = LATE_GU + LATE_DN, LATE_CHUNK = 16;
__device__ __forceinline__ void conv_late_item(const Args& a, int r, LAS float* scr, int lane) {
    unsigned char* ws = a.ws;
    if (r < LATE_GU) { const int e = r / (16 * 224), q = r % (16 * 224), kb = q / 224, nb = q % 224;
        conv_item8((const float*)a.in[I_MGU] + (size_t)e * 1024 * 7168, 7168, kb * 64, nb * 32, MOE_WSCALE, ws + WS_WGUM + (size_t)e * 7168 * 1024, 1024, gu_row(nb * 32, DFE), scr, lane); }
    else { r -= LATE_GU; const int e = r / (56 * 32), q = r % (56 * 32), kb = q / 32, nb = q % 32;
        conv_item8((const float*)a.in[I_MDN] + (size_t)e * DFE * 1024, 1024, kb * 64, nb * 32, MOE_WSCALE, ws + WS_WDM + (size_t)e * 1024 * DFE, DFE, nb * 32, scr, lane); }
}
__device__ __forceinline__ void conv_fill(const Args& a, LAS unsigned char* lds, unsigned* gdone, int G, int tid) {
    unsigned* qhead = (unsigned*)(a.ws + WS_CTL) + CW_Q; const int lane = tid & 63, wave = __builtin_amdgcn_readfirstlane(tid >> 6);
    LAS float* scr = (LAS float*)(lds + wave * 16384); volatile LAS int* qb = (volatile LAS int*)(lds + 131056);
    __syncthreads();
    if (gdone && tid == 0) (void)__hip_atomic_fetch_add(gdone, 1u, RLX_AGENT);
    for (;;) {
        if (tid == 0) { int v = -1;
            if (!gdone || __hip_atomic_load(gdone, RLX_AGENT) < (unsigned)G) { v = (int)__hip_atomic_fetch_add(qhead, (unsigned)LATE_CHUNK, RLX_AGENT); if (v >= N_LATE) v = -1; }
            *qb = v; }
        __syncthreads();
        const int base = *qb;
        __syncthreads();
        if (base < 0) break;
        for (int it = base + wave; it < base + LATE_CHUNK && it < N_LATE; it += NWAVES) conv_late_item(a, it, scr, lane);
    }
}
__device__ __forceinline__ void p0_prologue(const Args& a, LAS unsigned char* lds, int vcu, int G, int tid) {
    unsigned char* ws = a.ws; const int lane = tid & 63, wave = __builtin_amdgcn_readfirstlane(tid >> 6);
    p0_mod((const float*)a.in[I_C], (const float*)a.in[I_ADAW], (float*)(ws + WS_MODP), vcu, G, tid);
    const int gt = vcu * NTHR + tid, NGT = G * NTHR;
    { const int* pos = (const int*)a.in[I_POS]; float* cosT = (float*)(ws + WS_ROPE); float* sinT = cosT + (size_t)S * 32;
      for (int i = gt; i < S * 32; i += NGT) { const int t = i >> 5, f = i & 31; const float inv = (float)exp(-(double)f * (9.210340371976184 / 32.0));
          const float ang = (float)pos[t] * inv; const double ad = (double)ang;
          const double k = __builtin_rint(ad * 0.15915494309189535); const double r = __builtin_fma(-k, 6.283185307179586, ad) - k * 2.4492935982947064e-16;
          cosT[i] = cosf((float)r); sinT[i] = sinf((float)r); } }
    { const float* aws = (const float*)a.in[I_AWS]; bf16* wt = (bf16*)(ws + WS_WTRIL);
      for (int i = gt; i < 4 * 128 * 128 / 2; i += NGT) { const int e = 2 * i, s = e & 127, t = (e >> 7) & 127; const float v0 = s <= t ? aws[e] : 0.f, v1 = (s + 1) <= t ? aws[e + 1] : 0.f; ((unsigned*)wt)[i] = pk2(v0, v1); } }
    { v4u z = {0u, 0u, 0u, 0u}; v4u* p1 = (v4u*)(ws + WS_WIN1 + (size_t)O_IN * 1024 * 2);
      for (int i = gt; i < (O_INP - O_IN) * 1024 * 2 / 16; i += NGT) p1[i] = z;
      for (int i = gt; i < 4 * 64 * 256 * 2 / 16; i += NGT) { const int h = i / (64 * 32), r = i % (64 * 32); ((v4u*)(ws + WS_WUQ + (size_t)(h * 256 + 192) * 256 * 2))[r] = z; } }
    LAS float* scr = (LAS float*)(lds + wave * 16384);
    const int gw = vcu * NWAVES + wave, NGW = G * NWAVES;
    constexpr int I0 = 16 * 48, I1 = 16 * 32, I2 = 16 * 176, I3 = 44 * 32, I4 = 16 * 66, I5 = 4 * 24, I6 = 4 * 32, I7 = 16 * 32, I8 = 4 * 8;
    constexpr int NITEMS = I0 + I1 + I2 + I3 + I4 + I5 + I6 + I7 + I8;
    for (int it = gw; it < NITEMS; it += NGW) {
        int r = it;
        if (r < I0) { conv_item((const float*)a.in[I_EWIN], E_IN, (r / 48) * 64, (r % 48) * 32, nullptr, (bf16*)(ws + WS_WIN0), 1024, (r % 48) * 32, scr, lane); continue; } r -= I0;
        if (r < I1) { conv_item((const float*)a.in[I_EWOUT], 1024, (r / 32) * 64, (r % 32) * 32, nullptr, (bf16*)(ws + WS_WOUT0), 1024, (r % 32) * 32, scr, lane); continue; } r -= I1;
#if FFN_FP8
        if (r < I2) { conv_item8((const float*)a.in[I_FGU], 2 * D_FF, (r / 176) * 64, (r % 176) * 32, MOE_WSCALE, ws + WS_WGU0, 1024, gu_row((r % 176) * 32, D_FF), scr, lane); continue; } r -= I2;
        if (r < I3) { conv_item8((const float*)a.in[I_FDN], 1024, (r / 32) * 64, (r % 32) * 32, MOE_WSCALE, ws + WS_WD0, D_FF, (r % 32) * 32, scr, lane); continue; } r -= I3;
#else
        if (r < I2) { conv_item((const float*)a.in[I_FGU], 2 * D_FF, (r / 176) * 64, (r % 176) * 32, nullptr, (bf16*)(ws + WS_WGU0), 1024, gu_row((r % 176) * 32, D_FF), scr, lane); continue; } r -= I2;
        if (r < I3) { conv_item((const float*)a.in[I_FDN], 1024, (r / 32) * 64, (r % 32) * 32, nullptr, (bf16*)(ws + WS_WD0), D_FF, (r % 32) * 32, scr, lane); continue; } r -= I3;
#endif
        if (r < I4) { conv_item((const float*)a.in[I_OWIN], O_IN, (r / 66) * 64, (r % 66) * 32, nullptr, (bf16*)(ws + WS_WIN1), 1024, (r % 66) * 32, scr, lane); continue; } r -= I4;
        if (r < I5) { const int n0 = (r % 24) * 32; conv_item((const float*)a.in[I_WUQ], 768, (r / 24) * 64, n0, (const float*)a.in[I_QAN], (bf16*)(ws + WS_WUQ), 256, (n0 / 192) * 256 + n0 % 192, scr, lane); continue; } r -= I5;
        if (r < I6) { conv_item((const float*)a.in[I_WUKV], 1024, (r / 32) * 64, (r % 32) * 32, (const float*)a.in[I_KVN], (bf16*)(ws + WS_WUKV), 256, (r % 32) * 32, scr, lane); continue; } r -= I6;
        if (r < I7) { conv_item((const float*)a.in[I_OWOUT], 1024, (r / 32) * 64, (r % 32) * 32, nullptr, (bf16*)(ws + WS_WOUT1), 1024, (r % 32) * 32, scr, lane); continue; } r -= I7;
        { const int g = r / 8, q = r % 8; conv_item((const float*)a.in[I_BWG] + (size_t)g * 16384, 128, (q / 4) * 64, (q % 4) * 32, nullptr, (bf16*)(ws + WS_WGT) + (size_t)g * 16384, 128, (q % 4) * 32, scr, lane); }
    }
}

__device__ __forceinline__ float modv_partial(const float* modp, const float* ada_b, int layer, int idx) {
    float s = ada_b[layer * 6144 + idx];
#pragma unroll
    for (int ks = 0; ks < 16; ++ks) s += modp[(size_t)(layer * 16 + ks) * 6144 + idx];
    return s;
}
template <bool PARTIAL, bool OUT8 = false, bool IN16 = false>
__device__ __forceinline__ void norm_phase(const Args& a, const void* xin_, bf16* out, const float* nw, int layer, int off_sh, int off_sc, int gw, int NGW, int lane, LAS float* lmod = nullptr) {
    const float* modp = (const float*)(a.ws + WS_MODP); const float* modF = (const float*)(a.ws + WS_MODF); const float* ada_b = (const float*)a.in[I_ADAB];
    if (PARTIAL) {
        for (int i = threadIdx.x; i < 2048; i += NTHR) lmod[i] = modv_partial(modp, ada_b, layer, (i < 1024 ? off_sc : off_sh - 1024) + i);
        __syncthreads();
    }
    f32x4 g[4], sh[4];
#pragma unroll
    for (int j = 0; j < 4; ++j)
#pragma unroll
        for (int e = 0; e < 4; ++e) { const int col = 4 * lane + e + 256 * j; float scv, shv;
            if (PARTIAL) { scv = lmod[col]; shv = lmod[1024 + col]; }
            else { scv = modF[layer * 6144 + off_sc + col]; shv = modF[layer * 6144 + off_sh + col]; }
            g[j][e] = nw[col] * (1.f + scv); sh[j][e] = shv; }
    for (int m = gw; m < S; m += NGW) {
        f32x4 v[4]; float s = 0.f;
        if constexpr (IN16) { const v2u* xr = (const v2u*)((const bf16*)xin_ + (size_t)m * D) + lane;
#pragma unroll
            for (int j = 0; j < 4; ++j) { const v2u w = xr[64 * j]; v[j] = (f32x4){bflo(w.x), bfhi(w.x), bflo(w.y), bfhi(w.y)}; } }
        else { const f32x4* xr = (const f32x4*)((const float*)xin_ + (size_t)m * D) + lane;
#pragma unroll
            for (int j = 0; j < 4; ++j) v[j] = xr[64 * j]; }
#pragma unroll
        for (int j = 0; j < 4; ++j) s += (v[j].x * v[j].x + v[j].y * v[j].y) + (v[j].z * v[j].z + v[j].w * v[j].w);
        const float rstd = 1.f / sqrtf(wave_sum(s) * (1.f / D) + EPS);
        if constexpr (OUT8) { unsigned* o4 = (unsigned*)((unsigned char*)out + (size_t)m * D) + lane;
#pragma unroll
            for (int j = 0; j < 4; ++j) { const f32x4 y = v[j] * rstd * g[j] + sh[j]; o4[64 * j] = pg8::pk4_fp8(y.x, y.y, y.z, y.w); } }
        else { unsigned long long* o8 = (unsigned long long*)(out + (size_t)m * D) + lane;
#pragma unroll
            for (int j = 0; j < 4; ++j) { const f32x4 y = v[j] * rstd * g[j] + sh[j]; o8[64 * j] = (unsigned long long)pk2(y.x, y.y) | ((unsigned long long)pk2(y.z, y.w) << 32); } }
    }
}

__device__ __forceinline__ void mixab_phase(const Args& a, LAS unsigned char* lds, int vcu, int G, int tid) {
    const bf16* P0 = (const bf16*)(a.ws + WS_P0); bf16* MIX = (bf16*)(a.ws + WS_MIX);
    const bf16* Wtril = (const bf16*)(a.ws + WS_WTRIL); const bf16* wgT = (const bf16*)(a.ws + WS_WGT);
    const float* ln_w = (const float*)a.in[I_ALNW]; const float* ln_b = (const float*)a.in[I_ALNB]; const float* b_s = (const float*)a.in[I_ABS]; const float* b_sc = (const float*)a.in[I_BSC];
    const int lane = tid & 63, wave = __builtin_amdgcn_readfirstlane(tid >> 6), fr = lane & 15, fq = lane >> 4;
    LAS bf16* vnT = (LAS bf16*)lds;
    LAS bf16* poolS = (LAS bf16*)(lds + 34816);
    LAS bf16* ppS = (LAS bf16*)(lds + 69632);
    LAS float* stat = (LAS float*)(lds + 69632 + 39168);
    for (int u = vcu; u < 512; u += G) {
        const int n = u >> 2, g = u & 3, t0 = n * 128;
        v4u rawv[16];
#pragma unroll
        for (int rr = 0; rr < 16; ++rr) rawv[rr] = *(const v4u*)(P0 + (size_t)(t0 + wave * 16 + rr) * E_IN + 512 + lane * 8);
#pragma unroll
        for (int rr = 0; rr < 16; ++rr) { const int row = wave * 16 + rr;
            const v4u raw = rawv[rr];
            float x[8] = {bflo(raw.x), bfhi(raw.x), bflo(raw.y), bfhi(raw.y), bflo(raw.z), bfhi(raw.z), bflo(raw.w), bfhi(raw.w)};
            float s = 0.f;
#pragma unroll
            for (int j = 0; j < 8; ++j) s += x[j];
            const float mu = wave_sum(s) * (1.f / 512.f); float q = 0.f;
#pragma unroll
            for (int j = 0; j < 8; ++j) { const float d = x[j] - mu; q += d * d; }
            const float rstd = 1.f / sqrtf(wave_sum(q) * (1.f / 512.f) + EPS);
            if (lane == 0) { stat[row * 2] = mu; stat[row * 2 + 1] = rstd; } }
        for (int i = tid; i < 144 * 16; i += NTHR) { const int r = i >> 4, c8 = i & 15, t = t0 - 16 + r; v4u v = {0u, 0u, 0u, 0u};
            if (t >= 0) v = *(const v4u*)(P0 + (size_t)t * E_IN + 1024 + g * 128 + c8 * 8);
            *(LAS v4u*)(ppS + r * 136 + c8 * 8) = v; }
        __syncthreads();
        { const int s = tid & 127, dq = tid >> 7; const float mu = stat[s * 2], rstd = stat[s * 2 + 1];
#pragma unroll
          for (int cc = 0; cc < 4; ++cc) { const int d0 = dq * 32 + cc * 8; const v4u raw = *(const v4u*)(P0 + (size_t)(t0 + s) * E_IN + 512 + g * 128 + d0);
              float x[8] = {bflo(raw.x), bfhi(raw.x), bflo(raw.y), bfhi(raw.y), bflo(raw.z), bfhi(raw.z), bflo(raw.w), bfhi(raw.w)};
#pragma unroll
              for (int j = 0; j < 8; ++j) { const int ch = g * 128 + d0 + j; vnT[(d0 + j) * 136 + s] = (bf16)f2bf((x[j] - mu) * rstd * ln_w[ch] + ln_b[ch]); } } }
        { const int t = tid & 127, q4 = tid >> 7, w = 2 << g, tg = t0 + t; const float inv = 1.f / (float)((tg + 1) < w ? (tg + 1) : w);
#pragma unroll
          for (int cc = 0; cc < 4; ++cc) { const int ch = q4 * 32 + cc * 8; float acc[8] = {0.f, 0.f, 0.f, 0.f, 0.f, 0.f, 0.f, 0.f};
              for (int j = 0; j < w; ++j) { const v4u r = *(const LAS v4u*)(ppS + (16 + t - j) * 136 + ch);
                  acc[0] += bflo(r.x); acc[1] += bfhi(r.x); acc[2] += bflo(r.y); acc[3] += bfhi(r.y); acc[4] += bflo(r.z); acc[5] += bfhi(r.z); acc[6] += bflo(r.w); acc[7] += bfhi(r.w); }
              const v4u c0 = *(const LAS v4u*)(ppS + (16 + t) * 136 + ch);
              v4u o; o.x = pk2(acc[0] * inv - bflo(c0.x), acc[1] * inv - bfhi(c0.x)); o.y = pk2(acc[2] * inv - bflo(c0.y), acc[3] * inv - bfhi(c0.y));
              o.z = pk2(acc[4] * inv - bflo(c0.z), acc[5] * inv - bfhi(c0.z)); o.w = pk2(acc[6] * inv - bflo(c0.w), acc[7] * inv - bfhi(c0.w));
              *(LAS v4u*)(poolS + t * 136 + ch) = o; } }
        __syncthreads();
        const int m0 = wave * 16, trow = t0 + m0 + fr;
        f32x4 acc[8];
#pragma unroll
        for (int nb = 0; nb < 8; ++nb) acc[nb] = (f32x4){0.f, 0.f, 0.f, 0.f};
#pragma unroll
        for (int kk = 0; kk < 4; ++kk) { const bf16x8 af = *(const bf16x8*)(Wtril + ((size_t)g * 128 + m0 + fr) * 128 + kk * 32 + fq * 8);
#pragma unroll
            for (int nb = 0; nb < 8; ++nb) { const bf16x8 bfr = *(const LAS bf16x8*)(vnT + (nb * 16 + fr) * 136 + kk * 32 + fq * 8); acc[nb] = __builtin_amdgcn_mfma_f32_16x16x32_bf16(bfr, af, acc[nb], 0, 0, 0); } }
        { const float bias = b_s[g * 128 + m0 + fr];
#pragma unroll
          for (int nb = 0; nb < 8; ++nb) { const int col = g * 128 + nb * 16 + 4 * fq; const v2u uv = *(const v2u*)(P0 + (size_t)trow * E_IN + col);
              v2u o; o.x = pk2(bflo(uv.x) * (acc[nb][0] + bias), bfhi(uv.x) * (acc[nb][1] + bias)); o.y = pk2(bflo(uv.y) * (acc[nb][2] + bias), bfhi(uv.y) * (acc[nb][3] + bias));
              *(v2u*)(MIX + (size_t)trow * D + col) = o; } }
#pragma unroll
        for (int nb = 0; nb < 8; ++nb) acc[nb] = (f32x4){0.f, 0.f, 0.f, 0.f};
#pragma unroll
        for (int kk = 0; kk < 4; ++kk) { const bf16x8 af = *(const LAS bf16x8*)(poolS + (m0 + fr) * 136 + kk * 32 + fq * 8);
#pragma unroll
            for (int nb = 0; nb < 8; ++nb) { const bf16x8 bfr = *(const bf16x8*)(wgT + ((size_t)g * 128 + nb * 16 + fr) * 128 + kk * 32 + fq * 8); acc[nb] = __builtin_amdgcn_mfma_f32_16x16x32_bf16(bfr, af, acc[nb], 0, 0, 0); } }
#pragma unroll
        for (int nb = 0; nb < 8; ++nb) { const int e = g * 128 + nb * 16 + 4 * fq; const f32x4 sc = *(const f32x4*)(b_sc + e);
            v2u o; o.x = pk2(acc[nb][0] * sc.x, acc[nb][1] * sc.y); o.y = pk2(acc[nb][2] * sc.z, acc[nb][3] * sc.w);
            *(v2u*)(MIX + (size_t)trow * D + 512 + e) = o; }
        __syncthreads();
    }
}

namespace att {
constexpr int KSLOT = 24576, VSLOT = 16384, NSLOT = 3, LDS_K = 0, LDS_V = NSLOT * KSLOT, LDS_WS = LDS_V + NSLOT * VSLOT;
constexpr float SCALE = 0.07216878364870323f;
constexpr float THR = 8.f;
__device__ __forceinline__ int k_nope_off(int row, int colB) { return row * 256 + (colB ^ ((row & 7) << 4)); }
__device__ __forceinline__ int k_rope_off(int row, int cB) { return 16384 + row * 128 + (cB ^ (((row >> 1) & 7) << 4)); }
__device__ __forceinline__ int v_st(int k, int c) { const int kk = (k & ~0xC) | ((k & 4) << 1) | ((k & 8) >> 1); return ((kk >> 3) * 4 + (c >> 5)) * 512 + ((kk & 7) * 32 + (c & 31)) * 2; }
__device__ __forceinline__ int v_rd_base(int lane) { return ((lane & 3) << 3) | (((lane >> 2) & 3) << 6) | (((lane >> 4) & 1) << 5) | (((lane >> 5) & 1) << 8); }
constexpr int v_rd_off(int d0, int ks, int half) { return d0 * 512 + ks * 4096 + half * 2048; }
__device__ __forceinline__ int crow(int r, int hi) { return (r & 3) + 8 * (r >> 2) + 4 * hi; }
__device__ __forceinline__ unsigned cvtpk(float lo, float hi) { unsigned r; asm volatile("v_cvt_pk_bf16_f32 %0, %1, %2" : "=v"(r) : "v"(lo), "v"(hi)); return r; }
#define SBAR() __builtin_amdgcn_sched_barrier(0)
__device__ __forceinline__ void mask_tile(f32x16& p0, f32x16& p1, int dq) {
    const float NEG = -__builtin_inff();
#pragma unroll
    for (int r = 0; r < 16; ++r) { const int c = (r & 3) + 8 * (r >> 2); if (dq - c < 0) p0[r] = NEG; if (dq - c - 32 < 0) p1[r] = NEG; }
}
__device__ __forceinline__ void partialSM(f32x16& p0, f32x16& p1, float& m_reg, float& mn, float& alpha) {
    float pmax = p0[0];
#pragma unroll
    for (int r = 1; r < 16; ++r) pmax = fmaxf(pmax, p0[r]);
#pragma unroll
    for (int r = 0; r < 16; ++r) pmax = fmaxf(pmax, p1[r]);
    { auto rr = __builtin_amdgcn_permlane32_swap(__float_as_uint(pmax), __float_as_uint(pmax), false, false); pmax = fmaxf(__uint_as_float(rr[0]), __uint_as_float(rr[1])); }
    constexpr float C2 = 1.4426950408889634f * SCALE;
    if (__builtin_expect(__all((pmax - m_reg) * SCALE <= THR), 1)) { mn = m_reg; alpha = 1.f; }
    else { mn = fmaxf(m_reg, pmax); alpha = __builtin_amdgcn_exp2f((m_reg - mn) * C2); m_reg = mn; }
    const float mnL = -mn * C2;
#pragma unroll
    for (int r = 0; r < 16; ++r) p0[r] = fmaf(p0[r], C2, mnL);
#pragma unroll
    for (int r = 0; r < 16; ++r) p1[r] = fmaf(p1[r], C2, mnL);
#pragma unroll
    for (int r = 0; r < 16; ++r) p0[r] = __builtin_amdgcn_exp2f(p0[r]);
}
__device__ __forceinline__ void finishSM(f32x16& p0, f32x16& p1, float alpha, float& l_reg, bf16x8& pa0, bf16x8& pa1, bf16x8& pa2, bf16x8& pa3) {
#pragma unroll
    for (int r = 0; r < 16; ++r) p1[r] = __builtin_amdgcn_exp2f(p1[r]);
    float ps = 0;
#pragma unroll
    for (int r = 0; r < 16; ++r) ps += p0[r];
#pragma unroll
    for (int r = 0; r < 16; ++r) ps += p1[r];
    { auto rr = __builtin_amdgcn_permlane32_swap(__float_as_uint(ps), __float_as_uint(ps), false, false); ps = __uint_as_float(rr[0]) + __uint_as_float(rr[1]); }
    l_reg = l_reg * alpha + ps;
#define PK4(P, B_, OUT) do { unsigned a0 = cvtpk(P[B_+0], P[B_+1]), a1 = cvtpk(P[B_+2], P[B_+3]);                          \
        unsigned b0 = cvtpk(P[B_+4], P[B_+5]), b1 = cvtpk(P[B_+6], P[B_+7]);                                             \
        auto r0 = __builtin_amdgcn_permlane32_swap(a0, b0, false, false); auto r1 = __builtin_amdgcn_permlane32_swap(a1, b1, false, false); \
        v4u w = {r0[0], r1[0], r0[1], r1[1]}; OUT = __builtin_bit_cast(bf16x8, w); } while (0)
    PK4(p0, 0, pa0); PK4(p0, 8, pa1); PK4(p1, 0, pa2); PK4(p1, 8, pa3);
#undef PK4
}
__device__ __forceinline__ void qkt(f32x16& p0, f32x16& p1, const LAS char* Kl, int r32, int hi, const bf16x8* qr) {
    p0 = f32x16{}; p1 = f32x16{};
    const LAS char* kb[4];
#pragma unroll
    for (int dd = 0; dd < 4; ++dd) kb[dd] = Kl + k_nope_off(r32, (dd * 16 + hi * 8) * 2);
#pragma unroll
    for (int d0 = 0; d0 < 8; ++d0) { const LAS char* ap = kb[d0 & 3] + (d0 >> 2) * 128;
        const bf16x8 b0 = *(const LAS bf16x8*)ap; const bf16x8 b1 = *(const LAS bf16x8*)(ap + 32 * 256);
        p0 = __builtin_amdgcn_mfma_f32_32x32x16_bf16(b0, qr[d0], p0, 0, 0, 0);
        p1 = __builtin_amdgcn_mfma_f32_32x32x16_bf16(b1, qr[d0], p1, 0, 0, 0); }
#pragma unroll
    for (int dr = 0; dr < 4; ++dr) { const LAS char* ap = Kl + k_rope_off(r32, dr * 32 + hi * 16);
        const bf16x8 b0 = *(const LAS bf16x8*)ap; const bf16x8 b1 = *(const LAS bf16x8*)(ap + 32 * 128);
        p0 = __builtin_amdgcn_mfma_f32_32x32x16_bf16(b0, qr[8 + dr], p0, 0, 0, 0);
        p1 = __builtin_amdgcn_mfma_f32_32x32x16_bf16(b1, qr[8 + dr], p1, 0, 0, 0); }
}
__device__ __forceinline__ void pv_tile(f32x16* o, int vb0, bf16x8 pa0, bf16x8 pa1, bf16x8 pa2, bf16x8 pa3) {
#define TRRD(dst, off) asm volatile("ds_read_b64_tr_b16 %0, %1 offset:%2" : "=&v"(dst) : "v"(vb0), "i"(off) : "memory")
#define PV_LD(S_, d0, hf) do { constexpr int b_ = v_rd_off(d0, 2 * (hf), 0); TRRD(S_##l0, b_); TRRD(S_##h0, b_ + 2048); TRRD(S_##l1, b_ + 4096); TRRD(S_##h1, b_ + 6144); } while (0)
#define PV_MM(S_, d0, PA, PB) do { \
        o[d0] = __builtin_amdgcn_mfma_f32_32x32x16_bf16(PA, (bf16x8){S_##l0[0], S_##l0[1], S_##l0[2], S_##l0[3], S_##h0[0], S_##h0[1], S_##h0[2], S_##h0[3]}, o[d0], 0, 0, 0);   \
        o[d0] = __builtin_amdgcn_mfma_f32_32x32x16_bf16(PB, (bf16x8){S_##l1[0], S_##l1[1], S_##l1[2], S_##l1[3], S_##h1[0], S_##h1[1], S_##h1[2], S_##h1[3]}, o[d0], 0, 0, 0); } while (0)
#define PV_W4() do { asm volatile("s_waitcnt lgkmcnt(4)" ::: "memory"); SBAR(); } while (0)
    s16x4 Al0, Al1, Ah0, Ah1, Bl0, Bl1, Bh0, Bh1;
    PV_LD(A, 0, 0); PV_LD(B, 0, 1);
    PV_W4(); PV_MM(A, 0, pa0, pa1); SBAR(); PV_LD(A, 1, 0);
    PV_W4(); PV_MM(B, 0, pa2, pa3); SBAR(); PV_LD(B, 1, 1);
    PV_W4(); PV_MM(A, 1, pa0, pa1); SBAR(); PV_LD(A, 2, 0);
    PV_W4(); PV_MM(B, 1, pa2, pa3); SBAR(); PV_LD(B, 2, 1);
    PV_W4(); PV_MM(A, 2, pa0, pa1); SBAR(); PV_LD(A, 3, 0);
    PV_W4(); PV_MM(B, 2, pa2, pa3); SBAR(); PV_LD(B, 3, 1);
    PV_W4(); PV_MM(A, 3, pa0, pa1); SBAR();
    asm volatile("s_waitcnt lgkmcnt(0)" ::: "memory"); SBAR(); PV_MM(B, 3, pa2, pa3);
#undef PV_LD
#undef PV_MM
#undef PV_W4
#undef TRRD
}
__device__ __forceinline__ void glds16(const void* gsrc, unsigned lds_dst) { unsigned keep;
    asm volatile("s_mov_b32 %0, m0\n\ts_mov_b32 m0, %2\n\ts_nop 0\n\tglobal_load_lds_dwordx4 %1, off\n\ts_mov_b32 m0, %0" : "=&s"(keep) : "v"(gsrc), "s"(lds_dst) : "memory"); }
#define WAITBAR0() asm volatile("s_waitcnt vmcnt(0) lgkmcnt(0)\n\ts_barrier" ::: "memory")

__device__ __forceinline__ void attn_block(int h, int qb, int j_lo, int j_hi, int part, const bf16* QF, const unsigned char* KIMG, const unsigned char* VIMG, bf16* MIX, float* PART, float* PML, char* lds) {
    const int tid = threadIdx.x, wid = __builtin_amdgcn_readfirstlane(tid >> 6), lane = tid & 63, r32 = lane & 31, hi = lane >> 5;
    const int NT = j_hi - j_lo, q0 = qb * 256, qlo = q0 + wid * 32, qm = qlo + r32 - 4 * hi;
    const unsigned lds0 = (unsigned)(uintptr_t)lds;
    const LAS char* Kl = (const LAS char*)lds + LDS_K;
    LAS float* wsf = (LAS float*)((LAS char*)lds + LDS_WS) + wid * 64; LAS float* li_l = wsf; LAS float* al_l = wsf + 32;
    const int vb0 = (int)(lds0 + LDS_V) + v_rd_base(lane);
    const unsigned char* kimg = KIMG + ((size_t)h * 256 + j_lo) * KSLOT + (size_t)(3 * wid) * 1024 + lane * 16;
    const unsigned char* vimg = VIMG + ((size_t)h * 256 + j_lo) * VSLOT + (size_t)(2 * wid) * 1024 + lane * 16;
    const unsigned kdst = lds0 + LDS_K + (3 * wid) * 1024, vdst = lds0 + LDS_V + (2 * wid) * 1024;
#define DMA_K(t, soff) do { const unsigned char* s_ = kimg + (size_t)(t) * KSLOT; const unsigned d_ = (unsigned)__builtin_amdgcn_readfirstlane(kdst + (soff)); \
        glds16(s_, d_); glds16(s_ + 1024, d_ + 1024); glds16(s_ + 2048, d_ + 2048); } while (0)
#define DMA_V(t, soff) do { const unsigned char* s_ = vimg + (size_t)(t) * VSLOT; const unsigned d_ = (unsigned)__builtin_amdgcn_readfirstlane(vdst + (soff)); \
        glds16(s_, d_); glds16(s_ + 1024, d_ + 1024); } while (0)
    bf16x8 qr[12];
    { const bf16* qp = QF + ((size_t)h * S + q0 + wid * 32 + r32) * 192 + hi * 8;
#pragma unroll
      for (int d0 = 0; d0 < 12; ++d0) qr[d0] = *(const bf16x8*)(qp + d0 * 16); }
    int k0 = 0, k1 = KSLOT, k2 = 2 * KSLOT, vp = 2 * VSLOT, vc = 0, vn = VSLOT;
    DMA_K(0, k0); DMA_K(1, k1); DMA_V(0, vc);
    float m_reg = -1e30f, l_reg = 0.f; f32x16 o[4]; o[0] = f32x16{}; o[1] = f32x16{}; o[2] = f32x16{}; o[3] = f32x16{};
    f32x16 pA0, pA1, pB0, pB1; float mnA, mnB, alA = 1.f, alB = 1.f; bf16x8 pa0, pa1, pa2, pa3;
#define RESC(a_) do { if (__any((a_) < 1.f)) { if (hi == 0) al_l[r32] = (a_); asm volatile("s_waitcnt lgkmcnt(0)" ::: "memory"); \
        _Pragma("unroll") for (int d_ = 0; d_ < 4; ++d_) _Pragma("unroll") for (int r = 0; r < 16; ++r) o[d_][r] *= al_l[crow(r, hi)]; } } while (0)
#define MASKT(P0_, P1_, t) do { const int kb_ = (j_lo + (t)) * 64; if (kb_ + 63 > qlo) mask_tile(P0_, P1_, qm - kb_); } while (0)
#define OPEN(t) do { if ((t) + 1 < NT) asm volatile("s_waitcnt vmcnt(5) lgkmcnt(0)\n\ts_barrier" ::: "memory"); \
        else if ((t) < NT) asm volatile("s_waitcnt vmcnt(2) lgkmcnt(0)\n\ts_barrier" ::: "memory"); else asm volatile("s_waitcnt vmcnt(0) lgkmcnt(0)\n\ts_barrier" ::: "memory"); \
        if ((t) + 2 < NT) DMA_K((t) + 2, k2); if ((t) + 1 < NT) DMA_V((t) + 1, vn); } while (0)
#define ROT() do { int t_ = k0; k0 = k1; k1 = k2; k2 = t_; t_ = vp; vp = vc; vc = vn; vn = t_; } while (0)
    if (wid < 4) {
    OPEN(0);
    SBAR(); qkt(pA0, pA1, Kl + k0, r32, hi, qr); MASKT(pA0, pA1, 0); partialSM(pA0, pA1, m_reg, mnA, alA); ROT();
#define STEP(PX0, PX1, mnX, alX, PY0, PY1, alY, t) do { \
        OPEN(t); \
        SBAR(); qkt(PX0, PX1, Kl + k0, r32, hi, qr); if (DBG_QK2) { asm volatile("" : "+v"(PX0), "+v"(PX1)); qkt(PX0, PX1, Kl + k0, r32, hi, qr); } \
        finishSM(PY0, PY1, alY, l_reg, pa0, pa1, pa2, pa3); SBAR(); \
        pv_tile(o, vb0 + vp, pa0, pa1, pa2, pa3); MASKT(PX0, PX1, (t)); partialSM(PX0, PX1, m_reg, mnX, alX); \
        RESC(alX); ROT(); } while (0)
    int t = 1;
    for (; t + 1 < NT; t += 2) {
        STEP(pB0, pB1, mnB, alB, pA0, pA1, alA, t);
        STEP(pA0, pA1, mnA, alA, pB0, pB1, alB, t + 1);
    }
    STEP(pB0, pB1, mnB, alB, pA0, pA1, alA, NT - 1);
    OPEN(NT);
    finishSM(pB0, pB1, alB, l_reg, pa0, pa1, pa2, pa3); SBAR();
    pv_tile(o, vb0 + vp, pa0, pa1, pa2, pa3);
#undef STEP
    } else {
    OPEN(0);
    SBAR(); qkt(pA0, pA1, Kl + k0, r32, hi, qr); ROT();
#define STEPB(PX0, PX1, PY0, PY1, mnY, alY, t) do { \
        OPEN(t); \
        MASKT(PY0, PY1, (t) - 1); partialSM(PY0, PY1, m_reg, mnY, alY); RESC(alY); \
        SBAR(); qkt(PX0, PX1, Kl + k0, r32, hi, qr); if (DBG_QK2) { asm volatile("" : "+v"(PX0), "+v"(PX1)); qkt(PX0, PX1, Kl + k0, r32, hi, qr); } \
        finishSM(PY0, PY1, alY, l_reg, pa0, pa1, pa2, pa3); SBAR(); \
        pv_tile(o, vb0 + vp, pa0, pa1, pa2, pa3); ROT(); } while (0)
    int t = 1;
    for (; t + 1 < NT; t += 2) {
        STEPB(pB0, pB1, pA0, pA1, mnA, alA, t);
        STEPB(pA0, pA1, pB0, pB1, mnB, alB, t + 1);
    }
    STEPB(pB0, pB1, pA0, pA1, mnA, alA, NT - 1);
    OPEN(NT);
    MASKT(pB0, pB1, NT - 1); partialSM(pB0, pB1, m_reg, mnB, alB); RESC(alB);
    finishSM(pB0, pB1, alB, l_reg, pa0, pa1, pa2, pa3); SBAR();
    pv_tile(o, vb0 + vp, pa0, pa1, pa2, pa3);
#undef STEPB
    }
    if (part < 0) {
    if (hi == 0) li_l[r32] = l_reg; asm volatile("s_waitcnt lgkmcnt(0)" ::: "memory");
    float rli[16];
#pragma unroll
    for (int r = 0; r < 16; ++r) rli[r] = __builtin_amdgcn_rcpf(li_l[crow(r, hi)]);
    bf16* Ow = MIX + (size_t)(q0 + wid * 32) * D + 512 + h * 128;
#pragma unroll
    for (int r = 0; r < 16; ++r) { const int orow = crow(r, hi);
#pragma unroll
        for (int d0 = 0; d0 < 4; ++d0) { const float v = o[d0][r] * rli[r]; const float vn = __shfl_xor(v, 1);
            if ((r32 & 1) == 0) *(unsigned*)(Ow + (size_t)orow * D + d0 * 32 + r32) = cvtpk(v, vn); } }
    } else {
    float* Pw = PART + ((size_t)part * 256 + wid * 32) * 128;
#pragma unroll
    for (int r = 0; r < 16; ++r) { const int orow = crow(r, hi);
#pragma unroll
        for (int d0 = 0; d0 < 4; ++d0) Pw[(size_t)orow * 128 + d0 * 32 + r32] = o[d0][r]; }
    if (hi == 0) { float* ml = PML + ((size_t)part * 256 + wid * 32 + r32) * 2; ml[0] = m_reg; ml[1] = l_reg; }
    }
    asm volatile("s_waitcnt lgkmcnt(0)\n\ts_barrier" ::: "memory");
#undef DMA_K
#undef DMA_V
#undef RESC
#undef MASKT
#undef OPEN
#undef ROT
}
}

__device__ __forceinline__ void fin_phase(const Args& a, int gw, int NGW, int lane) {
    unsigned char* ws = a.ws;
    const bf16* P1 = (const bf16*)(ws + WS_P1); const bf16* QR = (const bf16*)(ws + WS_QR); const bf16* KVR = (const bf16*)(ws + WS_KVR);
    bf16* QF = (bf16*)(ws + WS_QF); unsigned char* KIMG = ws + WS_KIMG; unsigned char* VIMG = ws + WS_VIMG; bf16* MIX = (bf16*)(ws + WS_MIX);
    const float* cosT = (const float*)(ws + WS_ROPE); const float* sinT = cosT + (size_t)S * 32;
    const float* qnw = (const float*)a.in[I_QNW]; const float* knw = (const float*)a.in[I_KNW]; const float* cw = (const float*)a.in[I_CONV];
    const int hl = lane & 15, h = lane >> 4, c4 = lane & 3;
    float wq[16], wk[16], wkr[16];
#pragma unroll
    for (int e = 0; e < 16; ++e) { wq[e] = hl < 12 ? qnw[hl * 16 + e] : 0.f; wk[e] = hl < 8 ? knw[hl * 16 + e] : 0.f; wkr[e] = knw[128 + c4 * 16 + e]; }
    float cw0[8], cw1[8], cw2[8];
#pragma unroll
    for (int e = 0; e < 8; ++e) { cw0[e] = cw[lane * 8 + e]; cw1[e] = cw[512 + lane * 8 + e]; cw2[e] = cw[1024 + lane * 8 + e]; }
    for (int t = gw; t < S; t += NGW) {
        const bf16* prow = P1 + (size_t)t * O_INP;
        float s_q, s_kv;
        { const v2u r = *(const v2u*)(prow + 1536 + lane * 4); const float x0 = bflo(r.x), x1 = bfhi(r.x), x2 = bflo(r.y), x3 = bfhi(r.y);
          s_q = 1.f / sqrtf(wave_sum((x0 * x0 + x1 * x1) + (x2 * x2 + x3 * x3)) * (1.f / 256.f) + EPS); }
        { const v2u r = *(const v2u*)(prow + 1792 + lane * 4); const float x0 = bflo(r.x), x1 = bfhi(r.x), x2 = bflo(r.y), x3 = bfhi(r.y);
          s_kv = 1.f / sqrtf(wave_sum((x0 * x0 + x1 * x1) + (x2 * x2 + x3 * x3)) * (1.f / 256.f) + EPS); }
        const int fi = (hl & 1) * 16;
        float cs[16], sn[16];
        { const f32x4* cp = (const f32x4*)(cosT + (size_t)t * 32 + fi); const f32x4* sp = (const f32x4*)(sinT + (size_t)t * 32 + fi);
#pragma unroll
          for (int q = 0; q < 4; ++q) { const f32x4 c_ = cp[q], s_ = sp[q]; cs[4 * q] = c_.x; cs[4 * q + 1] = c_.y; cs[4 * q + 2] = c_.z; cs[4 * q + 3] = c_.w; sn[4 * q] = s_.x; sn[4 * q + 1] = s_.y; sn[4 * q + 2] = s_.z; sn[4 * q + 3] = s_.w; } }
        { const v4u r0 = *(const v4u*)(QR + (size_t)t * 1024 + lane * 16), r1 = *(const v4u*)(QR + (size_t)t * 1024 + lane * 16 + 8);
          float x[16] = {bflo(r0.x), bfhi(r0.x), bflo(r0.y), bfhi(r0.y), bflo(r0.z), bfhi(r0.z), bflo(r0.w), bfhi(r0.w), bflo(r1.x), bfhi(r1.x), bflo(r1.y), bfhi(r1.y), bflo(r1.z), bfhi(r1.z), bflo(r1.w), bfhi(r1.w)};
          float ss = 0.f;
#pragma unroll
          for (int e = 0; e < 16; ++e) { x[e] *= s_q; ss += x[e] * x[e]; }
          ss += __shfl_xor(ss, 1); ss += __shfl_xor(ss, 2); ss += __shfl_xor(ss, 4); ss += __shfl_xor(ss, 8);
          const float rq = 1.f / sqrtf(ss * (1.f / 192.f) + EPS);
          float y[16];
#pragma unroll
          for (int e = 0; e < 16; ++e) { const float v = x[e] * rq * wq[e]; const float pr = __shfl_xor(v, 2);
              y[e] = hl < 8 ? v : (hl < 10 ? v * cs[e] - pr * sn[e] : v * cs[e] + pr * sn[e]); }
          if (hl < 12) { v4u o0, o1; o0.x = pk2(y[0], y[1]); o0.y = pk2(y[2], y[3]); o0.z = pk2(y[4], y[5]); o0.w = pk2(y[6], y[7]); o1.x = pk2(y[8], y[9]); o1.y = pk2(y[10], y[11]); o1.z = pk2(y[12], y[13]); o1.w = pk2(y[14], y[15]);
              bf16* qd = QF + ((size_t)h * S + t) * 192 + hl * 16; *(v4u*)qd = o0; *(v4u*)(qd + 8) = o1; } }
        { const v4u r0 = *(const v4u*)(KVR + (size_t)t * 1024 + lane * 16), r1 = *(const v4u*)(KVR + (size_t)t * 1024 + lane * 16 + 8);
          float x[16] = {bflo(r0.x), bfhi(r0.x), bflo(r0.y), bfhi(r0.y), bflo(r0.z), bfhi(r0.z), bflo(r0.w), bfhi(r0.w), bflo(r1.x), bfhi(r1.x), bflo(r1.y), bfhi(r1.y), bflo(r1.z), bfhi(r1.z), bflo(r1.w), bfhi(r1.w)};
          const v4u p0 = *(const v4u*)(prow + 2048 + c4 * 16), p1 = *(const v4u*)(prow + 2048 + c4 * 16 + 8);
          float kp[16] = {bflo(p0.x), bfhi(p0.x), bflo(p0.y), bfhi(p0.y), bflo(p0.z), bfhi(p0.z), bflo(p0.w), bfhi(p0.w), bflo(p1.x), bfhi(p1.x), bflo(p1.y), bfhi(p1.y), bflo(p1.z), bfhi(p1.z), bflo(p1.w), bfhi(p1.w)};
          float ssk = 0.f, ssp = 0.f;
#pragma unroll
          for (int e = 0; e < 16; ++e) { x[e] *= s_kv; ssk += x[e] * x[e]; ssp += kp[e] * kp[e]; }
          if (hl >= 8) ssk = 0.f;
          ssk += __shfl_xor(ssk, 1); ssk += __shfl_xor(ssk, 2); ssk += __shfl_xor(ssk, 4); ssk += __shfl_xor(ssk, 8);
          ssp += __shfl_xor(ssp, 1); ssp += __shfl_xor(ssp, 2);
          const float rk = 1.f / sqrtf((ssk + ssp) * (1.f / 192.f) + EPS);
          const int krow = t & 63, tile = t >> 6;
          unsigned char* kt = KIMG + ((size_t)h * 256 + tile) * att::KSLOT; unsigned char* vt = VIMG + ((size_t)h * 256 + tile) * att::VSLOT;
          float y[16];
#pragma unroll
          for (int e = 0; e < 16; ++e) y[e] = hl < 8 ? x[e] * rk * wk[e] : x[e];
          { v4u o0, o1; o0.x = pk2(y[0], y[1]); o0.y = pk2(y[2], y[3]); o0.z = pk2(y[4], y[5]); o0.w = pk2(y[6], y[7]); o1.x = pk2(y[8], y[9]); o1.y = pk2(y[10], y[11]); o1.z = pk2(y[12], y[13]); o1.w = pk2(y[14], y[15]);
            if (hl < 8) { *(v4u*)(kt + att::k_nope_off(krow, hl * 32)) = o0; *(v4u*)(kt + att::k_nope_off(krow, hl * 32 + 16)) = o1; }
            else { *(v4u*)(vt + att::v_st(krow, (hl - 8) * 16)) = o0; *(v4u*)(vt + att::v_st(krow, (hl - 8) * 16 + 8)) = o1; } }
          float z[16];
#pragma unroll
          for (int e = 0; e < 16; ++e) { const float v = kp[e] * rk * wkr[e]; const float pr = __shfl_xor(v, 2); z[e] = c4 < 2 ? v * cs[e] - pr * sn[e] : v * cs[e] + pr * sn[e]; }
          if (hl < 4) { v4u o0, o1; o0.x = pk2(z[0], z[1]); o0.y = pk2(z[2], z[3]); o0.z = pk2(z[4], z[5]); o0.w = pk2(z[6], z[7]); o1.x = pk2(z[8], z[9]); o1.y = pk2(z[10], z[11]); o1.z = pk2(z[12], z[13]); o1.w = pk2(z[14], z[15]);
              *(v4u*)(kt + att::k_rope_off(krow, c4 * 32)) = o0; *(v4u*)(kt + att::k_rope_off(krow, c4 * 32 + 16)) = o1; } }
        { const int ch = lane * 8; float conv[8] = {0.f, 0.f, 0.f, 0.f, 0.f, 0.f, 0.f, 0.f};
#pragma unroll
          for (int k = 0; k < 3; ++k) { const int tt = t - 2 + k; if (tt >= 0) { const bf16* pr = P1 + (size_t)tt * O_INP; const v4u cg = *(const v4u*)(pr + 512 + ch), hh = *(const v4u*)(pr + 1024 + ch);
              const float* wv = k == 0 ? cw0 : (k == 1 ? cw1 : cw2);
              conv[0] += wv[0] * bflo(cg.x) * bflo(hh.x); conv[1] += wv[1] * bfhi(cg.x) * bfhi(hh.x); conv[2] += wv[2] * bflo(cg.y) * bflo(hh.y); conv[3] += wv[3] * bfhi(cg.y) * bfhi(hh.y);
              conv[4] += wv[4] * bflo(cg.z) * bflo(hh.z); conv[5] += wv[5] * bfhi(cg.z) * bfhi(hh.z); conv[6] += wv[6] * bflo(cg.w) * bflo(hh.w); conv[7] += wv[7] * bfhi(cg.w) * bfhi(hh.w); } }
          const v4u bg = *(const v4u*)(prow + ch);
          v4u o; o.x = pk2(bflo(bg.x) * conv[0], bfhi(bg.x) * conv[1]); o.y = pk2(bflo(bg.y) * conv[2], bfhi(bg.y) * conv[3]); o.z = pk2(bflo(bg.z) * conv[4], bfhi(bg.z) * conv[5]); o.w = pk2(bflo(bg.w) * conv[6], bfhi(bg.w) * conv[7]);
          *(v4u*)(MIX + (size_t)t * D + ch) = o; }
    }
}

__device__ __forceinline__ void route1_phase(const Args& a, LAS unsigned char* lds, int vcu, int G, int tid) {
    unsigned char* ws = a.ws; const float* XR = (const float*)(ws + WS_XR); const float* modF = (const float*)(ws + WS_MODF) + 6144;
    const float* nw = (const float*)a.in[I_NFW] + 1024; const float* rw = (const float*)a.in[I_RW];
    unsigned* tok = (unsigned*)(ws + WS_TOK); unsigned* cnt = (unsigned*)(ws + WS_CTL) + CW_CNT;
    const int lane = tid & 63, wave = __builtin_amdgcn_readfirstlane(tid >> 6);
    LAS int* tokE = (LAS int*)lds;
    LAS int* tokL = (LAS int*)(lds + 512);
    LAS int* offS = (LAS int*)(lds + 1024);
    f32x4 g[4], sh[4];
#pragma unroll
    for (int j = 0; j < 4; ++j)
#pragma unroll
        for (int e = 0; e < 4; ++e) { const int col = 4 * lane + e + 256 * j; g[j][e] = nw[col] * (1.f + modF[OFF_SCF + col]); sh[j][e] = modF[OFF_SHF + col]; }
    for (int chunk = vcu; chunk < S / 64; chunk += G) {
        for (int i = 0; i < 8; ++i) { const int ti = wave * 8 + i, t = chunk * 64 + ti;
            const f32x4* xr = (const f32x4*)(XR + (size_t)t * D) + lane; f32x4 v[4]; float s = 0.f;
#pragma unroll
            for (int j = 0; j < 4; ++j) { v[j] = xr[64 * j]; s += (v[j].x * v[j].x + v[j].y * v[j].y) + (v[j].z * v[j].z + v[j].w * v[j].w); }
            const float rstd = 1.f / sqrtf(wave_sum(s) * (1.f / D) + EPS);
            float lg[8] = {0.f, 0.f, 0.f, 0.f, 0.f, 0.f, 0.f, 0.f};
#pragma unroll
            for (int j = 0; j < 4; ++j) { const f32x4 hv = v[j] * rstd * g[j] + sh[j];
#pragma unroll
                for (int e = 0; e < 4; ++e) { const int col = 4 * lane + e + 256 * j; const f32x4 w0 = *(const f32x4*)(rw + col * 8), w1 = *(const f32x4*)(rw + col * 8 + 4); const float hx = hv[e];
                    lg[0] += hx * w0.x; lg[1] += hx * w0.y; lg[2] += hx * w0.z; lg[3] += hx * w0.w; lg[4] += hx * w1.x; lg[5] += hx * w1.y; lg[6] += hx * w1.z; lg[7] += hx * w1.w; } }
#pragma unroll
            for (int e = 0; e < 8; ++e) lg[e] = wave_sum(lg[e]);
            int e1 = 0; float l1 = lg[0];
#pragma unroll
            for (int e = 1; e < 8; ++e) if (lg[e] > l1) { l1 = lg[e]; e1 = e; }
            int e2 = -1; float l2 = -__builtin_inff();
#pragma unroll
            for (int e = 0; e < 8; ++e) if (e != e1 && lg[e] > l2) { l2 = lg[e]; e2 = e; }
            const float g1 = 1.f / (1.f + __expf(l2 - l1)), g2 = 1.f - g1;
            if (lane == 0) { unsigned* rec = tok + (size_t)t * 8; rec[0] = (unsigned)e1; rec[1] = (unsigned)e2; rec[4] = __float_as_uint(g1); rec[5] = __float_as_uint(g2); rec[6] = __float_as_uint(rstd);
                tokE[2 * ti] = e1; tokE[2 * ti + 1] = e2; } }
        __syncthreads();
        if (tid < 8) { int c = 0; for (int i = 0; i < 128; ++i) if (tokE[i] == tid) { tokL[i] = c; ++c; }
            offS[tid] = (int)__hip_atomic_fetch_add(cnt + 64 * tid, (unsigned)c, RLX_AGENT); }
        __syncthreads();
        if (tid < 128) { const int t = chunk * 64 + (tid >> 1); tok[(size_t)t * 8 + 2 + (tid & 1)] = (unsigned)(offS[tokE[tid]] + tokL[tid]); }
        __syncthreads();
    }
}
__device__ __forceinline__ void route2_phase(const Args& a, int gw, int NGW, int lane) {
    unsigned char* ws = a.ws; const float* XR = (const float*)(ws + WS_XR); const float* modF = (const float*)(ws + WS_MODF) + 6144;
    const float* nw = (const float*)a.in[I_NFW] + 1024; unsigned* tok = (unsigned*)(ws + WS_TOK); const unsigned* cnt = (const unsigned*)(ws + WS_CTL) + CW_CNT;
    unsigned char* AM = ws + WS_AMOE;
    f32x4 g[4], sh[4];
#pragma unroll
    for (int j = 0; j < 4; ++j)
#pragma unroll
        for (int e = 0; e < 4; ++e) { const int col = 4 * lane + e + 256 * j; g[j][e] = nw[col] * (1.f + modF[OFF_SCF + col]); sh[j][e] = modF[OFF_SHF + col]; }
    int base[8]; { int b = 0;
#pragma unroll
      for (int e = 0; e < 8; ++e) { base[e] = b; b += (int)((__hip_atomic_load(cnt + 64 * e, RLX_AGENT) + 255u) >> 8) * 256; } }
    for (int t = gw; t < S; t += NGW) {
        unsigned* rec = tok + (size_t)t * 8; const int e1 = (int)rec[0], e2 = (int)rec[1]; const float rstd = __uint_as_float(rec[6]);
        int b1 = 0, b2 = 0;
#pragma unroll
        for (int e = 0; e < 8; ++e) { b1 = e1 == e ? base[e] : b1; b2 = e2 == e ? base[e] : b2; }
        const int s1 = b1 + (int)rec[2], s2 = b2 + (int)rec[3];
        const f32x4* xr = (const f32x4*)(XR + (size_t)t * D) + lane;
        unsigned* o1 = (unsigned*)(AM + (size_t)s1 * D) + lane; unsigned* o2 = (unsigned*)(AM + (size_t)s2 * D) + lane;
#pragma unroll
        for (int j = 0; j < 4; ++j) { const f32x4 y = xr[64 * j] * rstd * g[j] + sh[j]; const unsigned w = pg8::pk4_fp8(y.x, y.y, y.z, y.w); o1[64 * j] = w; o2[64 * j] = w; }
        if (lane == 0) { rec[2] = (unsigned)s1; rec[3] = (unsigned)s2; }
    }
}
__device__ __forceinline__ void combine_phase(const Args& a, int gw, int NGW, int lane) {
    unsigned char* ws = a.ws; const float* XR = (const float*)(ws + WS_XR); const float* gf = (const float*)(ws + WS_MODF) + 6144 + OFF_GF;
    const unsigned* tok = (const unsigned*)(ws + WS_TOK); const bf16* Y = (const bf16*)(ws + WS_AMOE);
    f32x4 gg[4];
#pragma unroll
    for (int j = 0; j < 4; ++j) gg[j] = *(const f32x4*)(gf + 4 * lane + 256 * j);
    for (int t0 = gw; t0 < S; t0 += 4 * NGW) {
        v2u rs[4], rg[4];
#pragma unroll
        for (int i = 0; i < 4; ++i) { const int t = t0 + i * NGW < S ? t0 + i * NGW : t0; rs[i] = *(const v2u*)(tok + (size_t)t * 8 + 2); rg[i] = *(const v2u*)(tok + (size_t)t * 8 + 4); }
        f32x4 xv[4][4]; v2u y1[4][4], y2[4][4];
#pragma unroll
        for (int i = 0; i < 4; ++i) { const int t = t0 + i * NGW < S ? t0 + i * NGW : t0;
            const f32x4* xr = (const f32x4*)(XR + (size_t)t * D) + lane; const v2u* p1 = (const v2u*)(Y + (size_t)rs[i].x * D) + lane; const v2u* p2 = (const v2u*)(Y + (size_t)rs[i].y * D) + lane;
#pragma unroll
            for (int j = 0; j < 4; ++j) { xv[i][j] = xr[64 * j]; y1[i][j] = p1[64 * j]; y2[i][j] = p2[64 * j]; } }
#pragma unroll
        for (int i = 0; i < 4; ++i) { const int t = t0 + i * NGW; if (t < S) { const float g1 = __uint_as_float(rg[i].x), g2 = __uint_as_float(rg[i].y); f32x4* orow = (f32x4*)(a.out + (size_t)t * D) + lane;
#pragma unroll
            for (int j = 0; j < 4; ++j) { const v2u a1 = y1[i][j], a2 = y2[i][j];
                f32x4 m; m.x = g1 * bflo(a1.x) + g2 * bflo(a2.x); m.y = g1 * bfhi(a1.x) + g2 * bfhi(a2.x); m.z = g1 * bflo(a1.y) + g2 * bflo(a2.y); m.w = g1 * bfhi(a1.y) + g2 * bfhi(a2.y);
                orow[64 * j] = xv[i][j] + gg[j] * m; } } }
    }
}

constexpr int N_PHASES = 19;
__global__ void __launch_bounds__(NTHR, 2) fwd_kernel(Args args) {
    extern __shared__ __attribute__((aligned(16))) unsigned char lds[];
    LAS unsigned char* L = (LAS unsigned char*)lds;
    const int tid = threadIdx.x, lane = tid & 63, wave = __builtin_amdgcn_readfirstlane(tid >> 6);
    const int G = gridDim.x; int bx = blockIdx.x; int vcu = (G % 8 == 0) ? (bx % 8) * (G / 8) + bx / 8 : bx;
    int gw = vcu * NWAVES + wave; const int NGW = G * NWAVES;
    unsigned char* ws = args.ws;
    for (int u = tid; u < (LDS_BYTES - LDSCTL_OFF) / 4; u += NTHR) ((LAS unsigned*)(L + LDSCTL_OFF))[u] = 0u;
    __syncthreads();
    XcdBarrier bar; bar.bar = (unsigned*)(ws + WS_CTL) + CW_BAR; bar.x = 0; bar.st = nullptr;
#if !MK_MULTI
    bar = xcd_barrier_post((unsigned*)(ws + WS_CTL) + CW_BAR, (volatile LAS unsigned*)(L + MISC_OFF) + 8);
    if (tid == 0) { volatile LAS unsigned* M = (volatile LAS unsigned*)(L + MISC_OFF); M[10] = bar.x; M[11] = xb_add((unsigned*)(ws + WS_CTL) + CW_XRANK + 64 * bar.x, 1u); }
#define GRID_BAR() xcd_barrier(bar)
#else
#define GRID_BAR() do {} while (0)
#endif
    const int lo = args.ph_lo, hi = args.ph_hi;
#define IN(k) (lo <= (k) && (k) < hi)
#define BOTH(k) (IN(k) && IN((k) + 1))
    const float* modF = (const float*)(ws + WS_MODF);
    bf16* ABUF = (bf16*)(ws + WS_ABUF); bf16* MIX = (bf16*)(ws + WS_MIX); float* XR = (float*)(ws + WS_XR);

    if (IN(0)) { p0_prologue(args, L, vcu, G, tid); if (DBG_REP == 0) { GRID_BAR(); p0_prologue(args, L, vcu, G, tid); } if (BOTH(0)) GRID_BAR(); }
#if !MK_MULTI && XCC_ORDER
    if (BOTH(0)) {
        volatile LAS unsigned* M = (volatile LAS unsigned*)(L + MISC_OFF);
        if (tid == 0) { unsigned* xb = (unsigned*)(ws + WS_CTL) + CW_BAR; bool ok = (G % 8) == 0;
            for (unsigned j = 0; j < 16; ++j) { const unsigned c_ = xb_ld(&xb[XB_XCNT(j)]); ok = ok && (c_ == (j < 8 ? (unsigned)(G / 8) : 0u)); }
            M[12] = ok ? (M[11] * 8u + M[10]) : (unsigned)blockIdx.x; }
        __syncthreads();
        bx = (int)M[12]; vcu = (G % 8 == 0) ? (bx % 8) * (G / 8) + bx / 8 : bx; gw = vcu * NWAVES + wave;
    }
#endif
    if (IN(1)) {
        { float* mf = (float*)(ws + WS_MODF); for (int i = vcu * NTHR + tid; i < 2 * 6144; i += G * NTHR) mf[i] = modv_partial((const float*)(ws + WS_MODP), (const float*)args.in[I_ADAB], i / 6144, i % 6144); }
        norm_phase<true>(args, (const float*)args.in[I_X], ABUF, (const float*)args.in[I_NMW], 0, OFF_SHM, OFF_SCM, gw, NGW, lane, (LAS float*)L);
        if (DBG_REP == 1) { GRID_BAR(); norm_phase<true>(args, (const float*)args.in[I_X], ABUF, (const float*)args.in[I_NMW], 0, OFF_SHM, OFF_SCM, gw, NGW, lane, (LAS float*)L); }
        if (BOTH(1)) GRID_BAR(); }
    if (IN(2)) { pg8::Gemm g{ABUF, ws + WS_WIN0, 2048, 2048}; pg8::StaticOrder So; So.init(S, E_IN, G, bx);
        pg8::EpiBf16G E{(bf16*)(ws + WS_P0), E_IN, 4, 1.f}; pg8::gemm_phase(L, g, So, E); if (DBG_REP == 2) { GRID_BAR(); pg8::gemm_phase(L, g, So, E); } conv_fill(args, L, (unsigned*)(ws + WS_CTL) + CW_GD, G, tid); if (BOTH(2)) GRID_BAR(); }
    if (IN(3)) { mixab_phase(args, L, vcu, G, tid); if (DBG_REP == 3) { GRID_BAR(); mixab_phase(args, L, vcu, G, tid); } if (BOTH(3)) GRID_BAR(); }
    if (IN(4)) { pg8::Gemm g{MIX, ws + WS_WOUT0, 2048, 2048}; pg8::StaticOrder So; So.init(S, 1024, G, bx);
        pg8::EpiResT<false, true> E{args.in[I_X], ws + WS_XRB, modF + OFF_GM, 1.f}; pg8::gemm_phase(L, g, So, E); if (DBG_REP == 4) { GRID_BAR(); pg8::gemm_phase(L, g, So, E); } if (BOTH(4)) GRID_BAR(); }
    if (IN(5)) { norm_phase<false, false, true>(args, ws + WS_XRB, ABUF, (const float*)args.in[I_NFW], 0, OFF_SHF, OFF_SCF, gw, NGW, lane); if (DBG_REP == 5) { GRID_BAR(); norm_phase<false, false, true>(args, ws + WS_XRB, ABUF, (const float*)args.in[I_NFW], 0, OFF_SHF, OFF_SCF, gw, NGW, lane); } if (BOTH(5)) GRID_BAR(); }
    if (IN(6)) { pg8::Gemm g{ABUF, ws + WS_WGU0, 2048, 2048}; pg8::StaticOrder So; So.init(S, 2 * D_FF, G, bx);
        pg8::EpiSwiGLU E{(bf16*)(ws + WS_H), D_FF}; pg8::gemm_phase(L, g, So, E); if (DBG_REP == 6) { GRID_BAR(); pg8::gemm_phase(L, g, So, E); } conv_fill(args, L, (unsigned*)(ws + WS_CTL) + CW_GD + 64, G, tid); if (BOTH(6)) GRID_BAR(); }
    if (IN(7)) { pg8::Gemm g{ws + WS_H, ws + WS_WD0, D_FF * 2, D_FF * 2}; pg8::StaticOrder So; So.init(S, 1024, G, bx);
        pg8::EpiResT<true, true> E{ws + WS_XRB, ws + WS_XRB, modF + OFF_GF, 1.f}; pg8::gemm_phase(L, g, So, E); if (BOTH(7)) GRID_BAR(); }
    if (IN(8)) { norm_phase<false, false, true>(args, ws + WS_XRB, ABUF, (const float*)args.in[I_NMW] + 1024, 1, OFF_SHM, OFF_SCM, gw, NGW, lane); if (BOTH(8)) GRID_BAR(); }
    if (IN(9)) { pg8::Gemm g{ABUF, ws + WS_WIN1, 2048, 2048}; pg8::StaticOrder So; So.init(S, O_INP, G, bx);
        pg8::EpiBf16G E{(bf16*)(ws + WS_P1), O_INP, 0, 1.f}; pg8::gemm_phase(L, g, So, E); if (DBG_REP == 9) { GRID_BAR(); pg8::gemm_phase(L, g, So, E); } conv_fill(args, L, (unsigned*)(ws + WS_CTL) + CW_GD + 128, G, tid); if (BOTH(9)) GRID_BAR(); }
    if (IN(10)) {
        for (int rep_ = 0; rep_ < (DBG_REP == 10 ? 2 : 1); ++rep_) { if (rep_) GRID_BAR();
        { pg8::Gemm g{(const bf16*)(ws + WS_P1) + 1536, ws + WS_WUQ, O_INP * 2, 512}; pg8::StaticOrder So; So.init(S, 1024, G, bx);
          pg8::EpiBf16G E{(bf16*)(ws + WS_QR), 1024, 0, 1.f}; pg8::gemm_phase(L, g, So, E); }
        { pg8::Gemm g{(const bf16*)(ws + WS_P1) + 1792, ws + WS_WUKV, O_INP * 2, 512}; pg8::StaticOrder So; So.init(S, 1024, G, bx);
          pg8::EpiBf16G E{(bf16*)(ws + WS_KVR), 1024, 0, 1.f}; pg8::gemm_phase(L, g, So, E); } }
        if (BOTH(10)) GRID_BAR(); }
    if (IN(11)) { fin_phase(args, gw, NGW, lane); if (DBG_REP == 11) { GRID_BAR(); fin_phase(args, gw, NGW, lane); } if (BOTH(11)) GRID_BAR(); }
    if (IN(12)) {
        for (int rep = 0; rep < (DBG_REP == 12 ? 2 : 1); ++rep) { if (rep) GRID_BAR();
        for (int u = bx; u < 256; u += G) { const int h = u & 3, v = u >> 2, sb = v >> 1, role = v & 1, nA = 126 - 4 * sb, pi = (h * 32 + sb) * 2;
            const bf16* QF = (const bf16*)(ws + WS_QF); float* PART = (float*)(ws + WS_PART); float* PML = (float*)(ws + WS_PML);
            if (role == 0) { att::attn_block(h, sb, 0, 4 * (sb + 1), -1, QF, ws + WS_KIMG, ws + WS_VIMG, MIX, PART, PML, (char*)lds);
                             att::attn_block(h, 63 - sb, 0, nA, pi, QF, ws + WS_KIMG, ws + WS_VIMG, MIX, PART, PML, (char*)lds); }
            else att::attn_block(h, 63 - sb, nA, 4 * (64 - sb), pi + 1, QF, ws + WS_KIMG, ws + WS_VIMG, MIX, PART, PML, (char*)lds); } }
        GRID_BAR();
        { const float* PART = (const float*)(ws + WS_PART); const float* PML = (const float*)(ws + WS_PML); constexpr float C2 = 1.4426950408889634f * att::SCALE;
          for (int it = vcu * NTHR + tid; it < 128 * 256 * 16; it += G * NTHR) { const int rw = it >> 4, c8 = (it & 15) * 8, blk = rw >> 8, row = rw & 255, h = blk >> 5, sb = blk & 31, pi = blk * 2;
              const size_t ra = (size_t)pi * 256 + row, rb = ra + 256;
              const float mA = PML[ra * 2], lA = PML[ra * 2 + 1], mB = PML[rb * 2], lB = PML[rb * 2 + 1];
              const f32x4 a0 = *(const f32x4*)(PART + ra * 128 + c8), a1 = *(const f32x4*)(PART + ra * 128 + c8 + 4), b0 = *(const f32x4*)(PART + rb * 128 + c8), b1 = *(const f32x4*)(PART + rb * 128 + c8 + 4);
              const float m = fmaxf(mA, mB), wA = __builtin_amdgcn_exp2f((mA - m) * C2), wB = __builtin_amdgcn_exp2f((mB - m) * C2), inv = 1.f / (lA * wA + lB * wB);
              const f32x4 v0 = (a0 * wA + b0 * wB) * inv, v1 = (a1 * wA + b1 * wB) * inv;
              v4u o; o.x = pk2(v0[0], v0[1]); o.y = pk2(v0[2], v0[3]); o.z = pk2(v1[0], v1[1]); o.w = pk2(v1[2], v1[3]);
              *(v4u*)(MIX + (size_t)((63 - sb) * 256 + row) * D + 512 + h * 128 + c8) = o; } }
        if (BOTH(12)) GRID_BAR(); }
    if (IN(13)) { pg8::Gemm g{MIX, ws + WS_WOUT1, 2048, 2048}; pg8::StaticOrder So; So.init(S, 1024, G, bx);
        pg8::EpiResT<true, false> E{ws + WS_XRB, XR, modF + 6144 + OFF_GM, 1.f}; pg8::gemm_phase(L, g, So, E); if (BOTH(13)) GRID_BAR(); }
    if (IN(14)) { conv_fill(args, L, nullptr, G, tid); route1_phase(args, L, vcu, G, tid); if (BOTH(14)) GRID_BAR(); }
    if (IN(15)) { route2_phase(args, gw, NGW, lane); if (BOTH(15)) GRID_BAR(); }
    if (IN(16)) { pg8::Gemm g{ws + WS_AMOE, ws + WS_WGUM, 1024, 1024}; pg8::MoeOrder Mo; Mo.init((const unsigned*)(ws + WS_CTL) + CW_CNT, 28, G, vcu, 8);
        pg8::EpiSwiGLU8 E{ws + WS_HM, DFE, 1.f / MOE_WSCALE}; pg8::gemm_phase<pg8::EpiSwiGLU8, pg8::MoeOrder, true>(L, g, Mo, E); if (DBG_REP == 16) { GRID_BAR(); pg8::gemm_phase<pg8::EpiSwiGLU8, pg8::MoeOrder, true>(L, g, Mo, E); } if (BOTH(16)) GRID_BAR(); }
    if (IN(17)) { pg8::Gemm g{ws + WS_HM, ws + WS_WDM, DFE, DFE}; pg8::MoeOrder Mo; Mo.init((const unsigned*)(ws + WS_CTL) + CW_CNT, 4, G, vcu, 256);
        pg8::EpiBf16G E{(bf16*)(ws + WS_AMOE), 1024, 0, 1.f / MOE_WSCALE}; pg8::gemm_phase<pg8::EpiBf16G, pg8::MoeOrder, true>(L, g, Mo, E); if (DBG_REP == 17) { GRID_BAR(); pg8::gemm_phase<pg8::EpiBf16G, pg8::MoeOrder, true>(L, g, Mo, E); } if (BOTH(17)) GRID_BAR(); }
    if (IN(18)) { combine_phase(args, gw, NGW, lane); if (DBG_REP == 18) { GRID_BAR(); combine_phase(args, gw, NGW, lane); } }
#if DBG_DUMMY
    if (IN(18)) { GRID_BAR();
#if DBG_DUMMY >= 6 && DBG_DUMMY <= 8
        constexpr int KBX = DBG_DUMMY == 6 ? 1024 : (DBG_DUMMY == 7 ? 2048 : 4096);
        pg8::Gemm g{XR, XR, 4096, KBX}; pg8::StaticOrder So; So.init(S, 8192 * 1024 / KBX, G, bx);
        pg8::EpiNone E{}; pg8::gemm_phase<pg8::EpiNone, pg8::StaticOrder, true>(L, g, So, E);
#elif DBG_DUMMY == 5
        pg8::Gemm g{ABUF, ws + WS_WGUM, 2048, 1024}; pg8::MoeOrder Mo; Mo.init((const unsigned*)(ws + WS_CTL) + CW_CNT, 28, G, vcu, 8);
        pg8::EpiNone E{}; pg8::gemm_phase<pg8::EpiNone, pg8::MoeOrder, true>(L, g, Mo, E);
#elif DBG_DUMMY == 4
        pg8::Gemm g{ABUF, ws + WS_WGUM, 2048, 1024}; pg8::StaticOrder So; So.init(4096, 57344, G, bx);
        pg8::EpiNone E{}; pg8::gemm_phase<pg8::EpiNone, pg8::StaticOrder, true>(L, g, So, E);
#elif DBG_DUMMY == 3
        pg8::Gemm g{ABUF, ws + WS_WGU0, 2048, 2048}; pg8::StaticOrder So; So.init(S, 2048, G, bx);
        pg8::EpiNone E{}; pg8::gemm_phase<pg8::EpiNone, pg8::StaticOrder, true>(L, g, So, E);
#elif DBG_DUMMY == 2
        pg8::Gemm g{ABUF, ws + WS_WGUM, 2048, 1024}; pg8::StaticOrder So; So.init(S, 4096, G, bx);
        pg8::EpiSwiGLU8 E{ws + WS_HM, DFE, 1.f / MOE_WSCALE}; pg8::gemm_phase<pg8::EpiSwiGLU8, pg8::StaticOrder, true>(L, g, So, E);
#else
        pg8::Gemm g{ABUF, ws + WS_WGUM, 2048, 1024}; pg8::StaticOrder So; So.init(S, 4096, G, bx);
        pg8::EpiNone E{}; pg8::gemm_phase<pg8::EpiNone, pg8::StaticOrder, true>(L, g, So, E);
#endif
    }
#endif
    if (IN(19)) { const f32x4* src = (const f32x4*)(DBG_STOP < 4 ? (const float*)args.in[I_X] : (const float*)XR); f32x4* dst = (f32x4*)args.out;
        for (size_t i = (size_t)vcu * NTHR + tid; i < (size_t)S * D / 4; i += (size_t)G * NTHR) dst[i] = src[i]; }
#undef IN
#undef BOTH
}

extern "C" void kernel_launch(void* const* d_in, const int* in_sizes, int n_in, void* d_out, int out_size, void* d_ws, size_t ws_size, hipStream_t stream) {
    static int grid = 0;
    if (grid == 0) {
        if (n_in != 29 || out_size != S * D || ws_size < WS_END) { fprintf(stderr, "kernel_launch: unexpected shapes (n_in %d out %d ws %zu)\n", n_in, out_size, ws_size); grid = -1; return; }
        int dev = 0, cus = 0;
        if (hipGetDevice(&dev) != hipSuccess || hipDeviceGetAttribute(&cus, hipDeviceAttributeMultiprocessorCount, dev) != hipSuccess) { grid = -1; return; }
        if (hipFuncSetAttribute((const void*)fwd_kernel, hipFuncAttributeMaxDynamicSharedMemorySize, LDS_BYTES) != hipSuccess) { grid = -1; return; }
        int per_cu = 0;
        if (hipOccupancyMaxActiveBlocksPerMultiprocessor(&per_cu, (const void*)fwd_kernel, NTHR, LDS_BYTES) != hipSuccess || per_cu < 1) fprintf(stderr, "kernel_launch: occupancy query says %d\n", per_cu);
        (void)hipGetLastError();
        grid = cus;
    }
    if (grid < 0) return;
    (void)hipMemsetAsync((char*)d_ws + WS_CTL, 0, CTL_ZERO_BYTES, stream);
    Args a{};
    for (int i = 0; i < 29; ++i) a.in[i] = d_in[i];
    a.out = (float*)d_out; a.ws = (unsigned char*)d_ws;
#if MK_MULTI
    { const int last = DBG_STOP < 0 ? N_PHASES - 1 : DBG_STOP;
      for (int p = 0; p <= last; ++p) { a.ph_lo = p; a.ph_hi = p + 1; hipLaunchKernelGGL(fwd_kernel, dim3(grid), dim3(NTHR), LDS_BYTES, stream, a); }
      if (DBG_STOP >= 0) { a.ph_lo = 19; a.ph_hi = 20; hipLaunchKernelGGL(fwd_kernel, dim3(grid), dim3(NTHR), LDS_BYTES, stream, a); } }
#else
    a.ph_lo = 0; a.ph_hi = N_PHASES;
    hipLaunchKernelGGL(fwd_kernel, dim3(grid), dim3(NTHR), LDS_BYTES, stream, a);
#endif
}
```

```cpp
#include <hip/hip_runtime.h>
#include <cstdio>
#include <cstdint>

#ifndef MK_MULTI
#define MK_MULTI 0
#endif
#ifndef FFN_FP8
#define FFN_FP8 0
#endif
#ifndef DBG_EPI2
#define DBG_EPI2 0
#endif
#ifndef DBG_DUMMY
#define DBG_DUMMY 0
#endif
#ifndef XCC_ORDER
#define XCC_ORDER 1
#endif
#ifndef DBG_QK2
#define DBG_QK2 0
#endif
#ifndef SO_WGM
#define SO_WGM 8
#endif
#ifndef FILL_G3
#define FILL_G3 1
#endif
#ifndef DBG_REP
#define DBG_REP -1
#endif
#ifndef DBG_STOP
#define DBG_STOP -1
#endif

namespace pg8 {
#define PG8_LAS __attribute__((address_space(3)))
typedef unsigned short bf16_t;
typedef short bf16x8 __attribute__((ext_vector_type(8)));
typedef float f32x4 __attribute__((ext_vector_type(4)));
typedef float f32x2 __attribute__((ext_vector_type(2)));
typedef unsigned u32x4 __attribute__((ext_vector_type(4)));
typedef unsigned u32x2 __attribute__((ext_vector_type(2)));
typedef int i32x4 __attribute__((ext_vector_type(4)));
typedef int i32x8 __attribute__((ext_vector_type(8)));
constexpr int BM = 256, BK = 64, HALF = 128, HTB = HALF * BK * 2, STAGE_BYTES = 8 * HTB, NXCD = 8, WGM = 8;

#ifndef PG8_FULL_LINE
#define PG8_FULL_LINE 1
#endif
#if PG8_FULL_LINE
__host__ __device__ __forceinline__ int lds_byte(int r, int c) { return (r >> 3) * 1024 + (r & 7) * 128 + ((((c * 2) >> 4) ^ ((r >> 1) & 7)) << 4) + ((c * 2) & 15); }
__host__ __device__ __forceinline__ void stage_rc(int b, int& R, int& C) { const int pc = b >> 10, l16 = (b & 1023) >> 4; R = pc * 8 + (l16 >> 3); C = ((l16 & 7) ^ ((R >> 1) & 7)) * 8; }
#else
__host__ __device__ __forceinline__ int lds_byte(int r, int c) { const int st = (r >> 4) * 2 + (c >> 5), rr = r & 15, cc = c & 31, ob = rr * 64 + cc * 2; return st * 1024 + (ob ^ (((ob >> 9) & 1) << 5)); }
__host__ __device__ __forceinline__ void stage_rc(int b, int& R, int& C) { const int st = b / 1024, sb = b % 1024, swz = sb ^ (((sb >> 9) & 1) << 5); R = (st >> 1) * 16 + swz / 64; C = (st & 1) * 32 + (swz % 64) / 2; }
#endif
__host__ __device__ __forceinline__ int perm32(int rho) { const int n = rho >> 4, i = rho & 15; return 8 * (i >> 2) + 4 * n + (i & 3); }

struct Unit { int pm, pn, po, pma; };
struct Gemm { const void* A; const void* Bt; int ldaB, KB; };

struct StaticOrder {
    int nM, nN, nwg, G, c;
    __device__ void init(int M, int N, int G_, int c_) { nM = M / BM; nN = N / BM; nwg = nM * nN; G = G_; c = c_; }
    __device__ bool next(int i, Unit& u) const {
        const long L = (long)i * G + c; if (L >= nwg) return false;
        int wgid = (int)L; { const int q = nwg / NXCD, r = nwg % NXCD, xcd = wgid % NXCD, off = wgid / NXCD; wgid = (xcd < r ? xcd * (q + 1) : r * (q + 1) + (xcd - r) * q) + off; }
        const int nig = SO_WGM * nN, gid = wgid / nig, fm = gid * SO_WGM, gsz = (nM - fm) < SO_WGM ? (nM - fm) : SO_WGM;
        u.pm = fm + ((wgid % nig) % gsz); u.pn = (wgid % nig) / gsz; u.po = u.pn; u.pma = u.pm; return true;
    }
};
struct MoeOrder {
    unsigned p0, p1; int nct, G, c, wgm, sparse;
    __device__ void init(const unsigned* cnt, int nct_, int G_, int c_, int wgm_, int sparse_) { wgm = wgm_; sparse = sparse_;
        p0 = 0u; p1 = 0u;
#pragma unroll
        for (int q = 0; q < 4; ++q) { p0 |= ((__hip_atomic_load(cnt + 64 * q, __ATOMIC_RELAXED, __HIP_MEMORY_SCOPE_AGENT) + 255u) >> 8) << (8 * q); p1 |= ((__hip_atomic_load(cnt + 64 * (q + 4), __ATOMIC_RELAXED, __HIP_MEMORY_SCOPE_AGENT) + 255u) >> 8) << (8 * q); }
        nct = nct_; G = G_; c = c_;
    }
    __device__ bool next(int i, Unit& u) const {
        const int L = i * G + c; int cum = 0, tb = 0; bool found = false;
#pragma unroll
        for (int q = 0; q < 8; ++q) { const int rte = (int)(((q < 4 ? p0 : p1) >> (8 * (q & 3))) & 255u); const int n_ = rte * nct;
            if (!found && L < cum + n_) { const int r_ = L - cum, nig = wgm * nct, gid = r_ / nig, fm = gid * wgm, gsz = (rte - fm) < wgm ? (rte - fm) : wgm, rem = r_ - gid * nig;
                u.pm = tb + fm + rem % gsz; u.pma = sparse ? q * 64 + fm + rem % gsz : u.pm; u.po = rem / gsz; u.pn = q * nct + u.po; found = true; } cum += n_; tb += rte; }
        return found;
    }
};

__device__ __forceinline__ unsigned cvt_pk_bf16(float lo, float hi) { unsigned r; asm volatile("v_cvt_pk_bf16_f32 %0, %1, %2" : "=v"(r) : "v"(lo), "v"(hi)); return r; }
__device__ __forceinline__ float gelu_tanh(float x) {
    const float u2 = x * (1.5957691216057308f + 0.07135481282599649f * x * x);
    return x * __builtin_amdgcn_rcpf(1.0f + __builtin_amdgcn_exp2f(-1.4426950408889634f * u2));
}
__device__ __forceinline__ float silu_f(float x) { return x * __builtin_amdgcn_rcpf(1.0f + __builtin_amdgcn_exp2f(-1.4426950408889634f * x)); }

struct EpiBf16G {
    static constexpr bool PERM = true;
    bf16_t* O; int ldc; int gelu_tiles; float scale;
    __device__ __forceinline__ void operator()(const f32x4 (&acc)[2][2][4][2], const Unit& u, int wr, int wc, int fr, int fq) const {
        const int row0 = u.pm * BM + wr * 64 + fr, col0 = u.po * BM + wc * 32 + 8 * fq; const bool g = u.po < gelu_tiles;
#pragma unroll
        for (int ai = 0; ai < 2; ++ai)
#pragma unroll
            for (int m = 0; m < 4; ++m) { bf16_t* rowp = O + (size_t)(row0 + ai * HALF + m * 16) * ldc + col0;
#pragma unroll
                for (int bj = 0; bj < 2; ++bj) { f32x4 v0 = acc[ai][bj][m][0] * scale, v1 = acc[ai][bj][m][1] * scale;
                    if (g) { v0 = (f32x4){gelu_tanh(v0[0]), gelu_tanh(v0[1]), gelu_tanh(v0[2]), gelu_tanh(v0[3])}; v1 = (f32x4){gelu_tanh(v1[0]), gelu_tanh(v1[1]), gelu_tanh(v1[2]), gelu_tanh(v1[3])}; }
                    u32x4 w; w.x = cvt_pk_bf16(v0[0], v0[1]); w.y = cvt_pk_bf16(v0[2], v0[3]); w.z = cvt_pk_bf16(v1[0], v1[1]); w.w = cvt_pk_bf16(v1[2], v1[3]);
                    *(u32x4*)(rowp + bj * HALF) = w; } }
    }
};
struct EpiSwiGLU {
    static constexpr bool PERM = true;
    bf16_t* O; int ldc;
    __device__ __forceinline__ void operator()(const f32x4 (&acc)[2][2][4][2], const Unit& u, int wr, int wc, int fr, int fq) const {
        const int row0 = u.pm * BM + wr * 64 + fr, col0 = u.po * HALF + wc * 32 + 8 * fq;
#pragma unroll
        for (int ai = 0; ai < 2; ++ai)
#pragma unroll
            for (int m = 0; m < 4; ++m) { const f32x4 g0 = acc[ai][0][m][0], g1 = acc[ai][0][m][1], u0 = acc[ai][1][m][0], u1 = acc[ai][1][m][1];
                u32x4 w; w.x = cvt_pk_bf16(silu_f(g0[0]) * u0[0], silu_f(g0[1]) * u0[1]); w.y = cvt_pk_bf16(silu_f(g0[2]) * u0[2], silu_f(g0[3]) * u0[3]);
                w.z = cvt_pk_bf16(silu_f(g1[0]) * u1[0], silu_f(g1[1]) * u1[1]); w.w = cvt_pk_bf16(silu_f(g1[2]) * u1[2], silu_f(g1[3]) * u1[3]);
                *(u32x4*)(O + (size_t)(row0 + ai * HALF + m * 16) * ldc + col0) = w; }
    }
};
__device__ __forceinline__ unsigned pk4_fp8(float a, float b, float c, float d) { int w = 0; w = __builtin_amdgcn_cvt_pk_fp8_f32(a, b, w, false); w = __builtin_amdgcn_cvt_pk_fp8_f32(c, d, w, true); return (unsigned)w; }
struct EpiSwiGLU8 {
    static constexpr bool PERM = true;
    unsigned char* O; int ldc; float scale;
    __device__ __forceinline__ void operator()(const f32x4 (&acc)[2][2][4][2], const Unit& u, int wr, int wc, int fr, int fq) const {
        const int row0 = u.pm * BM + wr * 64 + fr, col0 = u.po * HALF + wc * 32 + 8 * fq;
#pragma unroll
        for (int ai = 0; ai < 2; ++ai)
#pragma unroll
            for (int m = 0; m < 4; ++m) { const f32x4 g0 = acc[ai][0][m][0] * scale, g1 = acc[ai][0][m][1] * scale, u0 = acc[ai][1][m][0] * scale, u1 = acc[ai][1][m][1] * scale;
                u32x2 w; w.x = pk4_fp8(silu_f(g0[0]) * u0[0], silu_f(g0[1]) * u0[1], silu_f(g0[2]) * u0[2], silu_f(g0[3]) * u0[3]);
                w.y = pk4_fp8(silu_f(g1[0]) * u1[0], silu_f(g1[1]) * u1[1], silu_f(g1[2]) * u1[2], silu_f(g1[3]) * u1[3]);
                *(u32x2*)(O + (size_t)(row0 + ai * HALF + m * 16) * ldc + col0) = w; }
    }
};
struct EpiNone { static constexpr bool PERM = true;
    __device__ __forceinline__ void operator()(const f32x4 (&acc)[2][2][4][2], const Unit&, int, int, int, int) const {
#pragma unroll
        for (int ai = 0; ai < 2; ++ai)
#pragma unroll
            for (int bj = 0; bj < 2; ++bj)
#pragma unroll
                for (int m = 0; m < 4; ++m)
#pragma unroll
                    for (int n = 0; n < 2; ++n) asm volatile("" :: "v"(acc[ai][bj][m][n])); }
};
template <bool BASE16, bool OUT16>
struct EpiResT {
    static constexpr bool PERM = false;
    const void* base; void* out; const float* gate; float scale;
    __device__ __forceinline__ void operator()(const f32x4 (&acc)[2][2][4][2], const Unit& u, int wr, int wc, int fr, int fq) const {
        const int col0 = u.po * BM + wc * 32 + 4 * fq;
        f32x4 gv[2][2];
#pragma unroll
        for (int bj = 0; bj < 2; ++bj)
#pragma unroll
            for (int n = 0; n < 2; ++n) gv[bj][n] = *(const f32x4*)(gate + col0 + bj * HALF + n * 16) * scale;
#pragma unroll
        for (int ai = 0; ai < 2; ++ai)
#pragma unroll
            for (int m = 0; m < 4; ++m) { const size_t off = (size_t)(u.pm * BM + ai * HALF + wr * 64 + m * 16 + fr) * 1024 + col0;
#pragma unroll
                for (int bj = 0; bj < 2; ++bj)
#pragma unroll
                    for (int n = 0; n < 2; ++n) { const size_t o_ = off + bj * HALF + n * 16; f32x4 bs;
                        if constexpr (BASE16) { const u32x2 w = *(const u32x2*)((const bf16_t*)base + o_); bs = (f32x4){__builtin_bit_cast(float, w.x << 16), __builtin_bit_cast(float, w.x & 0xffff0000u), __builtin_bit_cast(float, w.y << 16), __builtin_bit_cast(float, w.y & 0xffff0000u)}; }
                        else bs = *(const f32x4*)((const float*)base + o_);
                        const f32x4 r = bs + gv[bj][n] * acc[ai][bj][m][n];
                        if constexpr (OUT16) { u32x2 w; w.x = cvt_pk_bf16(r[0], r[1]); w.y = cvt_pk_bf16(r[2], r[3]); *(u32x2*)((bf16_t*)out + o_) = w; }
                        else *(f32x4*)((float*)out + o_) = r; } }
    }
};

template <class Epi, class Sched, bool FP8 = false, bool ALIGN_EPI = true>
__device__ __forceinline__ void gemm_phase(PG8_LAS unsigned char* lds, const Gemm g, const Sched& S, const Epi& E) {
    const int tid = threadIdx.x, wid = __builtin_amdgcn_readfirstlane(tid >> 6), lane = tid & 63, wr = wid >> 2, wc = wid & 3, fr = lane & 15, fq = lane >> 4;
    const int KB = g.KB, nt = KB / (BK * 2), ldaB = g.ldaB;
    unsigned voffA[2], voffB[2];
#pragma unroll
    for (int i = 0; i < 2; ++i) { int R, C; stage_rc(tid * 16 + i * 8192, R, C); const int Rb = Epi::PERM ? ((R & ~31) + perm32(R & 31)) : R;
        voffA[i] = (unsigned)(R * ldaB + C * 2); voffB[i] = (unsigned)(Rb * KB + C * 2); }
    const size_t kstep = (size_t)(BK * 2);
    const size_t hstepA = (size_t)HALF * ldaB, hstepB = (size_t)HALF * KB;
    const size_t tstepA = 2 * hstepA, tstepB = 2 * hstepB;
    const unsigned ldsw = (unsigned)wid * 1024u;
    const int aoff[2] = {lds_byte(wr * 64 + fr, fq * 8), lds_byte(wr * 64 + fr, (4 + fq) * 8)}, boff[2] = {lds_byte(wc * 32 + fr, fq * 8), lds_byte(wc * 32 + fr, (4 + fq) * 8)};
#define PG8_SA(b, h) (((b) * 2 + (h)) * HTB)
#define PG8_SB(b, h) ((4 + (b) * 2 + (h)) * HTB)
#define PG8_STAGE(bufoff, gbase, voff) do { _Pragma("unroll") for (int _i = 0; _i < 2; ++_i) \
        __builtin_amdgcn_global_load_lds((const unsigned*)((const char*)(gbase) + (voff)[_i]), (PG8_LAS unsigned*)(lds + (bufoff) + ldsw + _i * 8192), 16, 0, 0); } while (0)
#define PG8_RD8(p_, q_) __builtin_shufflevector(*(const PG8_LAS i32x4*)(p_), *(const PG8_LAS i32x4*)(q_), 0, 1, 2, 3, 4, 5, 6, 7)
#define PG8_LDA(dst, b, h) do { if constexpr (FP8) { _Pragma("unroll") for (int m = 0; m < 4; ++m) dst##8[m] = PG8_RD8(lds + PG8_SA(b, h) + aoff[0] + m * 2048, lds + PG8_SA(b, h) + aoff[1] + m * 2048); } \
        else { _Pragma("unroll") for (int m = 0; m < 4; ++m) _Pragma("unroll") for (int k = 0; k < 2; ++k) dst[m][k] = *(const PG8_LAS bf16x8*)(lds + PG8_SA(b, h) + aoff[k] + m * 2048); } } while (0)
#define PG8_LDB(dst, b, h) do { if constexpr (FP8) { _Pragma("unroll") for (int n = 0; n < 2; ++n) dst##8[n] = PG8_RD8(lds + PG8_SB(b, h) + boff[0] + n * 2048, lds + PG8_SB(b, h) + boff[1] + n * 2048); } \
        else { _Pragma("unroll") for (int n = 0; n < 2; ++n) _Pragma("unroll") for (int k = 0; k < 2; ++k) dst[n][k] = *(const PG8_LAS bf16x8*)(lds + PG8_SB(b, h) + boff[k] + n * 2048); } } while (0)
#define PG8_MMA(ai, bj, At, Bt) do { __builtin_amdgcn_s_setprio(1); \
        if constexpr (FP8) { _Pragma("unroll") for (int m = 0; m < 4; ++m) _Pragma("unroll") for (int n = 0; n < 2; ++n) \
            asm volatile("v_mfma_scale_f32_16x16x128_f8f6f4 %0, %1, %2, %0, %3, %3 op_sel_hi:[0,0,0]" : "+v"(acc[ai][bj][m][n]) : "v"(Bt##8[n]), "v"(At##8[m]), "v"(sc7f)); } \
        else { _Pragma("unroll") for (int m = 0; m < 4; ++m) _Pragma("unroll") for (int n = 0; n < 2; ++n) _Pragma("unroll") for (int k = 0; k < 2; ++k) \
            acc[ai][bj][m][n] = __builtin_amdgcn_mfma_f32_16x16x32_bf16(Bt[n][k], At[m][k], acc[ai][bj][m][n], 0, 0, 0); } \
        __builtin_amdgcn_s_setprio(0); } while (0)
#define PG8_WAIT_V(n) asm volatile("s_waitcnt vmcnt(" #n ")" ::: "memory")
#define PG8_WAIT_L(n) asm volatile("s_waitcnt lgkmcnt(" #n ")" ::: "memory")
#define PG8_BAR __builtin_amdgcn_s_barrier()
#define PG8_SCHED __builtin_amdgcn_sched_barrier(0)
    Unit cur, nxt; int ui = 0;
    if (!S.next(0, cur)) return;
    f32x4 acc[2][2][4][2];
#pragma unroll
    for (int a = 0; a < 2; ++a)
#pragma unroll
        for (int b = 0; b < 2; ++b)
#pragma unroll
            for (int m = 0; m < 4; ++m)
#pragma unroll
                for (int n = 0; n < 2; ++n) acc[a][b][m][n] = (f32x4){0.f, 0.f, 0.f, 0.f};
    const int sc7f = 0x7f7f7f7f;
    bf16x8 At[4][2], B0[2][2], B1[2][2]; i32x8 At8[4], B08[2], B18[2];
    const char* cA = (const char*)g.A + (size_t)cur.pma * tstepA; const char* cB = (const char*)g.Bt + (size_t)cur.pn * tstepB;
    PG8_STAGE(PG8_SB(0, 0), cB, voffB); PG8_STAGE(PG8_SB(0, 1), cB + hstepB, voffB); PG8_STAGE(PG8_SA(0, 0), cA, voffA); PG8_STAGE(PG8_SA(0, 1), cA + hstepA, voffA);
    if (wr == 1) PG8_BAR;
    PG8_WAIT_V(2); PG8_BAR;
    PG8_STAGE(PG8_SB(1, 0), cB + kstep, voffB); PG8_STAGE(PG8_SA(1, 0), cA + kstep, voffA); PG8_STAGE(PG8_SB(1, 1), cB + hstepB + kstep, voffB);
    PG8_WAIT_V(6); PG8_BAR;
    for (;;) {
        const bool has_next = S.next(ui + 1, nxt);
        const char* nA = has_next ? (const char*)g.A + (size_t)nxt.pma * tstepA : cA; const char* nB = has_next ? (const char*)g.Bt + (size_t)nxt.pn * tstepB : cB;
#pragma nounroll
        for (int t = 0; t < nt; t += 2) {
            const bool last = (t == nt - 2);
            const char* a1 = cA + (size_t)(t + 1) * kstep;
            const char* a2 = last ? nA : cA + (size_t)(t + 2) * kstep; const char* b2 = last ? nB : cB + (size_t)(t + 2) * kstep;
            const char* a3 = a2 + kstep; const char* b3 = b2 + kstep;
            PG8_LDB(B0, 0, 0); PG8_LDB(B1, 0, 1); PG8_SCHED; PG8_LDA(At, 0, 0); PG8_STAGE(PG8_SA(1, 1), a1 + hstepA, voffA);
            PG8_WAIT_V(8); PG8_WAIT_L(0); PG8_BAR; PG8_MMA(0, 0, At, B0); PG8_MMA(0, 1, At, B1); PG8_BAR; PG8_SCHED;
            PG8_LDA(At, 0, 1); PG8_STAGE(PG8_SB(0, 0), b2, voffB); PG8_STAGE(PG8_SB(0, 1), b2 + hstepB, voffB); PG8_STAGE(PG8_SA(0, 0), a2, voffA);
            PG8_WAIT_V(8); PG8_WAIT_L(0); PG8_BAR; PG8_MMA(1, 0, At, B0); PG8_MMA(1, 1, At, B1); PG8_BAR; PG8_SCHED;
            PG8_LDB(B0, 1, 0); PG8_LDB(B1, 1, 1); PG8_SCHED; PG8_LDA(At, 1, 0); PG8_STAGE(PG8_SA(0, 1), a2 + hstepA, voffA);
            PG8_WAIT_V(8); PG8_WAIT_L(0); PG8_BAR; PG8_MMA(0, 0, At, B0); PG8_MMA(0, 1, At, B1); PG8_BAR; PG8_SCHED;
            PG8_LDA(At, 1, 1); PG8_STAGE(PG8_SB(1, 0), b3, voffB); PG8_STAGE(PG8_SB(1, 1), b3 + hstepB, voffB); PG8_STAGE(PG8_SA(1, 0), a3, voffA);
            PG8_WAIT_V(8); PG8_WAIT_L(0); PG8_BAR; PG8_MMA(1, 0, At, B0); PG8_MMA(1, 1, At, B1); PG8_BAR; PG8_SCHED;
        }
        if constexpr (ALIGN_EPI) { if (wr == 0) PG8_BAR; }
        if constexpr (FP8) asm volatile("s_nop 15\n\ts_nop 15" ::: "memory");
        E(acc, cur, wr, wc, fr, fq);
        if constexpr (FP8 && DBG_EPI2) { asm volatile("" ::: "memory"); E(acc, cur, wr, wc, fr, fq); }
        if (!has_next) break;
#pragma unroll
        for (int a = 0; a < 2; ++a)
#pragma unroll
            for (int b = 0; b < 2; ++b)
#pragma unroll
                for (int m = 0; m < 4; ++m)
#pragma unroll
                    for (int n = 0; n < 2; ++n) acc[a][b][m][n] = (f32x4){0.f, 0.f, 0.f, 0.f};
        cur = nxt; cA = nA; cB = nB; ++ui;
        if constexpr (ALIGN_EPI) { if (wr == 1) PG8_BAR; }
    }
    PG8_WAIT_V(0);
    if constexpr (!ALIGN_EPI) { if (wr == 0) PG8_BAR; }
    PG8_BAR;
#undef PG8_SA
#undef PG8_SB
#undef PG8_STAGE
#undef PG8_LDA
#undef PG8_LDB
#undef PG8_MMA
#undef PG8_RD8
#undef PG8_WAIT_V
#undef PG8_WAIT_L
#undef PG8_BAR
#undef PG8_SCHED
}
}

constexpr int NWAVES = 8, NTHR = 512;
constexpr int S = 16384, D = 1024;
constexpr int E_IN = 1536, D_FF = 2816, O_IN = 2112, O_INP = 2304, NE = 8, DFE = 3584;
constexpr int MOE_ROWS = 34816;
constexpr float EPS = 1e-6f;
constexpr float MOE_WSCALE = 64.f;

constexpr size_t MiB = 1u << 20;
constexpr size_t WS_CTL = 0, CTL_ZERO_BYTES = 1 * MiB;
constexpr size_t WS_MODP = 1 * MiB, WS_MODF = 2 * MiB, WS_ROPE = 3 * MiB;
constexpr size_t WS_TOK = 7 * MiB;
constexpr size_t WS_WIN0 = 8 * MiB, WS_WOUT0 = 11 * MiB, WS_WGU0 = 13 * MiB, WS_WD0 = 24 * MiB, WS_WIN1 = 30 * MiB;
constexpr size_t WS_WUQ = 35 * MiB, WS_WUKV = WS_WUQ + MiB / 2, WS_WOUT1 = 36 * MiB, WS_WTRIL = 38 * MiB, WS_WGT = WS_WTRIL + 131072;
constexpr size_t WS_WGUM = 40 * MiB, WS_WDM = 152 * MiB;
constexpr size_t WS_ABUF = 208 * MiB, WS_MIX = 240 * MiB, WS_XR = 272 * MiB, WS_AMOE = 336 * MiB  , WS_BIG = 404 * MiB;
constexpr size_t WS_P0 = WS_BIG, WS_H = WS_BIG + 48 * MiB;
constexpr size_t WS_P1 = WS_BIG, WS_QR = WS_BIG + 72 * MiB, WS_KVR = WS_BIG + 104 * MiB, WS_QF = WS_BIG + 136 * MiB, WS_KIMG = WS_BIG + 160 * MiB, WS_VIMG = WS_BIG + 184 * MiB;
constexpr size_t WS_PART = WS_BIG + 200 * MiB, WS_PML = WS_BIG + 232 * MiB;
constexpr size_t WS_HM = WS_BIG;
constexpr size_t WS_XRB = 660 * MiB;
constexpr size_t WS_AMOES = 692 * MiB;
constexpr size_t WS_END = 820 * MiB;
static_assert(WS_H + (size_t)S * D_FF * 2 <= WS_END && WS_VIMG + 16 * MiB <= WS_END && WS_HM + (size_t)MOE_ROWS * DFE * 2 <= WS_END, "big region");
static_assert(WS_AMOE + (size_t)MOE_ROWS * D * 2 <= WS_BIG && WS_WDM + (size_t)NE * D * DFE * 2 <= WS_ABUF && WS_WGUM + (size_t)NE * 2 * DFE * D * 2 <= WS_WDM, "map");
constexpr int CW_BAR = 4096;
constexpr int CW_CNT = 16384;
constexpr int CW_Q = 17408;
constexpr int CW_XRANK = 20480;
constexpr int CW_GD = 17472;

constexpr int RING_BYTES = 131072, LDSCTL_OFF = RING_BYTES, MISC_OFF = LDSCTL_OFF + 320, LDS_BYTES = 147456;

#define GAS __attribute__((address_space(1)))
#define LAS __attribute__((address_space(3)))
typedef unsigned short bf16;
typedef unsigned v4u __attribute__((ext_vector_type(4)));
typedef unsigned v2u __attribute__((ext_vector_type(2)));
typedef float f32x4 __attribute__((ext_vector_type(4)));
typedef float f32x16 __attribute__((ext_vector_type(16)));
typedef short bf16x8 __attribute__((ext_vector_type(8)));
typedef short s16x4 __attribute__((ext_vector_type(4)));
typedef GAS unsigned gu32;
#define RLX_AGENT __ATOMIC_RELAXED, __HIP_MEMORY_SCOPE_AGENT
#define LDS_WAIT() asm volatile("s_waitcnt lgkmcnt(0)" ::: "memory")
#define VM_WAIT() asm volatile("s_waitcnt vmcnt(0)" ::: "memory")
__device__ __forceinline__ unsigned f2bf(float f) { unsigned u = __builtin_bit_cast(unsigned, f); return (u + 0x7fffu + ((u >> 16) & 1u)) >> 16; }
__device__ __forceinline__ unsigned pk2(float lo, float hi) { return f2bf(lo) | (f2bf(hi) << 16); }
__device__ __forceinline__ float bflo(unsigned w) { return __builtin_bit_cast(float, w << 16); }
__device__ __forceinline__ float bfhi(unsigned w) { return __builtin_bit_cast(float, w & 0xffff0000u); }
__device__ __forceinline__ float wave_sum(float v) {
#pragma unroll
    for (int o = 1; o < 64; o <<= 1) v += __shfl_xor(v, o);
    return v;
}

#define XB_TMO      128
#define XB_XCNT(j)  (256  + 64 * (j))
#define XB_XSUB(j)  (1280 + 64 * (j))
#define XB_XGEN(j)  (2304 + 64 * (j))
#define XB_TOP      3328
#define XB_TOPGEN   3392
#define XCD_BAR_WORDS 3456
#define XB_SPIN_CAP (1u << 18)
__device__ __forceinline__ unsigned xb_ld(unsigned* p)              { return __hip_atomic_load(p, __ATOMIC_RELAXED, __HIP_MEMORY_SCOPE_AGENT); }
__device__ __forceinline__ unsigned xb_add(unsigned* p, unsigned v) { return __hip_atomic_fetch_add(p, v, __ATOMIC_RELAXED, __HIP_MEMORY_SCOPE_AGENT); }
__device__ __forceinline__ unsigned xb_xcc_id() { return (unsigned)__builtin_amdgcn_s_getreg((3 << 11) | 20) & 0xFu; }
#define XB_SPIN(cond, bar) do { unsigned _sp = 0; while (cond) { __builtin_amdgcn_s_sleep(1); \
    if ((++_sp & 255u) == 0u) { if (xb_ld(&(bar)[XB_TMO])) break; if (_sp > XB_SPIN_CAP) { atomicAdd(&(bar)[XB_TMO], 1u); break; } } } } while (0)
struct XcdBarrier { unsigned* bar; unsigned x; volatile LAS unsigned* st; };
__device__ __forceinline__ XcdBarrier xcd_barrier_post(unsigned* bar, volatile LAS unsigned* st) {
    XcdBarrier b; b.bar = bar; b.x = xb_xcc_id(); b.st = st;
    if (threadIdx.x == 0) (void)xb_add(&bar[XB_XCNT(b.x)], 1u);
    return b;
}
__device__ __forceinline__ void xcd_barrier_complete(unsigned* bar, unsigned x, unsigned& nloc, unsigned& nx) {
    const unsigned G = gridDim.x * gridDim.y * gridDim.z;
    unsigned sum, cnt, mine, sp = 0u;
    for (;;) {
        sum = 0u; cnt = 0u; mine = 0u;
#pragma unroll
        for (unsigned j = 0; j < 16; ++j) { const unsigned c = xb_ld(&bar[XB_XCNT(j)]); sum += c; cnt += (c > 0u) ? 1u : 0u; mine = (j == x) ? c : mine; }
        if (sum == G) break;
        __builtin_amdgcn_s_sleep(1);
        if ((++sp & 255u) == 0u) { if (xb_ld(&bar[XB_TMO])) break; if (sp > XB_SPIN_CAP) { atomicAdd(&bar[XB_TMO], 1u); break; } }
    }
    nloc = mine > 0u ? mine : 1u; nx = cnt > 0u ? cnt : 1u;
}
__device__ __forceinline__ void xcd_barrier(const XcdBarrier& b) {
    asm volatile("s_waitcnt vmcnt(0)" ::: "memory");
    __syncthreads();
    if (threadIdx.x == 0) {
        unsigned* bar = b.bar;
        __builtin_amdgcn_s_waitcnt(0);
        unsigned nloc = b.st[0], nx = b.st[1];
        if (nloc == 0u) { xcd_barrier_complete(bar, b.x, nloc, nx); b.st[0] = nloc; b.st[1] = nx; }
        const unsigned old = xb_add(&bar[XB_XSUB(b.x)], 1u);
        const unsigned gen = old / nloc;
        if (old + 1u == (gen + 1u) * nloc) {
            __builtin_amdgcn_fence(__ATOMIC_RELEASE, "agent");
            asm volatile("s_waitcnt vmcnt(0)" ::: "memory");
            const unsigned og = xb_add(&bar[XB_TOP], 1u);
            const unsigned tg = og / nx;
            if (og + 1u == (tg + 1u) * nx) xb_add(&bar[XB_TOPGEN], 1u);
            else XB_SPIN(xb_ld(&bar[XB_TOPGEN]) == tg, bar);
            __builtin_amdgcn_fence(__ATOMIC_ACQUIRE, "agent");
            xb_add(&bar[XB_XGEN(b.x)], 1u);
            asm volatile("s_waitcnt vmcnt(0)" ::: "memory");
        } else {
            XB_SPIN(xb_ld(&bar[XB_XGEN(b.x)]) == gen, bar);
            __builtin_amdgcn_fence(__ATOMIC_ACQUIRE, "agent");
            asm volatile("s_waitcnt vmcnt(0)" ::: "memory");
        }
    }
    __syncthreads();
}

struct Args { const void* in[29]; float* out; unsigned char* ws; int ph_lo, ph_hi; };
enum { I_X = 0, I_C, I_POS, I_NMW, I_NFW, I_ADAW, I_ADAB, I_EWIN, I_ALNW, I_ALNB, I_AWS, I_ABS, I_BWG, I_BSC, I_EWOUT, I_FGU, I_FDN,
       I_OWIN, I_CONV, I_QAN, I_WUQ, I_KVN, I_WUKV, I_QNW, I_KNW, I_OWOUT, I_RW, I_MGU, I_MDN };
constexpr int OFF_SHM = 0, OFF_SCM = 1024, OFF_GM = 2048, OFF_SHF = 3072, OFF_SCF = 4096, OFF_GF = 5120;

__device__ __forceinline__ void p0_mod(const float* c, const float* ada_w, float* modp, int vcu, int G, int tid) {
    for (int u = vcu; u < 384; u += G) {
        const int layer = u / 192, r = u % 192, ks = r / 12, cb = r % 12, col = cb * 512 + tid;
        const float* w = ada_w + ((size_t)layer * 1024 + ks * 64) * 6144 + col;
        float acc = 0.f;
#pragma unroll 8
        for (int k = 0; k < 64; ++k) { const float cv = c[ks * 64 + k]; const float sv = cv / (1.f + __expf(-cv)); acc += sv * w[(size_t)k * 6144]; }
        modp[(size_t)(layer * 16 + ks) * 6144 + col] = acc;
    }
}
__device__ __forceinline__ void conv_item(const float* src, int ldn, int k0, int n0, const float* kscale, bf16* dst, int ldk, int drow0, LAS float* scr, int lane) {
#pragma unroll
    for (int i = 0; i < 8; ++i) { const int kk = 8 * i + (lane >> 3); f32x4 v = *(const f32x4*)(src + (size_t)(k0 + kk) * ldn + n0 + (lane & 7) * 4);
        if (kscale) v = v * kscale[k0 + kk];
        LAS float* p = scr + kk * 33 + (lane & 7) * 4; p[0] = v.x; p[1] = v.y; p[2] = v.z; p[3] = v.w; }
    LDS_WAIT(); asm volatile("" ::: "memory");
    const int c = lane & 7;
#pragma unroll
    for (int j = 0; j < 4; ++j) { const int nn = (lane >> 3) + 8 * j; const LAS float* s = scr + (8 * c) * 33 + nn;
        v4u o; o.x = pk2(s[0 * 33], s[1 * 33]); o.y = pk2(s[2 * 33], s[3 * 33]); o.z = pk2(s[4 * 33], s[5 * 33]); o.w = pk2(s[6 * 33], s[7 * 33]);
        *(v4u*)(dst + (size_t)(drow0 + nn) * ldk + k0 + 8 * c) = o; }
    LDS_WAIT(); asm volatile("" ::: "memory");
}
__device__ __forceinline__ void conv_item8(const float* src, int ldn, int k0, int n0, float scale, unsigned char* dst, int ldkB, int drow0, LAS float* scr, int lane) {
#pragma unroll
    for (int i = 0; i < 8; ++i) { const int kk = 8 * i + (lane >> 3); const f32x4 v = *(const f32x4*)(src + (size_t)(k0 + kk) * ldn + n0 + (lane & 7) * 4) * scale;
        LAS float* p = scr + kk * 33 + (lane & 7) * 4; p[0] = v.x; p[1] = v.y; p[2] = v.z; p[3] = v.w; }
    LDS_WAIT(); asm volatile("" ::: "memory");
    const int c = lane & 7;
#pragma unroll
    for (int j = 0; j < 4; ++j) { const int nn = (lane >> 3) + 8 * j; const LAS float* s = scr + (8 * c) * 33 + nn;
        v2u o; o.x = pg8::pk4_fp8(s[0 * 33], s[1 * 33], s[2 * 33], s[3 * 33]); o.y = pg8::pk4_fp8(s[4 * 33], s[5 * 33], s[6 * 33], s[7 * 33]);
        *(v2u*)(dst + (size_t)(drow0 + nn) * ldkB + k0 + 8 * c) = o; }
    LDS_WAIT(); asm volatile("" ::: "memory");
}
__device__ __forceinline__ int gu_row(int n0, int half) { return n0 < half ? (n0 >> 7) * 256 + (n0 & 127) : ((n0 - half) >> 7) * 256 + 128 + ((n0 - half) & 127); }
constexpr int LATE_GU = 8 * 16 * 224, LATE_DN = 8 * 56 * 32, N_LATE = LATE_GU + LATE_DN, LATE_CHUNK = 16;
__device__ __forceinline__ void conv_late_item(const Args& a, int r, LAS float* scr, int lane) {
    unsigned char* ws = a.ws;
    if (r < LATE_GU) { const int e = r / (16 * 224), q = r % (16 * 224), kb = q / 224, nb = q % 224;
        conv_item8((const float*)a.in[I_MGU] + (size_t)e * 1024 * 7168, 7168, kb * 64, nb * 32, MOE_WSCALE, ws + WS_WGUM + (size_t)e * 7168 * 1024, 1024, gu_row(nb * 32, DFE), scr, lane); }
    else { r -= LATE_GU; const int e = r / (56 * 32), q = r % (56 * 32), kb = q / 32, nb = q % 32;
        conv_item8((const float*)a.in[I_MDN] + (size_t)e * DFE * 1024, 1024, kb * 64, nb * 32, MOE_WSCALE, ws + WS_WDM + (size_t)e * 1024 * DFE, DFE, nb * 32, scr, lane); }
}
__device__ __forceinline__ void conv_fill(const Args& a, LAS unsigned char* lds, unsigned* gdone, int G, int tid) {
    unsigned* qhead = (unsigned*)(a.ws + WS_CTL) + CW_Q; const int lane = tid & 63, wave = __builtin_amdgcn_readfirstlane(tid >> 6);
    LAS float* scr = (LAS float*)(lds + wave * 16384); volatile LAS int* qb = (volatile LAS int*)(lds + 131056);
    __syncthreads();
    if (gdone && tid == 0) (void)__hip_atomic_fetch_add(gdone, 1u, RLX_AGENT);
    for (;;) {
        if (tid == 0) { int v = -1;
            if (!gdone || __hip_atomic_load(gdone, RLX_AGENT) < (unsigned)G) { v = (int)__hip_atomic_fetch_add(qhead, (unsigned)LATE_CHUNK, RLX_AGENT); if (v >= N_LATE) v = -1; }
            *qb = v; }
        __syncthreads();
        const int base = *qb;
        __syncthreads();
        if (base < 0) break;
        for (int it = base + wave; it < base + LATE_CHUNK && it < N_LATE; it += NWAVES) conv_late_item(a, it, scr, lane);
    }
}
__device__ __forceinline__ void p0_prologue(const Args& a, LAS unsigned char* lds, int vcu, int G, int tid) {
    unsigned char* ws = a.ws; const int lane = tid & 63, wave = __builtin_amdgcn_readfirstlane(tid >> 6);
    p0_mod((const float*)a.in[I_C], (const float*)a.in[I_ADAW], (float*)(ws + WS_MODP), vcu, G, tid);
    const int gt = vcu * NTHR + tid, NGT = G * NTHR;
    { const int* pos = (const int*)a.in[I_POS]; float* cosT = (float*)(ws + WS_ROPE); float* sinT = cosT + (size_t)S * 32;
      for (int i = gt; i < S * 32; i += NGT) { const int t = i >> 5, f = i & 31; const float inv = (float)exp(-(double)f * (9.210340371976184 / 32.0));
          const float ang = (float)pos[t] * inv; const double ad = (double)ang;
          const double k = __builtin_rint(ad * 0.15915494309189535); const double r = __builtin_fma(-k, 6.283185307179586, ad) - k * 2.4492935982947064e-16;
          cosT[i] = cosf((float)r); sinT[i] = sinf((float)r); } }
    { const float* aws = (const float*)a.in[I_AWS]; bf16* wt = (bf16*)(ws + WS_WTRIL);
      for (int i = gt; i < 4 * 128 * 128 / 2; i += NGT) { const int e = 2 * i, s = e & 127, t = (e >> 7) & 127; const float v0 = s <= t ? aws[e] : 0.f, v1 = (s + 1) <= t ? aws[e + 1] : 0.f; ((unsigned*)wt)[i] = pk2(v0, v1); } }
    { v4u z = {0u, 0u, 0u, 0u}; v4u* p1 = (v4u*)(ws + WS_WIN1 + (size_t)O_IN * 1024 * 2);
      for (int i = gt; i < (O_INP - O_IN) * 1024 * 2 / 16; i += NGT) p1[i] = z;
      for (int i = gt; i < 4 * 64 * 256 * 2 / 16; i += NGT) { const int h = i / (64 * 32), r = i % (64 * 32); ((v4u*)(ws + WS_WUQ + (size_t)(h * 256 + 192) * 256 * 2))[r] = z; } }
    LAS float* scr = (LAS float*)(lds + wave * 16384);
    const int gw = vcu * NWAVES + wave, NGW = G * NWAVES;
    constexpr int I0 = 16 * 48, I1 = 16 * 32, I2 = 16 * 176, I3 = 44 * 32, I4 = 16 * 66, I5 = 4 * 24, I6 = 4 * 32, I7 = 16 * 32, I8 = 4 * 8;
    constexpr int NITEMS = I0 + I1 + I2 + I3 + I4 + I5 + I6 + I7 + I8;
    for (int it = gw; it < NITEMS; it += NGW) {
        int r = it;
        if (r < I0) { conv_item((const float*)a.in[I_EWIN], E_IN, (r / 48) * 64, (r % 48) * 32, nullptr, (bf16*)(ws + WS_WIN0), 1024, (r % 48) * 32, scr, lane); continue; } r -= I0;
        if (r < I1) { conv_item((const float*)a.in[I_EWOUT], 1024, (r / 32) * 64, (r % 32) * 32, nullptr, (bf16*)(ws + WS_WOUT0), 1024, (r % 32) * 32, scr, lane); continue; } r -= I1;
#if FFN_FP8
        if (r < I2) { conv_item8((const float*)a.in[I_FGU], 2 * D_FF, (r / 176) * 64, (r % 176) * 32, MOE_WSCALE, ws + WS_WGU0, 1024, gu_row((r % 176) * 32, D_FF), scr, lane); continue; } r -= I2;
        if (r < I3) { conv_item8((const float*)a.in[I_FDN], 1024, (r / 32) * 64, (r % 32) * 32, MOE_WSCALE, ws + WS_WD0, D_FF, (r % 32) * 32, scr, lane); continue; } r -= I3;
#else
        if (r < I2) { conv_item((const float*)a.in[I_FGU], 2 * D_FF, (r / 176) * 64, (r % 176) * 32, nullptr, (bf16*)(ws + WS_WGU0), 1024, gu_row((r % 176) * 32, D_FF), scr, lane); continue; } r -= I2;
        if (r < I3) { conv_item((const float*)a.in[I_FDN], 1024, (r / 32) * 64, (r % 32) * 32, nullptr, (bf16*)(ws + WS_WD0), D_FF, (r % 32) * 32, scr, lane); continue; } r -= I3;
#endif
        if (r < I4) { conv_item((const float*)a.in[I_OWIN], O_IN, (r / 66) * 64, (r % 66) * 32, nullptr, (bf16*)(ws + WS_WIN1), 1024, (r % 66) * 32, scr, lane); continue; } r -= I4;
        if (r < I5) { const int n0 = (r % 24) * 32; conv_item((const float*)a.in[I_WUQ], 768, (r / 24) * 64, n0, (const float*)a.in[I_QAN], (bf16*)(ws + WS_WUQ), 256, (n0 / 192) * 256 + n0 % 192, scr, lane); continue; } r -= I5;
        if (r < I6) { conv_item((const float*)a.in[I_WUKV], 1024, (r / 32) * 64, (r % 32) * 32, (const float*)a.in[I_KVN], (bf16*)(ws + WS_WUKV), 256, (r % 32) * 32, scr, lane); continue; } r -= I6;
        if (r < I7) { conv_item((const float*)a.in[I_OWOUT], 1024, (r / 32) * 64, (r % 32) * 32, nullptr, (bf16*)(ws + WS_WOUT1), 1024, (r % 32) * 32, scr, lane); continue; } r -= I7;
        { const int g = r / 8, q = r % 8; conv_item((const float*)a.in[I_BWG] + (size_t)g * 16384, 128, (q / 4) * 64, (q % 4) * 32, nullptr, (bf16*)(ws + WS_WGT) + (size_t)g * 16384, 128, (q % 4) * 32, scr, lane); }
    }
}

__device__ __forceinline__ float modv_partial(const float* modp, const float* ada_b, int layer, int idx) {
    float s = ada_b[layer * 6144 + idx];
#pragma unroll
    for (int ks = 0; ks < 16; ++ks) s += modp[(size_t)(layer * 16 + ks) * 6144 + idx];
    return s;
}
template <bool PARTIAL, bool OUT8 = false, bool IN16 = false>
__device__ __forceinline__ void norm_phase(const Args& a, const void* xin_, bf16* out, const float* nw, int layer, int off_sh, int off_sc, int gw, int NGW, int lane, LAS float* lmod = nullptr) {
    const float* modp = (const float*)(a.ws + WS_MODP); const float* modF = (const float*)(a.ws + WS_MODF); const float* ada_b = (const float*)a.in[I_ADAB];
    if (PARTIAL) {
        for (int i = threadIdx.x; i < 2048; i += NTHR) lmod[i] = modv_partial(modp, ada_b, layer, (i < 1024 ? off_sc : off_sh - 1024) + i);
        __syncthreads();
    }
    f32x4 g[4], sh[4];
#pragma unroll
    for (int j = 0; j < 4; ++j)
#pragma unroll
        for (int e = 0; e < 4; ++e) { const int col = 4 * lane + e + 256 * j; float scv, shv;
            if (PARTIAL) { scv = lmod[col]; shv = lmod[1024 + col]; }
            else { scv = modF[layer * 6144 + off_sc + col]; shv = modF[layer * 6144 + off_sh + col]; }
            g[j][e] = nw[col] * (1.f + scv); sh[j][e] = shv; }
    for (int m = gw; m < S; m += NGW) {
        f32x4 v[4]; float s = 0.f;
        if constexpr (IN16) { const v2u* xr = (const v2u*)((const bf16*)xin_ + (size_t)m * D) + lane;
#pragma unroll
            for (int j = 0; j < 4; ++j) { const v2u w = xr[64 * j]; v[j] = (f32x4){bflo(w.x), bfhi(w.x), bflo(w.y), bfhi(w.y)}; } }
        else { const f32x4* xr = (const f32x4*)((const float*)xin_ + (size_t)m * D) + lane;
#pragma unroll
            for (int j = 0; j < 4; ++j) v[j] = xr[64 * j]; }
#pragma unroll
        for (int j = 0; j < 4; ++j) s += (v[j].x * v[j].x + v[j].y * v[j].y) + (v[j].z * v[j].z + v[j].w * v[j].w);
        const float rstd = 1.f / sqrtf(wave_sum(s) * (1.f / D) + EPS);
        if constexpr (OUT8) { unsigned* o4 = (unsigned*)((unsigned char*)out + (size_t)m * D) + lane;
#pragma unroll
            for (int j = 0; j < 4; ++j) { const f32x4 y = v[j] * rstd * g[j] + sh[j]; o4[64 * j] = pg8::pk4_fp8(y.x, y.y, y.z, y.w); } }
        else { unsigned long long* o8 = (unsigned long long*)(out + (size_t)m * D) + lane;
#pragma unroll
            for (int j = 0; j < 4; ++j) { const f32x4 y = v[j] * rstd * g[j] + sh[j]; o8[64 * j] = (unsigned long long)pk2(y.x, y.y) | ((unsigned long long)pk2(y.z, y.w) << 32); } }
    }
}

__device__ __forceinline__ void mixab_phase(const Args& a, LAS unsigned char* lds, int vcu, int G, int tid) {
    const bf16* P0 = (const bf16*)(a.ws + WS_P0); bf16* MIX = (bf16*)(a.ws + WS_MIX);
    const bf16* Wtril = (const bf16*)(a.ws + WS_WTRIL); const bf16* wgT = (const bf16*)(a.ws + WS_WGT);
    const float* ln_w = (const float*)a.in[I_ALNW]; const float* ln_b = (const float*)a.in[I_ALNB]; const float* b_s = (const float*)a.in[I_ABS]; const float* b_sc = (const float*)a.in[I_BSC];
    const int lane = tid & 63, wave = __builtin_amdgcn_readfirstlane(tid >> 6), fr = lane & 15, fq = lane >> 4;
    LAS bf16* vnT = (LAS bf16*)lds;
    LAS bf16* poolS = (LAS bf16*)(lds + 34816);
    LAS bf16* ppS = (LAS bf16*)(lds + 69632);
    LAS float* stat = (LAS float*)(lds + 69632 + 39168);
    for (int u = vcu; u < 512; u += G) {
        const int n = u >> 2, g = u & 3, t0 = n * 128;
        v4u rawv[16];
#pragma unroll
        for (int rr = 0; rr < 16; ++rr) rawv[rr] = *(const v4u*)(P0 + (size_t)(t0 + wave * 16 + rr) * E_IN + 512 + lane * 8);
#pragma unroll
        for (int rr = 0; rr < 16; ++rr) { const int row = wave * 16 + rr;
            const v4u raw = rawv[rr];
            float x[8] = {bflo(raw.x), bfhi(raw.x), bflo(raw.y), bfhi(raw.y), bflo(raw.z), bfhi(raw.z), bflo(raw.w), bfhi(raw.w)};
            float s = 0.f;
#pragma unroll
            for (int j = 0; j < 8; ++j) s += x[j];
            const float mu = wave_sum(s) * (1.f / 512.f); float q = 0.f;
#pragma unroll
            for (int j = 0; j < 8; ++j) { const float d = x[j] - mu; q += d * d; }
            const float rstd = 1.f / sqrtf(wave_sum(q) * (1.f / 512.f) + EPS);
            if (lane == 0) { stat[row * 2] = mu; stat[row * 2 + 1] = rstd; } }
        for (int i = tid; i < 144 * 16; i += NTHR) { const int r = i >> 4, c8 = i & 15, t = t0 - 16 + r; v4u v = {0u, 0u, 0u, 0u};
            if (t >= 0) v = *(const v4u*)(P0 + (size_t)t * E_IN + 1024 + g * 128 + c8 * 8);
            *(LAS v4u*)(ppS + r * 136 + c8 * 8) = v; }
        __syncthreads();
        { const int s = tid & 127, dq = tid >> 7; const float mu = stat[s * 2], rstd = stat[s * 2 + 1];
#pragma unroll
          for (int cc = 0; cc < 4; ++cc) { const int d0 = dq * 32 + cc * 8; const v4u raw = *(const v4u*)(P0 + (size_t)(t0 + s) * E_IN + 512 + g * 128 + d0);
              float x[8] = {bflo(raw.x), bfhi(raw.x), bflo(raw.y), bfhi(raw.y), bflo(raw.z), bfhi(raw.z), bflo(raw.w), bfhi(raw.w)};
#pragma unroll
              for (int j = 0; j < 8; ++j) { const int ch = g * 128 + d0 + j; vnT[(d0 + j) * 136 + s] = (bf16)f2bf((x[j] - mu) * rstd * ln_w[ch] + ln_b[ch]); } } }
        { const int t = tid & 127, q4 = tid >> 7, w = 2 << g, tg = t0 + t; const float inv = 1.f / (float)((tg + 1) < w ? (tg + 1) : w);
#pragma unroll
          for (int cc = 0; cc < 4; ++cc) { const int ch = q4 * 32 + cc * 8; float acc[8] = {0.f, 0.f, 0.f, 0.f, 0.f, 0.f, 0.f, 0.f};
              for (int j = 0; j < w; ++j) { const v4u r = *(const LAS v4u*)(ppS + (16 + t - j) * 136 + ch);
                  acc[0] += bflo(r.x); acc[1] += bfhi(r.x); acc[2] += bflo(r.y); acc[3] += bfhi(r.y); acc[4] += bflo(r.z); acc[5] += bfhi(r.z); acc[6] += bflo(r.w); acc[7] += bfhi(r.w); }
              const v4u c0 = *(const LAS v4u*)(ppS + (16 + t) * 136 + ch);
              v4u o; o.x = pk2(acc[0] * inv - bflo(c0.x), acc[1] * inv - bfhi(c0.x)); o.y = pk2(acc[2] * inv - bflo(c0.y), acc[3] * inv - bfhi(c0.y));
              o.z = pk2(acc[4] * inv - bflo(c0.z), acc[5] * inv - bfhi(c0.z)); o.w = pk2(acc[6] * inv - bflo(c0.w), acc[7] * inv - bfhi(c0.w));
              *(LAS v4u*)(poolS + t * 136 + ch) = o; } }
        __syncthreads();
        const int m0 = wave * 16, trow = t0 + m0 + fr;
        f32x4 acc[8];
#pragma unroll
        for (int nb = 0; nb < 8; ++nb) acc[nb] = (f32x4){0.f, 0.f, 0.f, 0.f};
#pragma unroll
        for (int kk = 0; kk < 4; ++kk) { const bf16x8 af = *(const bf16x8*)(Wtril + ((size_t)g * 128 + m0 + fr) * 128 + kk * 32 + fq * 8);
#pragma unroll
            for (int nb = 0; nb < 8; ++nb) { const bf16x8 bfr = *(const LAS bf16x8*)(vnT + (nb * 16 + fr) * 136 + kk * 32 + fq * 8); acc[nb] = __builtin_amdgcn_mfma_f32_16x16x32_bf16(bfr, af, acc[nb], 0, 0, 0); } }
        { const float bias = b_s[g * 128 + m0 + fr];
#pragma unroll
          for (int nb = 0; nb < 8; ++nb) { const int col = g * 128 + nb * 16 + 4 * fq; const v2u uv = *(const v2u*)(P0 + (size_t)trow * E_IN + col);
              v2u o; o.x = pk2(bflo(uv.x) * (acc[nb][0] + bias), bfhi(uv.x) * (acc[nb][1] + bias)); o.y = pk2(bflo(uv.y) * (acc[nb][2] + bias), bfhi(uv.y) * (acc[nb][3] + bias));
              *(v2u*)(MIX + (size_t)trow * D + col) = o; } }
#pragma unroll
        for (int nb = 0; nb < 8; ++nb) acc[nb] = (f32x4){0.f, 0.f, 0.f, 0.f};
#pragma unroll
        for (int kk = 0; kk < 4; ++kk) { const bf16x8 af = *(const LAS bf16x8*)(poolS + (m0 + fr) * 136 + kk * 32 + fq * 8);
#pragma unroll
            for (int nb = 0; nb < 8; ++nb) { const bf16x8 bfr = *(const bf16x8*)(wgT + ((size_t)g * 128 + nb * 16 + fr) * 128 + kk * 32 + fq * 8); acc[nb] = __builtin_amdgcn_mfma_f32_16x16x32_bf16(bfr, af, acc[nb], 0, 0, 0); } }
#pragma unroll
        for (int nb = 0; nb < 8; ++nb) { const int e = g * 128 + nb * 16 + 4 * fq; const f32x4 sc = *(const f32x4*)(b_sc + e);
            v2u o; o.x = pk2(acc[nb][0] * sc.x, acc[nb][1] * sc.y); o.y = pk2(acc[nb][2] * sc.z, acc[nb][3] * sc.w);
            *(v2u*)(MIX + (size_t)trow * D + 512 + e) = o; }
        __syncthreads();
    }
}

namespace att {
constexpr int KSLOT = 24576, VSLOT = 16384, NSLOT = 3, LDS_K = 0, LDS_V = NSLOT * KSLOT, LDS_WS = LDS_V + NSLOT * VSLOT;
constexpr float SCALE = 0.07216878364870323f;
constexpr float THR = 8.f;
__device__ __forceinline__ int k_nope_off(int row, int colB) { return row * 256 + (colB ^ ((row & 7) << 4)); }
__device__ __forceinline__ int k_rope_off(int row, int cB) { return 16384 + row * 128 + (cB ^ (((row >> 1) & 7) << 4)); }
__device__ __forceinline__ int v_st(int k, int c) { const int kk = (k & ~0xC) | ((k & 4) << 1) | ((k & 8) >> 1); return ((kk >> 3) * 4 + (c >> 5)) * 512 + ((kk & 7) * 32 + (c & 31)) * 2; }
__device__ __forceinline__ int v_rd_base(int lane) { return ((lane & 3) << 3) | (((lane >> 2) & 3) << 6) | (((lane >> 4) & 1) << 5) | (((lane >> 5) & 1) << 8); }
constexpr int v_rd_off(int d0, int ks, int half) { return d0 * 512 + ks * 4096 + half * 2048; }
__device__ __forceinline__ int crow(int r, int hi) { return (r & 3) + 8 * (r >> 2) + 4 * hi; }
__device__ __forceinline__ unsigned cvtpk(float lo, float hi) { unsigned r; asm volatile("v_cvt_pk_bf16_f32 %0, %1, %2" : "=v"(r) : "v"(lo), "v"(hi)); return r; }
#define SBAR() __builtin_amdgcn_sched_barrier(0)
__device__ __forceinline__ void mask_tile(f32x16& p0, f32x16& p1, int dq) {
    const float NEG = -__builtin_inff();
#pragma unroll
    for (int r = 0; r < 16; ++r) { const int c = (r & 3) + 8 * (r >> 2); if (dq - c < 0) p0[r] = NEG; if (dq - c - 32 < 0) p1[r] = NEG; }
}
__device__ __forceinline__ void partialSM(f32x16& p0, f32x16& p1, float& m_reg, float& mn, float& alpha) {
    float pmax = p0[0];
#pragma unroll
    for (int r = 1; r < 16; ++r) pmax = fmaxf(pmax, p0[r]);
#pragma unroll
    for (int r = 0; r < 16; ++r) pmax = fmaxf(pmax, p1[r]);
    { auto rr = __builtin_amdgcn_permlane32_swap(__float_as_uint(pmax), __float_as_uint(pmax), false, false); pmax = fmaxf(__uint_as_float(rr[0]), __uint_as_float(rr[1])); }
    constexpr float C2 = 1.4426950408889634f * SCALE;
    if (__builtin_expect(__all((pmax - m_reg) * SCALE <= THR), 1)) { mn = m_reg; alpha = 1.f; }
    else { mn = fmaxf(m_reg, pmax); alpha = __builtin_amdgcn_exp2f((m_reg - mn) * C2); m_reg = mn; }
    const float mnL = -mn * C2;
#pragma unroll
    for (int r = 0; r < 16; ++r) p0[r] = fmaf(p0[r], C2, mnL);
#pragma unroll
    for (int r = 0; r < 16; ++r) p1[r] = fmaf(p1[r], C2, mnL);
#pragma unroll
    for (int r = 0; r < 16; ++r) p0[r] = __builtin_amdgcn_exp2f(p0[r]);
}
__device__ __forceinline__ void finishSM(f32x16& p0, f32x16& p1, float alpha, float& l_reg, bf16x8& pa0, bf16x8& pa1, bf16x8& pa2, bf16x8& pa3) {
#pragma unroll
    for (int r = 0; r < 16; ++r) p1[r] = __builtin_amdgcn_exp2f(p1[r]);
    float ps = 0;
#pragma unroll
    for (int r = 0; r < 16; ++r) ps += p0[r];
#pragma unroll
    for (int r = 0; r < 16; ++r) ps += p1[r];
    { auto rr = __builtin_amdgcn_permlane32_swap(__float_as_uint(ps), __float_as_uint(ps), false, false); ps = __uint_as_float(rr[0]) + __uint_as_float(rr[1]); }
    l_reg = l_reg * alpha + ps;
#define PK4(P, B_, OUT) do { unsigned a0 = cvtpk(P[B_+0], P[B_+1]), a1 = cvtpk(P[B_+2], P[B_+3]);                          \
        unsigned b0 = cvtpk(P[B_+4], P[B_+5]), b1 = cvtpk(P[B_+6], P[B_+7]);                                             \
        auto r0 = __builtin_amdgcn_permlane32_swap(a0, b0, false, false); auto r1 = __builtin_amdgcn_permlane32_swap(a1, b1, false, false); \
        v4u w = {r0[0], r1[0], r0[1], r1[1]}; OUT = __builtin_bit_cast(bf16x8, w); } while (0)
    PK4(p0, 0, pa0); PK4(p0, 8, pa1); PK4(p1, 0, pa2); PK4(p1, 8, pa3);
#undef PK4
}
__device__ __forceinline__ void qkt(f32x16& p0, f32x16& p1, const LAS char* Kl, int r32, int hi, const bf16x8* qr) {
    p0 = f32x16{}; p1 = f32x16{};
    const LAS char* kb[4];
#pragma unroll
    for (int dd = 0; dd < 4; ++dd) kb[dd] = Kl + k_nope_off(r32, (dd * 16 + hi * 8) * 2);
#pragma unroll
    for (int d0 = 0; d0 < 8; ++d0) { const LAS char* ap = kb[d0 & 3] + (d0 >> 2) * 128;
        const bf16x8 b0 = *(const LAS bf16x8*)ap; const bf16x8 b1 = *(const LAS bf16x8*)(ap + 32 * 256);
        p0 = __builtin_amdgcn_mfma_f32_32x32x16_bf16(b0, qr[d0], p0, 0, 0, 0);
        p1 = __builtin_amdgcn_mfma_f32_32x32x16_bf16(b1, qr[d0], p1, 0, 0, 0); }
#pragma unroll
    for (int dr = 0; dr < 4; ++dr) { const LAS char* ap = Kl + k_rope_off(r32, dr * 32 + hi * 16);
        const bf16x8 b0 = *(const LAS bf16x8*)ap; const bf16x8 b1 = *(const LAS bf16x8*)(ap + 32 * 128);
        p0 = __builtin_amdgcn_mfma_f32_32x32x16_bf16(b0, qr[8 + dr], p0, 0, 0, 0);
        p1 = __builtin_amdgcn_mfma_f32_32x32x16_bf16(b1, qr[8 + dr], p1, 0, 0, 0); }
}
__device__ __forceinline__ void pv_tile(f32x16* o, int vb0, bf16x8 pa0, bf16x8 pa1, bf16x8 pa2, bf16x8 pa3) {
#define TRRD(dst, off) asm volatile("ds_read_b64_tr_b16 %0, %1 offset:%2" : "=&v"(dst) : "v"(vb0), "i"(off) : "memory")
#define PV_LD(S_, d0, hf) do { constexpr int b_ = v_rd_off(d0, 2 * (hf), 0); TRRD(S_##l0, b_); TRRD(S_##h0, b_ + 2048); TRRD(S_##l1, b_ + 4096); TRRD(S_##h1, b_ + 6144); } while (0)
#define PV_MM(S_, d0, PA, PB) do { \
        o[d0] = __builtin_amdgcn_mfma_f32_32x32x16_bf16(PA, (bf16x8){S_##l0[0], S_##l0[1], S_##l0[2], S_##l0[3], S_##h0[0], S_##h0[1], S_##h0[2], S_##h0[3]}, o[d0], 0, 0, 0);   \
        o[d0] = __builtin_amdgcn_mfma_f32_32x32x16_bf16(PB, (bf16x8){S_##l1[0], S_##l1[1], S_##l1[2], S_##l1[3], S_##h1[0], S_##h1[1], S_##h1[2], S_##h1[3]}, o[d0], 0, 0, 0); } while (0)
#define PV_W4() do { asm volatile("s_waitcnt lgkmcnt(4)" ::: "memory"); SBAR(); } while (0)
    s16x4 Al0, Al1, Ah0, Ah1, Bl0, Bl1, Bh0, Bh1;
    PV_LD(A, 0, 0); PV_LD(B, 0, 1);
    PV_W4(); PV_MM(A, 0, pa0, pa1); SBAR(); PV_LD(A, 1, 0);
    PV_W4(); PV_MM(B, 0, pa2, pa3); SBAR(); PV_LD(B, 1, 1);
    PV_W4(); PV_MM(A, 1, pa0, pa1); SBAR(); PV_LD(A, 2, 0);
    PV_W4(); PV_MM(B, 1, pa2, pa3); SBAR(); PV_LD(B, 2, 1);
    PV_W4(); PV_MM(A, 2, pa0, pa1); SBAR(); PV_LD(A, 3, 0);
    PV_W4(); PV_MM(B, 2, pa2, pa3); SBAR(); PV_LD(B, 3, 1);
    PV_W4(); PV_MM(A, 3, pa0, pa1); SBAR();
    asm volatile("s_waitcnt lgkmcnt(0)" ::: "memory"); SBAR(); PV_MM(B, 3, pa2, pa3);
#undef PV_LD
#undef PV_MM
#undef PV_W4
#undef TRRD
}
__device__ __forceinline__ void glds16(const void* gsrc, unsigned lds_dst) { unsigned keep;
    asm volatile("s_mov_b32 %0, m0\n\ts_mov_b32 m0, %2\n\ts_nop 0\n\tglobal_load_lds_dwordx4 %1, off\n\ts_mov_b32 m0, %0" : "=&s"(keep) : "v"(gsrc), "s"(lds_dst) : "memory"); }
#define WAITBAR0() asm volatile("s_waitcnt vmcnt(0) lgkmcnt(0)\n\ts_barrier" ::: "memory")

__device__ __forceinline__ void attn_block(int h, int qb, int j_lo, int j_hi, int part, const bf16* QF, const unsigned char* KIMG, const unsigned char* VIMG, bf16* MIX, float* PART, float* PML, char* lds) {
    const int tid = threadIdx.x, wid = __builtin_amdgcn_readfirstlane(tid >> 6), lane = tid & 63, r32 = lane & 31, hi = lane >> 5;
    const int NT = j_hi - j_lo, q0 = qb * 256, qlo = q0 + wid * 32, qm = qlo + r32 - 4 * hi;
    const unsigned lds0 = (unsigned)(uintptr_t)lds;
    const LAS char* Kl = (const LAS char*)lds + LDS_K;
    LAS float* wsf = (LAS float*)((LAS char*)lds + LDS_WS) + wid * 64; LAS float* li_l = wsf; LAS float* al_l = wsf + 32;
    const int vb0 = (int)(lds0 + LDS_V) + v_rd_base(lane);
    const unsigned char* kimg = KIMG + ((size_t)h * 256 + j_lo) * KSLOT + (size_t)(3 * wid) * 1024 + lane * 16;
    const unsigned char* vimg = VIMG + ((size_t)h * 256 + j_lo) * VSLOT + (size_t)(2 * wid) * 1024 + lane * 16;
    const unsigned kdst = lds0 + LDS_K + (3 * wid) * 1024, vdst = lds0 + LDS_V + (2 * wid) * 1024;
#define DMA_K(t, soff) do { const unsigned char* s_ = kimg + (size_t)(t) * KSLOT; const unsigned d_ = (unsigned)__builtin_amdgcn_readfirstlane(kdst + (soff)); \
        glds16(s_, d_); glds16(s_ + 1024, d_ + 1024); glds16(s_ + 2048, d_ + 2048); } while (0)
#define DMA_V(t, soff) do { const unsigned char* s_ = vimg + (size_t)(t) * VSLOT; const unsigned d_ = (unsigned)__builtin_amdgcn_readfirstlane(vdst + (soff)); \
        glds16(s_, d_); glds16(s_ + 1024, d_ + 1024); } while (0)
    bf16x8 qr[12];
    { const bf16* qp = QF + ((size_t)h * S + q0 + wid * 32 + r32) * 192 + hi * 8;
#pragma unroll
      for (int d0 = 0; d0 < 12; ++d0) qr[d0] = *(const bf16x8*)(qp + d0 * 16); }
    int k0 = 0, k1 = KSLOT, k2 = 2 * KSLOT, vp = 2 * VSLOT, vc = 0, vn = VSLOT;
    DMA_K(0, k0); DMA_K(1, k1); DMA_V(0, vc);
    float m_reg = -1e30f, l_reg = 0.f; f32x16 o[4]; o[0] = f32x16{}; o[1] = f32x16{}; o[2] = f32x16{}; o[3] = f32x16{};
    f32x16 pA0, pA1, pB0, pB1; float mnA, mnB, alA = 1.f, alB = 1.f; bf16x8 pa0, pa1, pa2, pa3;
#define RESC(a_) do { if (__any((a_) < 1.f)) { if (hi == 0) al_l[r32] = (a_); asm volatile("s_waitcnt lgkmcnt(0)" ::: "memory"); \
        _Pragma("unroll") for (int d_ = 0; d_ < 4; ++d_) _Pragma("unroll") for (int r = 0; r < 16; ++r) o[d_][r] *= al_l[crow(r, hi)]; } } while (0)
#define MASKT(P0_, P1_, t) do { const int kb_ = (j_lo + (t)) * 64; if (kb_ + 63 > qlo) mask_tile(P0_, P1_, qm - kb_); } while (0)
#define OPEN(t) do { if ((t) + 1 < NT) asm volatile("s_waitcnt vmcnt(5) lgkmcnt(0)\n\ts_barrier" ::: "memory"); \
        else if ((t) < NT) asm volatile("s_waitcnt vmcnt(2) lgkmcnt(0)\n\ts_barrier" ::: "memory"); else asm volatile("s_waitcnt vmcnt(0) lgkmcnt(0)\n\ts_barrier" ::: "memory"); \
        if ((t) + 2 < NT) DMA_K((t) + 2, k2); if ((t) + 1 < NT) DMA_V((t) + 1, vn); } while (0)
#define ROT() do { int t_ = k0; k0 = k1; k1 = k2; k2 = t_; t_ = vp; vp = vc; vc = vn; vn = t_; } while (0)
    if (wid >= 4) __builtin_amdgcn_s_setprio(1);
    if (wid < 4) {
    OPEN(0);
    SBAR(); qkt(pA0, pA1, Kl + k0, r32, hi, qr); MASKT(pA0, pA1, 0); partialSM(pA0, pA1, m_reg, mnA, alA); ROT();
#define STEP(PX0, PX1, mnX, alX, PY0, PY1, alY, t) do { \
        OPEN(t); \
        SBAR(); qkt(PX0, PX1, Kl + k0, r32, hi, qr); if (DBG_QK2) { asm volatile("" : "+v"(PX0), "+v"(PX1)); qkt(PX0, PX1, Kl + k0, r32, hi, qr); } \
        finishSM(PY0, PY1, alY, l_reg, pa0, pa1, pa2, pa3); SBAR(); \
        pv_tile(o, vb0 + vp, pa0, pa1, pa2, pa3); MASKT(PX0, PX1, (t)); partialSM(PX0, PX1, m_reg, mnX, alX); \
        RESC(alX); ROT(); } while (0)
    int t = 1;
    for (; t + 1 < NT; t += 2) {
        STEP(pB0, pB1, mnB, alB, pA0, pA1, alA, t);
        STEP(pA0, pA1, mnA, alA, pB0, pB1, alB, t + 1);
    }
    STEP(pB0, pB1, mnB, alB, pA0, pA1, alA, NT - 1);
    OPEN(NT);
    finishSM(pB0, pB1, alB, l_reg, pa0, pa1, pa2, pa3); SBAR();
    pv_tile(o, vb0 + vp, pa0, pa1, pa2, pa3);
#undef STEP
    } else {
    OPEN(0);
    SBAR(); qkt(pA0, pA1, Kl + k0, r32, hi, qr); ROT();
#define STEPB(PX0, PX1, PY0, PY1, mnY, alY, t) do { \
        OPEN(t); \
        MASKT(PY0, PY1, (t) - 1); partialSM(PY0, PY1, m_reg, mnY, alY); RESC(alY); \
        SBAR(); qkt(PX0, PX1, Kl + k0, r32, hi, qr); if (DBG_QK2) { asm volatile("" : "+v"(PX0), "+v"(PX1)); qkt(PX0, PX1, Kl + k0, r32, hi, qr); } \
        finishSM(PY0, PY1, alY, l_reg, pa0, pa1, pa2, pa3); SBAR(); \
        pv_tile(o, vb0 + vp, pa0, pa1, pa2, pa3); ROT(); } while (0)
    int t = 1;
    for (; t + 1 < NT; t += 2) {
        STEPB(pB0, pB1, pA0, pA1, mnA, alA, t);
        STEPB(pA0, pA1, pB0, pB1, mnB, alB, t + 1);
    }
    STEPB(pB0, pB1, pA0, pA1, mnA, alA, NT - 1);
    OPEN(NT);
    MASKT(pB0, pB1, NT - 1); partialSM(pB0, pB1, m_reg, mnB, alB); RESC(alB);
    finishSM(pB0, pB1, alB, l_reg, pa0, pa1, pa2, pa3); SBAR();
    pv_tile(o, vb0 + vp, pa0, pa1, pa2, pa3);
#undef STEPB
    }
    __builtin_amdgcn_s_setprio(0);
    if (part < 0) {
    if (hi == 0) li_l[r32] = l_reg; asm volatile("s_waitcnt lgkmcnt(0)" ::: "memory");
    float rli[16];
#pragma unroll
    for (int r = 0; r < 16; ++r) rli[r] = __builtin_amdgcn_rcpf(li_l[crow(r, hi)]);
    bf16* Ow = MIX + (size_t)(q0 + wid * 32) * D + 512 + h * 128;
#pragma unroll
    for (int r = 0; r < 16; ++r) { const int orow = crow(r, hi);
#pragma unroll
        for (int d0 = 0; d0 < 4; ++d0) { const float v = o[d0][r] * rli[r]; const float vn = __shfl_xor(v, 1);
            if ((r32 & 1) == 0) *(unsigned*)(Ow + (size_t)orow * D + d0 * 32 + r32) = cvtpk(v, vn); } }
    } else {
    float* Pw = PART + ((size_t)part * 256 + wid * 32) * 128;
#pragma unroll
    for (int r = 0; r < 16; ++r) { const int orow = crow(r, hi);
#pragma unroll
        for (int d0 = 0; d0 < 4; ++d0) Pw[(size_t)orow * 128 + d0 * 32 + r32] = o[d0][r]; }
    if (hi == 0) { float* ml = PML + ((size_t)part * 256 + wid * 32 + r32) * 2; ml[0] = m_reg; ml[1] = l_reg; }
    }
    asm volatile("s_waitcnt lgkmcnt(0)\n\ts_barrier" ::: "memory");
#undef DMA_K
#undef DMA_V
#undef RESC
#undef MASKT
#undef OPEN
#undef ROT
}
}

__device__ __forceinline__ void fin_phase(const Args& a, int gw, int NGW, int lane) {
    unsigned char* ws = a.ws;
    const bf16* P1 = (const bf16*)(ws + WS_P1); const bf16* QR = (const bf16*)(ws + WS_QR); const bf16* KVR = (const bf16*)(ws + WS_KVR);
    bf16* QF = (bf16*)(ws + WS_QF); unsigned char* KIMG = ws + WS_KIMG; unsigned char* VIMG = ws + WS_VIMG; bf16* MIX = (bf16*)(ws + WS_MIX);
    const float* cosT = (const float*)(ws + WS_ROPE); const float* sinT = cosT + (size_t)S * 32;
    const float* qnw = (const float*)a.in[I_QNW]; const float* knw = (const float*)a.in[I_KNW]; const float* cw = (const float*)a.in[I_CONV];
    const int hl = lane & 15, h = lane >> 4, c4 = lane & 3;
    float wq[16], wk[16], wkr[16];
#pragma unroll
    for (int e = 0; e < 16; ++e) { wq[e] = hl < 12 ? qnw[hl * 16 + e] : 0.f; wk[e] = hl < 8 ? knw[hl * 16 + e] : 0.f; wkr[e] = knw[128 + c4 * 16 + e]; }
    float cw0[8], cw1[8], cw2[8];
#pragma unroll
    for (int e = 0; e < 8; ++e) { cw0[e] = cw[lane * 8 + e]; cw1[e] = cw[512 + lane * 8 + e]; cw2[e] = cw[1024 + lane * 8 + e]; }
    for (int t = gw; t < S; t += NGW) {
        const bf16* prow = P1 + (size_t)t * O_INP;
        float s_q, s_kv;
        { const v2u r = *(const v2u*)(prow + 1536 + lane * 4); const float x0 = bflo(r.x), x1 = bfhi(r.x), x2 = bflo(r.y), x3 = bfhi(r.y);
          s_q = 1.f / sqrtf(wave_sum((x0 * x0 + x1 * x1) + (x2 * x2 + x3 * x3)) * (1.f / 256.f) + EPS); }
        { const v2u r = *(const v2u*)(prow + 1792 + lane * 4); const float x0 = bflo(r.x), x1 = bfhi(r.x), x2 = bflo(r.y), x3 = bfhi(r.y);
          s_kv = 1.f / sqrtf(wave_sum((x0 * x0 + x1 * x1) + (x2 * x2 + x3 * x3)) * (1.f / 256.f) + EPS); }
        const int fi = (hl & 1) * 16;
        float cs[16], sn[16];
        { const f32x4* cp = (const f32x4*)(cosT + (size_t)t * 32 + fi); const f32x4* sp = (const f32x4*)(sinT + (size_t)t * 32 + fi);
#pragma unroll
          for (int q = 0; q < 4; ++q) { const f32x4 c_ = cp[q], s_ = sp[q]; cs[4 * q] = c_.x; cs[4 * q + 1] = c_.y; cs[4 * q + 2] = c_.z; cs[4 * q + 3] = c_.w; sn[4 * q] = s_.x; sn[4 * q + 1] = s_.y; sn[4 * q + 2] = s_.z; sn[4 * q + 3] = s_.w; } }
        { const v4u r0 = *(const v4u*)(QR + (size_t)t * 1024 + lane * 16), r1 = *(const v4u*)(QR + (size_t)t * 1024 + lane * 16 + 8);
          float x[16] = {bflo(r0.x), bfhi(r0.x), bflo(r0.y), bfhi(r0.y), bflo(r0.z), bfhi(r0.z), bflo(r0.w), bfhi(r0.w), bflo(r1.x), bfhi(r1.x), bflo(r1.y), bfhi(r1.y), bflo(r1.z), bfhi(r1.z), bflo(r1.w), bfhi(r1.w)};
          float ss = 0.f;
#pragma unroll
          for (int e = 0; e < 16; ++e) { x[e] *= s_q; ss += x[e] * x[e]; }
          ss += __shfl_xor(ss, 1); ss += __shfl_xor(ss, 2); ss += __shfl_xor(ss, 4); ss += __shfl_xor(ss, 8);
          const float rq = 1.f / sqrtf(ss * (1.f / 192.f) + EPS);
          float y[16];
#pragma unroll
          for (int e = 0; e < 16; ++e) { const float v = x[e] * rq * wq[e]; const float pr = __shfl_xor(v, 2);
              y[e] = hl < 8 ? v : (hl < 10 ? v * cs[e] - pr * sn[e] : v * cs[e] + pr * sn[e]); }
          if (hl < 12) { v4u o0, o1; o0.x = pk2(y[0], y[1]); o0.y = pk2(y[2], y[3]); o0.z = pk2(y[4], y[5]); o0.w = pk2(y[6], y[7]); o1.x = pk2(y[8], y[9]); o1.y = pk2(y[10], y[11]); o1.z = pk2(y[12], y[13]); o1.w = pk2(y[14], y[15]);
              bf16* qd = QF + ((size_t)h * S + t) * 192 + hl * 16; *(v4u*)qd = o0; *(v4u*)(qd + 8) = o1; } }
        { const v4u r0 = *(const v4u*)(KVR + (size_t)t * 1024 + lane * 16), r1 = *(const v4u*)(KVR + (size_t)t * 1024 + lane * 16 + 8);
          float x[16] = {bflo(r0.x), bfhi(r0.x), bflo(r0.y), bfhi(r0.y), bflo(r0.z), bfhi(r0.z), bflo(r0.w), bfhi(r0.w), bflo(r1.x), bfhi(r1.x), bflo(r1.y), bfhi(r1.y), bflo(r1.z), bfhi(r1.z), bflo(r1.w), bfhi(r1.w)};
          const v4u p0 = *(const v4u*)(prow + 2048 + c4 * 16), p1 = *(const v4u*)(prow + 2048 + c4 * 16 + 8);
          float kp[16] = {bflo(p0.x), bfhi(p0.x), bflo(p0.y), bfhi(p0.y), bflo(p0.z), bfhi(p0.z), bflo(p0.w), bfhi(p0.w), bflo(p1.x), bfhi(p1.x), bflo(p1.y), bfhi(p1.y), bflo(p1.z), bfhi(p1.z), bflo(p1.w), bfhi(p1.w)};
          float ssk = 0.f, ssp = 0.f;
#pragma unroll
          for (int e = 0; e < 16; ++e) { x[e] *= s_kv; ssk += x[e] * x[e]; ssp += kp[e] * kp[e]; }
          if (hl >= 8) ssk = 0.f;
          ssk += __shfl_xor(ssk, 1); ssk += __shfl_xor(ssk, 2); ssk += __shfl_xor(ssk, 4); ssk += __shfl_xor(ssk, 8);
          ssp += __shfl_xor(ssp, 1); ssp += __shfl_xor(ssp, 2);
          const float rk = 1.f / sqrtf((ssk + ssp) * (1.f / 192.f) + EPS);
          const int krow = t & 63, tile = t >> 6;
          unsigned char* kt = KIMG + ((size_t)h * 256 + tile) * att::KSLOT; unsigned char* vt = VIMG + ((size_t)h * 256 + tile) * att::VSLOT;
          float y[16];
#pragma unroll
          for (int e = 0; e < 16; ++e) y[e] = hl < 8 ? x[e] * rk * wk[e] : x[e];
          { v4u o0, o1; o0.x = pk2(y[0], y[1]); o0.y = pk2(y[2], y[3]); o0.z = pk2(y[4], y[5]); o0.w = pk2(y[6], y[7]); o1.x = pk2(y[8], y[9]); o1.y = pk2(y[10], y[11]); o1.z = pk2(y[12], y[13]); o1.w = pk2(y[14], y[15]);
            if (hl < 8) { *(v4u*)(kt + att::k_nope_off(krow, hl * 32)) = o0; *(v4u*)(kt + att::k_nope_off(krow, hl * 32 + 16)) = o1; }
            else { *(v4u*)(vt + att::v_st(krow, (hl - 8) * 16)) = o0; *(v4u*)(vt + att::v_st(krow, (hl - 8) * 16 + 8)) = o1; } }
          float z[16];
#pragma unroll
          for (int e = 0; e < 16; ++e) { const float v = kp[e] * rk * wkr[e]; const float pr = __shfl_xor(v, 2); z[e] = c4 < 2 ? v * cs[e] - pr * sn[e] : v * cs[e] + pr * sn[e]; }
          if (hl < 4) { v4u o0, o1; o0.x = pk2(z[0], z[1]); o0.y = pk2(z[2], z[3]); o0.z = pk2(z[4], z[5]); o0.w = pk2(z[6], z[7]); o1.x = pk2(z[8], z[9]); o1.y = pk2(z[10], z[11]); o1.z = pk2(z[12], z[13]); o1.w = pk2(z[14], z[15]);
              *(v4u*)(kt + att::k_rope_off(krow, c4 * 32)) = o0; *(v4u*)(kt + att::k_rope_off(krow, c4 * 32 + 16)) = o1; } }
        { const int ch = lane * 8; float conv[8] = {0.f, 0.f, 0.f, 0.f, 0.f, 0.f, 0.f, 0.f};
#pragma unroll
          for (int k = 0; k < 3; ++k) { const int tt = t - 2 + k; if (tt >= 0) { const bf16* pr = P1 + (size_t)tt * O_INP; const v4u cg = *(const v4u*)(pr + 512 + ch), hh = *(const v4u*)(pr + 1024 + ch);
              const float* wv = k == 0 ? cw0 : (k == 1 ? cw1 : cw2);
              conv[0] += wv[0] * bflo(cg.x) * bflo(hh.x); conv[1] += wv[1] * bfhi(cg.x) * bfhi(hh.x); conv[2] += wv[2] * bflo(cg.y) * bflo(hh.y); conv[3] += wv[3] * bfhi(cg.y) * bfhi(hh.y);
              conv[4] += wv[4] * bflo(cg.z) * bflo(hh.z); conv[5] += wv[5] * bfhi(cg.z) * bfhi(hh.z); conv[6] += wv[6] * bflo(cg.w) * bflo(hh.w); conv[7] += wv[7] * bfhi(cg.w) * bfhi(hh.w); } }
          const v4u bg = *(const v4u*)(prow + ch);
          v4u o; o.x = pk2(bflo(bg.x) * conv[0], bfhi(bg.x) * conv[1]); o.y = pk2(bflo(bg.y) * conv[2], bfhi(bg.y) * conv[3]); o.z = pk2(bflo(bg.z) * conv[4], bfhi(bg.z) * conv[5]); o.w = pk2(bflo(bg.w) * conv[6], bfhi(bg.w) * conv[7]);
          *(v4u*)(MIX + (size_t)t * D + ch) = o; }
    }
}

__device__ __forceinline__ void route_phase(const Args& a, LAS unsigned char* lds, int vcu, int G, int tid) {
    unsigned char* ws = a.ws; const float* XR = (const float*)(ws + WS_XR); const float* modF = (const float*)(ws + WS_MODF) + 6144;
    const float* nw = (const float*)a.in[I_NFW] + 1024; const float* rw = (const float*)a.in[I_RW];
    unsigned* tok = (unsigned*)(ws + WS_TOK); unsigned* cnt = (unsigned*)(ws + WS_CTL) + CW_CNT; unsigned char* AM = ws + WS_AMOES;
    const int lane = tid & 63, wave = __builtin_amdgcn_readfirstlane(tid >> 6);
    LAS int* tokE = (LAS int*)lds;
    LAS int* tokL = (LAS int*)(lds + 512);
    LAS int* offS = (LAS int*)(lds + 1024);
    LAS unsigned* rows = (LAS unsigned*)(lds + 2048);
    f32x4 g[4], sh[4];
#pragma unroll
    for (int j = 0; j < 4; ++j)
#pragma unroll
        for (int e = 0; e < 4; ++e) { const int col = 4 * lane + e + 256 * j; g[j][e] = nw[col] * (1.f + modF[OFF_SCF + col]); sh[j][e] = modF[OFF_SHF + col]; }
    for (int chunk = vcu; chunk < S / 64; chunk += G) {
        for (int i = 0; i < 8; ++i) { const int ti = wave * 8 + i, t = chunk * 64 + ti;
            const f32x4* xr = (const f32x4*)(XR + (size_t)t * D) + lane; f32x4 v[4]; float s = 0.f;
#pragma unroll
            for (int j = 0; j < 4; ++j) { v[j] = xr[64 * j]; s += (v[j].x * v[j].x + v[j].y * v[j].y) + (v[j].z * v[j].z + v[j].w * v[j].w); }
            const float rstd = 1.f / sqrtf(wave_sum(s) * (1.f / D) + EPS);
            float lg[8] = {0.f, 0.f, 0.f, 0.f, 0.f, 0.f, 0.f, 0.f};
#pragma unroll
            for (int j = 0; j < 4; ++j) { const f32x4 hv = v[j] * rstd * g[j] + sh[j]; rows[ti * 256 + lane + 64 * j] = pg8::pk4_fp8(hv.x, hv.y, hv.z, hv.w);
#pragma unroll
                for (int e = 0; e < 4; ++e) { const int col = 4 * lane + e + 256 * j; const f32x4 w0 = *(const f32x4*)(rw + col * 8), w1 = *(const f32x4*)(rw + col * 8 + 4); const float hx = hv[e];
                    lg[0] += hx * w0.x; lg[1] += hx * w0.y; lg[2] += hx * w0.z; lg[3] += hx * w0.w; lg[4] += hx * w1.x; lg[5] += hx * w1.y; lg[6] += hx * w1.z; lg[7] += hx * w1.w; } }
#pragma unroll
            for (int e = 0; e < 8; ++e) lg[e] = wave_sum(lg[e]);
            int e1 = 0; float l1 = lg[0];
#pragma unroll
            for (int e = 1; e < 8; ++e) if (lg[e] > l1) { l1 = lg[e]; e1 = e; }
            int e2 = -1; float l2 = -__builtin_inff();
#pragma unroll
            for (int e = 0; e < 8; ++e) if (e != e1 && lg[e] > l2) { l2 = lg[e]; e2 = e; }
            const float g1 = 1.f / (1.f + __expf(l2 - l1)), g2 = 1.f - g1;
            if (lane == 0) { unsigned* rec = tok + (size_t)t * 8; rec[0] = (unsigned)e1; rec[1] = (unsigned)e2; rec[4] = __float_as_uint(g1); rec[5] = __float_as_uint(g2);
                tokE[2 * ti] = e1; tokE[2 * ti + 1] = e2; } }
        __syncthreads();
        if (tid < 8) { int c = 0; for (int i = 0; i < 128; ++i) if (tokE[i] == tid) { tokL[i] = c; ++c; }
            offS[tid] = (int)__hip_atomic_fetch_add(cnt + 64 * tid, (unsigned)c, RLX_AGENT); }
        __syncthreads();
        for (int i = 0; i < 8; ++i) { const int ti = wave * 8 + i, t = chunk * 64 + ti; const int e1 = tokE[2 * ti], e2 = tokE[2 * ti + 1];
            const int r1 = offS[e1] + tokL[2 * ti], r2 = offS[e2] + tokL[2 * ti + 1];
            unsigned* o1 = (unsigned*)(AM + ((size_t)e1 * 16384 + r1) * D) + lane; unsigned* o2 = (unsigned*)(AM + ((size_t)e2 * 16384 + r2) * D) + lane;
#pragma unroll
            for (int j = 0; j < 4; ++j) { const unsigned w = rows[ti * 256 + lane + 64 * j]; o1[64 * j] = w; o2[64 * j] = w; }
            if (lane == 0) { tok[(size_t)t * 8 + 2] = (unsigned)r1; tok[(size_t)t * 8 + 3] = (unsigned)r2; } }
        __syncthreads();
    }
}
__device__ __forceinline__ void combine_phase(const Args& a, int gw, int NGW, int lane) {
    unsigned char* ws = a.ws; const float* XR = (const float*)(ws + WS_XR); const float* gf = (const float*)(ws + WS_MODF) + 6144 + OFF_GF;
    const unsigned* tok = (const unsigned*)(ws + WS_TOK); const bf16* Y = (const bf16*)(ws + WS_AMOE);
    f32x4 gg[4];
#pragma unroll
    for (int j = 0; j < 4; ++j) gg[j] = *(const f32x4*)(gf + 4 * lane + 256 * j);
    int base[8]; { const unsigned* cnt = (const unsigned*)(ws + WS_CTL) + CW_CNT; int b_ = 0;
#pragma unroll
      for (int e = 0; e < 8; ++e) { base[e] = b_; b_ += (int)((__hip_atomic_load(cnt + 64 * e, RLX_AGENT) + 255u) >> 8) * 256; } }
    for (int t0 = gw; t0 < S; t0 += 4 * NGW) {
        v2u rs[4], rg[4];
#pragma unroll
        for (int i = 0; i < 4; ++i) { const int t = t0 + i * NGW < S ? t0 + i * NGW : t0; const v2u re = *(const v2u*)(tok + (size_t)t * 8); rs[i] = *(const v2u*)(tok + (size_t)t * 8 + 2); rg[i] = *(const v2u*)(tok + (size_t)t * 8 + 4);
            unsigned b1 = 0u, b2 = 0u;
#pragma unroll
            for (int e = 0; e < 8; ++e) { b1 = re.x == (unsigned)e ? (unsigned)base[e] : b1; b2 = re.y == (unsigned)e ? (unsigned)base[e] : b2; }
            rs[i].x += b1; rs[i].y += b2; }
        f32x4 xv[4][4]; v2u y1[4][4], y2[4][4];
#pragma unroll
        for (int i = 0; i < 4; ++i) { const int t = t0 + i * NGW < S ? t0 + i * NGW : t0;
            const f32x4* xr = (const f32x4*)(XR + (size_t)t * D) + lane; const v2u* p1 = (const v2u*)(Y + (size_t)rs[i].x * D) + lane; const v2u* p2 = (const v2u*)(Y + (size_t)rs[i].y * D) + lane;
#pragma unroll
            for (int j = 0; j < 4; ++j) { xv[i][j] = xr[64 * j]; y1[i][j] = p1[64 * j]; y2[i][j] = p2[64 * j]; } }
#pragma unroll
        for (int i = 0; i < 4; ++i) { const int t = t0 + i * NGW; if (t < S) { const float g1 = __uint_as_float(rg[i].x), g2 = __uint_as_float(rg[i].y); f32x4* orow = (f32x4*)(a.out + (size_t)t * D) + lane;
#pragma unroll
            for (int j = 0; j < 4; ++j) { const v2u a1 = y1[i][j], a2 = y2[i][j];
                f32x4 m; m.x = g1 * bflo(a1.x) + g2 * bflo(a2.x); m.y = g1 * bfhi(a1.x) + g2 * bfhi(a2.x); m.z = g1 * bflo(a1.y) + g2 * bflo(a2.y); m.w = g1 * bfhi(a1.y) + g2 * bfhi(a2.y);
                orow[64 * j] = xv[i][j] + gg[j] * m; } } }
    }
}

constexpr int N_PHASES = 19;
__global__ void __launch_bounds__(NTHR, 2) fwd_kernel(Args args) {
    extern __shared__ __attribute__((aligned(16))) unsigned char lds[];
    LAS unsigned char* L = (LAS unsigned char*)lds;
    const int tid = threadIdx.x, lane = tid & 63, wave = __builtin_amdgcn_readfirstlane(tid >> 6);
    const int G = gridDim.x; int bx = blockIdx.x; int vcu = (G % 8 == 0) ? (bx % 8) * (G / 8) + bx / 8 : bx;
    int gw = vcu * NWAVES + wave; const int NGW = G * NWAVES;
    unsigned char* ws = args.ws;
    for (int u = tid; u < (LDS_BYTES - LDSCTL_OFF) / 4; u += NTHR) ((LAS unsigned*)(L + LDSCTL_OFF))[u] = 0u;
    __syncthreads();
    XcdBarrier bar; bar.bar = (unsigned*)(ws + WS_CTL) + CW_BAR; bar.x = 0; bar.st = nullptr;
#if !MK_MULTI
    bar = xcd_barrier_post((unsigned*)(ws + WS_CTL) + CW_BAR, (volatile LAS unsigned*)(L + MISC_OFF) + 8);
    if (tid == 0) { volatile LAS unsigned* M = (volatile LAS unsigned*)(L + MISC_OFF); M[10] = bar.x; M[11] = xb_add((unsigned*)(ws + WS_CTL) + CW_XRANK + 64 * bar.x, 1u); }
#define GRID_BAR() xcd_barrier(bar)
#else
#define GRID_BAR() do {} while (0)
#endif
    const int lo = args.ph_lo, hi = args.ph_hi;
#define IN(k) (lo <= (k) && (k) < hi)
#define BOTH(k) (IN(k) && IN((k) + 1))
    const float* modF = (const float*)(ws + WS_MODF);
    bf16* ABUF = (bf16*)(ws + WS_ABUF); bf16* MIX = (bf16*)(ws + WS_MIX); float* XR = (float*)(ws + WS_XR);

    if (IN(0)) { p0_prologue(args, L, vcu, G, tid); if (DBG_REP == 0) { GRID_BAR(); p0_prologue(args, L, vcu, G, tid); } if (BOTH(0)) GRID_BAR(); }
#if !MK_MULTI && XCC_ORDER
    if (BOTH(0)) {
        volatile LAS unsigned* M = (volatile LAS unsigned*)(L + MISC_OFF);
        if (tid == 0) { unsigned* xb = (unsigned*)(ws + WS_CTL) + CW_BAR; bool ok = (G % 8) == 0;
            for (unsigned j = 0; j < 16; ++j) { const unsigned c_ = xb_ld(&xb[XB_XCNT(j)]); ok = ok && (c_ == (j < 8 ? (unsigned)(G / 8) : 0u)); }
            M[12] = ok ? (M[11] * 8u + M[10]) : (unsigned)blockIdx.x; }
        __syncthreads();
        bx = (int)M[12]; vcu = (G % 8 == 0) ? (bx % 8) * (G / 8) + bx / 8 : bx; gw = vcu * NWAVES + wave;
    }
#endif
    if (IN(1)) {
        { float* mf = (float*)(ws + WS_MODF); for (int i = vcu * NTHR + tid; i < 2 * 6144; i += G * NTHR) mf[i] = modv_partial((const float*)(ws + WS_MODP), (const float*)args.in[I_ADAB], i / 6144, i % 6144); }
        norm_phase<true>(args, (const float*)args.in[I_X], ABUF, (const float*)args.in[I_NMW], 0, OFF_SHM, OFF_SCM, gw, NGW, lane, (LAS float*)L);
        if (DBG_REP == 1) { GRID_BAR(); norm_phase<true>(args, (const float*)args.in[I_X], ABUF, (const float*)args.in[I_NMW], 0, OFF_SHM, OFF_SCM, gw, NGW, lane, (LAS float*)L); }
        if (BOTH(1)) GRID_BAR(); }
    if (IN(2)) { pg8::Gemm g{ABUF, ws + WS_WIN0, 2048, 2048}; pg8::StaticOrder So; So.init(S, E_IN, G, bx);
        pg8::EpiBf16G E{(bf16*)(ws + WS_P0), E_IN, 4, 1.f}; pg8::gemm_phase(L, g, So, E); if (DBG_REP == 2) { GRID_BAR(); pg8::gemm_phase(L, g, So, E); } conv_fill(args, L, (unsigned*)(ws + WS_CTL) + CW_GD, G, tid); if (BOTH(2)) GRID_BAR(); }
    if (IN(3)) { mixab_phase(args, L, vcu, G, tid); if (DBG_REP == 3) { GRID_BAR(); mixab_phase(args, L, vcu, G, tid); } if (BOTH(3)) GRID_BAR(); }
    if (IN(4)) { pg8::Gemm g{MIX, ws + WS_WOUT0, 2048, 2048}; pg8::StaticOrder So; So.init(S, 1024, G, bx);
        pg8::EpiResT<false, true> E{args.in[I_X], ws + WS_XRB, modF + OFF_GM, 1.f}; pg8::gemm_phase(L, g, So, E); if (DBG_REP == 4) { GRID_BAR(); pg8::gemm_phase(L, g, So, E); } if (BOTH(4)) GRID_BAR(); }
    if (IN(5)) { norm_phase<false, false, true>(args, ws + WS_XRB, ABUF, (const float*)args.in[I_NFW], 0, OFF_SHF, OFF_SCF, gw, NGW, lane); if (DBG_REP == 5) { GRID_BAR(); norm_phase<false, false, true>(args, ws + WS_XRB, ABUF, (const float*)args.in[I_NFW], 0, OFF_SHF, OFF_SCF, gw, NGW, lane); } if (BOTH(5)) GRID_BAR(); }
    if (IN(6)) { pg8::Gemm g{ABUF, ws + WS_WGU0, 2048, 2048}; pg8::StaticOrder So; So.init(S, 2 * D_FF, G, bx);
        pg8::EpiSwiGLU E{(bf16*)(ws + WS_H), D_FF}; pg8::gemm_phase(L, g, So, E); if (DBG_REP == 6) { GRID_BAR(); pg8::gemm_phase(L, g, So, E); } if (FILL_G3) conv_fill(args, L, (unsigned*)(ws + WS_CTL) + CW_GD + 64, G, tid); if (BOTH(6)) GRID_BAR(); }
    if (IN(7)) { pg8::Gemm g{ws + WS_H, ws + WS_WD0, D_FF * 2, D_FF * 2}; pg8::StaticOrder So; So.init(S, 1024, G, bx);
        pg8::EpiResT<true, true> E{ws + WS_XRB, ws + WS_XRB, modF + OFF_GF, 1.f}; pg8::gemm_phase(L, g, So, E);
        if (DBG_REP == 7) { GRID_BAR(); pg8::EpiResT<true, true> E2{ws + WS_XRB, ABUF, modF + OFF_GF, 1.f}; pg8::gemm_phase(L, g, So, E2); }
        if (BOTH(7)) GRID_BAR(); }
    if (IN(8)) { norm_phase<false, false, true>(args, ws + WS_XRB, ABUF, (const float*)args.in[I_NMW] + 1024, 1, OFF_SHM, OFF_SCM, gw, NGW, lane); if (BOTH(8)) GRID_BAR(); }
    if (IN(9)) { pg8::Gemm g{ABUF, ws + WS_WIN1, 2048, 2048}; pg8::StaticOrder So; So.init(S, O_INP, G, bx);
        pg8::EpiBf16G E{(bf16*)(ws + WS_P1), O_INP, 0, 1.f}; pg8::gemm_phase(L, g, So, E); if (DBG_REP == 9) { GRID_BAR(); pg8::gemm_phase(L, g, So, E); } conv_fill(args, L, (unsigned*)(ws + WS_CTL) + CW_GD + 128, G, tid); if (BOTH(9)) GRID_BAR(); }
    if (IN(10)) {
        for (int rep_ = 0; rep_ < (DBG_REP == 10 ? 2 : 1); ++rep_) { if (rep_) GRID_BAR();
        { pg8::Gemm g{(const bf16*)(ws + WS_P1) + 1536, ws + WS_WUQ, O_INP * 2, 512}; pg8::StaticOrder So; So.init(S, 1024, G, bx);
          pg8::EpiBf16G E{(bf16*)(ws + WS_QR), 1024, 0, 1.f}; pg8::gemm_phase(L, g, So, E); }
        { pg8::Gemm g{(const bf16*)(ws + WS_P1) + 1792, ws + WS_WUKV, O_INP * 2, 512}; pg8::StaticOrder So; So.init(S, 1024, G, bx);
          pg8::EpiBf16G E{(bf16*)(ws + WS_KVR), 1024, 0, 1.f}; pg8::gemm_phase(L, g, So, E); } }
        if (BOTH(10)) GRID_BAR(); }
    if (IN(11)) { fin_phase(args, gw, NGW, lane); if (DBG_REP == 11) { GRID_BAR(); fin_phase(args, gw, NGW, lane); } if (BOTH(11)) GRID_BAR(); }
    if (IN(12)) {
        for (int rep = 0; rep < (DBG_REP == 12 ? 2 : 1); ++rep) { if (rep) GRID_BAR();
        for (int u = bx; u < 256; u += G) { const int h = u & 3, v = u >> 2, sb = v >> 1, role = v & 1, nA = 126 - 4 * sb, pi = (h * 32 + sb) * 2;
            const bf16* QF = (const bf16*)(ws + WS_QF); float* PART = (float*)(ws + WS_PART); float* PML = (float*)(ws + WS_PML);
            if (role == 0) { att::attn_block(h, sb, 0, 4 * (sb + 1), -1, QF, ws + WS_KIMG, ws + WS_VIMG, MIX, PART, PML, (char*)lds);
                             att::attn_block(h, 63 - sb, 0, nA, pi, QF, ws + WS_KIMG, ws + WS_VIMG, MIX, PART, PML, (char*)lds); }
            else att::attn_block(h, 63 - sb, nA, 4 * (64 - sb), pi + 1, QF, ws + WS_KIMG, ws + WS_VIMG, MIX, PART, PML, (char*)lds); } }
        GRID_BAR();
        { const float* PART = (const float*)(ws + WS_PART); const float* PML = (const float*)(ws + WS_PML); constexpr float C2 = 1.4426950408889634f * att::SCALE;
          for (int it = vcu * NTHR + tid; it < 128 * 256 * 16; it += G * NTHR) { const int rw = it >> 4, c8 = (it & 15) * 8, blk = rw >> 8, row = rw & 255, h = blk >> 5, sb = blk & 31, pi = blk * 2;
              const size_t ra = (size_t)pi * 256 + row, rb = ra + 256;
              const float mA = PML[ra * 2], lA = PML[ra * 2 + 1], mB = PML[rb * 2], lB = PML[rb * 2 + 1];
              const f32x4 a0 = *(const f32x4*)(PART + ra * 128 + c8), a1 = *(const f32x4*)(PART + ra * 128 + c8 + 4), b0 = *(const f32x4*)(PART + rb * 128 + c8), b1 = *(const f32x4*)(PART + rb * 128 + c8 + 4);
              const float m = fmaxf(mA, mB), wA = __builtin_amdgcn_exp2f((mA - m) * C2), wB = __builtin_amdgcn_exp2f((mB - m) * C2), inv = 1.f / (lA * wA + lB * wB);
              const f32x4 v0 = (a0 * wA + b0 * wB) * inv, v1 = (a1 * wA + b1 * wB) * inv;
              v4u o; o.x = pk2(v0[0], v0[1]); o.y = pk2(v0[2], v0[3]); o.z = pk2(v1[0], v1[1]); o.w = pk2(v1[2], v1[3]);
              *(v4u*)(MIX + (size_t)((63 - sb) * 256 + row) * D + 512 + h * 128 + c8) = o; } }
        if (BOTH(12)) GRID_BAR(); }
    if (IN(13)) { pg8::Gemm g{MIX, ws + WS_WOUT1, 2048, 2048}; pg8::StaticOrder So; So.init(S, 1024, G, bx);
        pg8::EpiResT<true, false> E{ws + WS_XRB, XR, modF + 6144 + OFF_GM, 1.f}; pg8::gemm_phase(L, g, So, E); if (DBG_REP == 13) { GRID_BAR(); pg8::gemm_phase(L, g, So, E); }
        if (BOTH(13)) GRID_BAR(); }
    if (IN(14)) { conv_fill(args, L, nullptr, G, tid); route_phase(args, L, vcu, G, tid); if (BOTH(14)) GRID_BAR(); }
    if (IN(16)) { pg8::Gemm g{ws + WS_AMOES, ws + WS_WGUM, 1024, 1024}; pg8::MoeOrder Mo; Mo.init((const unsigned*)(ws + WS_CTL) + CW_CNT, 28, G, vcu, 8, 1);
        pg8::EpiSwiGLU8 E{ws + WS_HM, DFE, 1.f / MOE_WSCALE}; pg8::gemm_phase<pg8::EpiSwiGLU8, pg8::MoeOrder, true>(L, g, Mo, E); if (DBG_REP == 16) { GRID_BAR(); pg8::gemm_phase<pg8::EpiSwiGLU8, pg8::MoeOrder, true>(L, g, Mo, E); } if (BOTH(16)) GRID_BAR(); }
    if (IN(17)) { pg8::Gemm g{ws + WS_HM, ws + WS_WDM, DFE, DFE}; pg8::MoeOrder Mo; Mo.init((const unsigned*)(ws + WS_CTL) + CW_CNT, 4, G, vcu, 256, 0);
        pg8::EpiBf16G E{(bf16*)(ws + WS_AMOE), 1024, 0, 1.f / MOE_WSCALE}; pg8::gemm_phase<pg8::EpiBf16G, pg8::MoeOrder, true>(L, g, Mo, E); if (DBG_REP == 17) { GRID_BAR(); pg8::gemm_phase<pg8::EpiBf16G, pg8::MoeOrder, true>(L, g, Mo, E); } if (BOTH(17)) GRID_BAR(); }
    if (IN(18)) { combine_phase(args, gw, NGW, lane); if (DBG_REP == 18) { GRID_BAR(); combine_phase(args, gw, NGW, lane); } }
#if DBG_DUMMY
    if (IN(18)) { GRID_BAR();
#if DBG_DUMMY >= 6 && DBG_DUMMY <= 8
        constexpr int KBX = DBG_DUMMY == 6 ? 1024 : (DBG_DUMMY == 7 ? 2048 : 4096);
        pg8::Gemm g{XR, XR, 4096, KBX}; pg8::StaticOrder So; So.init(S, 8192 * 1024 / KBX, G, bx);
        pg8::EpiNone E{}; pg8::gemm_phase<pg8::EpiNone, pg8::StaticOrder, true>(L, g, So, E);
#elif DBG_DUMMY == 5
        pg8::Gemm g{ABUF, ws + WS_WGUM, 2048, 1024}; pg8::MoeOrder Mo; Mo.init((const unsigned*)(ws + WS_CTL) + CW_CNT, 28, G, vcu, 8);
        pg8::EpiNone E{}; pg8::gemm_phase<pg8::EpiNone, pg8::MoeOrder, true>(L, g, Mo, E);
#elif DBG_DUMMY == 4
        pg8::Gemm g{ABUF, ws + WS_WGUM, 2048, 1024}; pg8::StaticOrder So; So.init(4096, 57344, G, bx);
        pg8::EpiNone E{}; pg8::gemm_phase<pg8::EpiNone, pg8::StaticOrder, true>(L, g, So, E);
#elif DBG_DUMMY == 3
        pg8::Gemm g{ABUF, ws + WS_WGU0, 2048, 2048}; pg8::StaticOrder So; So.init(S, 2048, G, bx);
        pg8::EpiNone E{}; pg8::gemm_phase<pg8::EpiNone, pg8::StaticOrder, true>(L, g, So, E);
#elif DBG_DUMMY == 2
        pg8::Gemm g{ABUF, ws + WS_WGUM, 2048, 1024}; pg8::StaticOrder So; So.init(S, 4096, G, bx);
        pg8::EpiSwiGLU8 E{ws + WS_HM, DFE, 1.f / MOE_WSCALE}; pg8::gemm_phase<pg8::EpiSwiGLU8, pg8::StaticOrder, true>(L, g, So, E);
#else
        pg8::Gemm g{ABUF, ws + WS_WGUM, 2048, 1024}; pg8::StaticOrder So; So.init(S, 4096, G, bx);
        pg8::EpiNone E{}; pg8::gemm_phase<pg8::EpiNone, pg8::StaticOrder, true>(L, g, So, E);
#endif
    }
#endif
    if (IN(19)) { const f32x4* src = (const f32x4*)(DBG_STOP < 4 ? (const float*)args.in[I_X] : (const float*)XR); f32x4* dst = (f32x4*)args.out;
        for (size_t i = (size_t)vcu * NTHR + tid; i < (size_t)S * D / 4; i += (size_t)G * NTHR) dst[i] = src[i]; }
#undef IN
#undef BOTH
}

extern "C" void kernel_launch(void* const* d_in, const int* in_sizes, int n_in, void* d_out, int out_size, void* d_ws, size_t ws_size, hipStream_t stream) {
    static int grid = 0;
    if (grid == 0) {
        if (n_in != 29 || out_size != S * D || ws_size < WS_END) { fprintf(stderr, "kernel_launch: unexpected shapes (n_in %d out %d ws %zu)\n", n_in, out_size, ws_size); grid = -1; return; }
        int dev = 0, cus = 0;
        if (hipGetDevice(&dev) != hipSuccess || hipDeviceGetAttribute(&cus, hipDeviceAttributeMultiprocessorCount, dev) != hipSuccess) { grid = -1; return; }
        if (hipFuncSetAttribute((const void*)fwd_kernel, hipFuncAttributeMaxDynamicSharedMemorySize, LDS_BYTES) != hipSuccess) { grid = -1; return; }
        int per_cu = 0;
        if (hipOccupancyMaxActiveBlocksPerMultiprocessor(&per_cu, (const void*)fwd_kernel, NTHR, LDS_BYTES) != hipSuccess || per_cu < 1) fprintf(stderr, "kernel_launch: occupancy query says %d\n", per_cu);
        (void)hipGetLastError();
        grid = cus;
    }
    if (grid < 0) return;
    (void)hipMemsetAsync((char*)d_ws + WS_CTL, 0, CTL_ZERO_BYTES, stream);
    Args a{};
    for (int i = 0; i < 29; ++i) a.in[i] = d_in[i];
    a.out = (float*)d_out; a.ws = (unsigned char*)d_ws;
#if MK_MULTI
    { const int last = DBG_STOP < 0 ? N_PHASES - 1 : DBG_STOP;
      for (int p = 0; p <= last; ++p) { a.ph_lo = p; a.ph_hi = p + 1; hipLaunchKernelGGL(fwd_kernel, dim3(grid), dim3(NTHR), LDS_BYTES, stream, a); }
      if (DBG_STOP >= 0) { a.ph_lo = 19; a.ph_hi = 20; hipLaunchKernelGGL(fwd_kernel, dim3(grid), dim3(NTHR), LDS_BYTES, stream, a); } }
#else
    a.ph_lo = 0; a.ph_hi = N_PHASES;
    hipLaunchKernelGGL(fwd_kernel, dim3(grid), dim3(NTHR), LDS_BYTES, stream, a);
#endif
}
```
